# Optimizing an MI355X kernel written in HIP

```python
import math
import jax, jax.numpy as jnp
from jax import lax
import numpy as np

D_MODEL = 2048
BATCH = 8
SEQ = 4096
DEPTH = 2

N_A_LAYERS = DEPTH // 2
N_B_LAYERS = DEPTH - N_A_LAYERS
BLOCK_Q = 128
EPS = 1e-6

SB_HEADS = 16
SB_HEAD_DIM = D_MODEL // SB_HEADS

MLA_HEADS = 16
QK_NOPE = 128
QK_ROPE = 64
V_HEAD = 128
Q_LORA = 512
KV_LORA = 512
ROPE_BASE = 10000.0

PEER_HEADS = 8
N_KEYS = 128
N_EXPERTS = N_KEYS * N_KEYS
PEER_TOPK = 16
PEER_KEY_DIM = 256
PEER_HALF = PEER_KEY_DIM // 2
PEER_CHUNK = 128

kernel_name = 'hybrid_yoco_stickbreak_mla_peer'


def rmsnorm(x, g):
    xf = x.astype(jnp.float32)
    y = xf * lax.rsqrt(jnp.mean(xf * xf, axis=-1, keepdims=True) + EPS)
    return (y * g.astype(jnp.float32)).astype(x.dtype)


def rope(x, positions):
    r = x.shape[-1]
    inv_freq = ROPE_BASE ** (-jnp.arange(0, r, 2, dtype=jnp.float32) / r)
    ang = positions.astype(jnp.float32)[..., None] * inv_freq
    cos = jnp.cos(ang)[:, :, None, :]
    sin = jnp.sin(ang)[:, :, None, :]
    xf = x.astype(jnp.float32)
    x1, x2 = xf[..., : r // 2], xf[..., r // 2:]
    out = jnp.concatenate([x1 * cos - x2 * sin, x2 * cos + x1 * sin], axis=-1)
    return out.astype(x.dtype)


def stick_breaking_attention(h, w_qkv, w_o):
    b, s, _ = h.shape
    q, k, v = jnp.split(h @ w_qkv, 3, axis=-1)
    q = q.reshape(b, s, SB_HEADS, SB_HEAD_DIM)
    k = k.reshape(b, s, SB_HEADS, SB_HEAD_DIM)
    v = v.reshape(b, s, SB_HEADS, SB_HEAD_DIM)
    scale = SB_HEAD_DIM ** -0.5
    outs = []
    for i in range(s // BLOCK_Q):
        lo, hi = i * BLOCK_Q, (i + 1) * BLOCK_Q
        z = jnp.einsum('bqhd,bkhd->bhqk', q[:, lo:hi], k[:, :hi]).astype(jnp.float32) * scale
        causal = jnp.arange(hi)[None, :] < jnp.arange(lo, hi)[:, None]
        log_1m_beta = jnp.where(causal, jax.nn.log_sigmoid(-z), 0.0)
        tail = lax.cumsum(log_1m_beta, axis=3, reverse=True) - log_1m_beta
        a = jnp.where(causal, jnp.exp(jax.nn.log_sigmoid(z) + tail), 0.0)
        outs.append(jnp.einsum('bhqk,bkhd->bqhd', a.astype(v.dtype), v[:, :hi]))
    o = jnp.concatenate(outs, axis=1).reshape(b, s, SB_HEADS * SB_HEAD_DIM)
    return o @ w_o


def mla_shared_kv(x, positions, kv_norm_g, w_dkv, kv_latent_g, w_ukv):
    b, s, _ = x.shape
    h = rmsnorm(x, kv_norm_g)
    ckv = h @ w_dkv
    c = rmsnorm(ckv[..., :KV_LORA], kv_latent_g)
    k_rope = rope(ckv[..., None, KV_LORA:], positions)[:, :, 0, :]
    kv = (c @ w_ukv).reshape(b, s, MLA_HEADS, QK_NOPE + V_HEAD)
    return kv[..., :QK_NOPE], k_rope, kv[..., QK_NOPE:]


def mla_attention(h, positions, k_nope, k_rope, v, w_dq, q_latent_g, w_uq, w_o):
    b, s, _ = h.shape
    cq = rmsnorm(h @ w_dq, q_latent_g)
    q = (cq @ w_uq).reshape(b, s, MLA_HEADS, QK_NOPE + QK_ROPE)
    q_nope = q[..., :QK_NOPE]
    q_rope = rope(q[..., QK_NOPE:], positions)
    scale = (QK_NOPE + QK_ROPE) ** -0.5
    outs = []
    for i in range(s // BLOCK_Q):
        lo, hi = i * BLOCK_Q, (i + 1) * BLOCK_Q
        sc = (jnp.einsum('bqhd,bkhd->bhqk', q_nope[:, lo:hi], k_nope[:, :hi])
              + jnp.einsum('bqhr,bkr->bhqk', q_rope[:, lo:hi], k_rope[:, :hi])).astype(jnp.float32) * scale
        causal = jnp.arange(hi)[None, :] <= jnp.arange(lo, hi)[:, None]
        p = jax.nn.softmax(jnp.where(causal, sc, -jnp.inf), axis=-1)
        outs.append(jnp.einsum('bhqk,bkhd->bqhd', p.astype(v.dtype), v[:, :hi]))
    o = jnp.concatenate(outs, axis=1).reshape(b, s, MLA_HEADS * V_HEAD)
    return o @ w_o


def peer_ffn(h, w_q, keys_1, keys_2, expert_u, expert_v):
    b, s, d = h.shape
    q = (h @ w_q).reshape(b, s, PEER_HEADS, 2, PEER_HALF)
    s1 = jnp.einsum('bshd,hkd->bshk', q[..., 0, :], keys_1).astype(jnp.float32)
    s2 = jnp.einsum('bshd,hkd->bshk', q[..., 1, :], keys_2).astype(jnp.float32)
    v1, i1 = lax.top_k(s1, PEER_TOPK)
    v2, i2 = lax.top_k(s2, PEER_TOPK)
    cand_sc = (v1[..., :, None] + v2[..., None, :]).reshape(b, s, PEER_HEADS, PEER_TOPK * PEER_TOPK)
    cand_id = (i1[..., :, None] * N_KEYS + i2[..., None, :]).reshape(b, s, PEER_HEADS, PEER_TOPK * PEER_TOPK)
    top_sc, pos = lax.top_k(cand_sc, PEER_TOPK)
    ids = jnp.take_along_axis(cand_id, pos, axis=-1)
    g = jax.nn.softmax(top_sc, axis=-1).astype(h.dtype)
    n_sel = PEER_HEADS * PEER_TOPK
    n_chunks = (b * s) // PEER_CHUNK
    hc = h.reshape(n_chunks, PEER_CHUNK, d)
    idc = ids.reshape(n_chunks, PEER_CHUNK, n_sel)
    gc = g.reshape(n_chunks, PEER_CHUNK, n_sel)

    def chunk_fn(args):
        hx, idx, gx = args
        u = jnp.take(expert_u, idx, axis=0)
        act = jax.nn.gelu(jnp.einsum('ced,cd->ce', u, hx), approximate=False)
        vv = jnp.take(expert_v, idx, axis=0)
        return jnp.einsum('ce,ced->cd', gx * act, vv)

    out = lax.map(chunk_fn, (hc, idc, gc))
    return out.reshape(b, s, d)


def setup_inputs(seed: int = 0) -> dict:
    key = jax.random.key(seed)
    ks = jax.random.split(key, 24)

    def nrm(k, shape, scale):
        return jax.random.normal(k, shape, jnp.float32) * scale

    def gain(k, shape):
        return 1.0 + 0.01 * jax.random.normal(k, shape, jnp.float32)

    x = jax.random.normal(ks[0], (BATCH, SEQ, D_MODEL), jnp.float32)
    offsets = jax.random.randint(ks[1], (BATCH, 1), 0, 1024, dtype=jnp.int32)
    positions = (jnp.arange(SEQ, dtype=jnp.int32)[None, :] + offsets).astype(jnp.int32)
    return {
        'x': x,
        'positions': positions,
        'sb_norm_g': gain(ks[2], (N_A_LAYERS, D_MODEL)),
        'sb_w_qkv': nrm(ks[3], (N_A_LAYERS, D_MODEL, 3 * SB_HEADS * SB_HEAD_DIM), D_MODEL ** -0.5),
        'sb_w_o': nrm(ks[4], (N_A_LAYERS, SB_HEADS * SB_HEAD_DIM, D_MODEL), (SB_HEADS * SB_HEAD_DIM) ** -0.5),
        'kv_norm_g': gain(ks[5], (D_MODEL,)),
        'mla_w_dkv': nrm(ks[6], (D_MODEL, KV_LORA + QK_ROPE), D_MODEL ** -0.5),
        'mla_kv_latent_g': gain(ks[7], (KV_LORA,)),
        'mla_w_ukv': nrm(ks[8], (KV_LORA, MLA_HEADS * (QK_NOPE + V_HEAD)), KV_LORA ** -0.5),
        'mla_norm_g': gain(ks[9], (N_B_LAYERS, D_MODEL)),
        'mla_w_dq': nrm(ks[10], (N_B_LAYERS, D_MODEL, Q_LORA), D_MODEL ** -0.5),
        'mla_q_latent_g': gain(ks[11], (N_B_LAYERS, Q_LORA)),
        'mla_w_uq': nrm(ks[12], (N_B_LAYERS, Q_LORA, MLA_HEADS * (QK_NOPE + QK_ROPE)), Q_LORA ** -0.5),
        'mla_w_o': nrm(ks[13], (N_B_LAYERS, MLA_HEADS * V_HEAD, D_MODEL), (MLA_HEADS * V_HEAD) ** -0.5),
        'peer_norm_g': gain(ks[14], (DEPTH, D_MODEL)),
        'peer_w_q': nrm(ks[15], (DEPTH, D_MODEL, PEER_HEADS * PEER_KEY_DIM), D_MODEL ** -0.5),
        'peer_keys_1': nrm(ks[16], (DEPTH, PEER_HEADS, N_KEYS, PEER_HALF), PEER_HALF ** -0.5),
        'peer_keys_2': nrm(ks[17], (DEPTH, PEER_HEADS, N_KEYS, PEER_HALF), PEER_HALF ** -0.5),
        'peer_u': nrm(ks[18], (DEPTH, N_EXPERTS, D_MODEL), D_MODEL ** -0.5),
        'peer_v': nrm(ks[19], (DEPTH, N_EXPERTS, D_MODEL), PEER_HEADS ** -0.5),
        'final_norm_g': gain(ks[20], (D_MODEL,)),
    }


def reference(x, positions, sb_norm_g, sb_w_qkv, sb_w_o, kv_norm_g, mla_w_dkv, mla_kv_latent_g,
              mla_w_ukv, mla_norm_g, mla_w_dq, mla_q_latent_g, mla_w_uq, mla_w_o, peer_norm_g,
              peer_w_q, peer_keys_1, peer_keys_2, peer_u, peer_v, final_norm_g):
    k_nope = k_rope = v_shared = None
    for layer in range(DEPTH):
        if layer < N_A_LAYERS:
            x = x + stick_breaking_attention(rmsnorm(x, sb_norm_g[layer]), sb_w_qkv[layer], sb_w_o[layer])
        else:
            if layer == N_A_LAYERS:
                k_nope, k_rope, v_shared = mla_shared_kv(x, positions, kv_norm_g, mla_w_dkv,
                                                         mla_kv_latent_g, mla_w_ukv)
            j = layer - N_A_LAYERS
            x = x + mla_attention(rmsnorm(x, mla_norm_g[j]), positions, k_nope, k_rope, v_shared,
                                  mla_w_dq[j], mla_q_latent_g[j], mla_w_uq[j], mla_w_o[j])
        x = x + peer_ffn(rmsnorm(x, peer_norm_g[layer]), peer_w_q[layer], peer_keys_1[layer],
                         peer_keys_2[layer], peer_u[layer], peer_v[layer])
    return rmsnorm(x, final_norm_g)
```

```cpp
#include <hip/hip_runtime.h>
#include <cstdio>
#include <cstdint>

#ifndef MK_ONE_LAUNCH
#define MK_ONE_LAUNCH 0
#endif

#define LAS __attribute__((address_space(3)))
#define GAS __attribute__((address_space(1)))
typedef unsigned short bf16_t;
typedef short bf16x8 __attribute__((ext_vector_type(8)));
typedef short s16x4 __attribute__((ext_vector_type(4)));
typedef float f32x2 __attribute__((ext_vector_type(2)));
typedef float f32x4 __attribute__((ext_vector_type(4)));
typedef float f32x16 __attribute__((ext_vector_type(16)));
typedef unsigned u32x2 __attribute__((ext_vector_type(2)));
typedef unsigned u32x4 __attribute__((ext_vector_type(4)));

constexpr int NB = 8, SEQ = 4096, DM = 2048, T = NB * SEQ, NH = 16, HD = 128;
constexpr int KVL = 512, QKR = 64, QL = 512, NEXP = 16384, PH = 8, NKEYS = 128, TOPK = 16, NSEL = PH * TOPK;
constexpr int NDKQ = 1280;
constexpr float EPS = 1e-6f;
constexpr float LOG2E = 1.4426950408889634f;
constexpr int NWAVES = 8, NTHR = 512;

constexpr size_t MiB = 1u << 20;
constexpr size_t WS_CTL = 0, CTL_ZERO_BYTES = 1 * MiB;
constexpr size_t WS_RSTD = 1 * MiB;
constexpr size_t WS_CS = 2 * MiB;
constexpr size_t WS_WQKV = 16 * MiB;
constexpr size_t WS_WO = 40 * MiB;
constexpr size_t WS_WDKQ = 48 * MiB;
constexpr size_t WS_WUKV = 54 * MiB;
constexpr size_t WS_WUQ = 58 * MiB;
constexpr size_t WS_WMO = 62 * MiB;
constexpr size_t WS_WPQ = 70 * MiB;
constexpr size_t WS_KBD = 86 * MiB;
constexpr size_t WS_TU = 96 * MiB;
constexpr size_t WS_TV = 160 * MiB;
constexpr size_t WS_CB = 96 * MiB;
constexpr size_t WS_CQB = 128 * MiB;
constexpr size_t WS_XB = 224 * MiB;
constexpr size_t WS_R0 = 352 * MiB;
constexpr size_t WS_Q = WS_R0, WS_K = WS_R0 + 128 * MiB, WS_V = WS_R0 + 256 * MiB;
constexpr size_t WS_KN = WS_R0, WS_VM = WS_R0 + 128 * MiB, WS_QM = WS_R0 + 256 * MiB;
constexpr size_t WS_KR = WS_R0 + 448 * MiB;
constexpr size_t WS_QP = WS_R0, WS_SC = WS_R0 + 128 * MiB, WS_IDS = WS_R0 + 384 * MiB, WS_GATE = WS_R0 + 400 * MiB;
constexpr size_t WS_DKQ = WS_R0 + 256 * MiB;
constexpr size_t WS_END = WS_R0 + 452 * MiB;

constexpr int CW_TMO = 0, CW_CHK = 2, CW_BAR = 4096;

__device__ __forceinline__ unsigned f2bf(float f) { unsigned u = __builtin_bit_cast(unsigned, f); return (u + 0x7fffu + ((u >> 16) & 1u)) >> 16; }
__device__ __forceinline__ unsigned pk2(float lo, float hi) { return f2bf(lo) | (f2bf(hi) << 16); }
__device__ __forceinline__ float bflo(unsigned w) { return __builtin_bit_cast(float, w << 16); }
__device__ __forceinline__ float bfhi(unsigned w) { return __builtin_bit_cast(float, w & 0xffff0000u); }
__device__ __forceinline__ float bf2f(bf16_t h) { return __builtin_bit_cast(float, (unsigned)h << 16); }
__device__ __forceinline__ unsigned cvtpk(float lo, float hi) { unsigned r; asm volatile("v_cvt_pk_bf16_f32 %0, %1, %2" : "=v"(r) : "v"(lo), "v"(hi)); return r; }
__device__ __forceinline__ float wave_sum(float v) {
#pragma unroll
    for (int o = 1; o < 64; o <<= 1) v += __shfl_xor(v, o);
    return v;
}
__device__ __forceinline__ unsigned wave_max_u32(unsigned v) {
#pragma unroll
    for (int o = 1; o < 64; o <<= 1) { unsigned w = (unsigned)__shfl_xor((int)v, o); v = v > w ? v : w; }
    return v;
}
__device__ __forceinline__ int lane_id_v() { int l; asm volatile("v_mbcnt_lo_u32_b32 %0, -1, 0\n\tv_mbcnt_hi_u32_b32 %0, -1, %0" : "=v"(l)); return l; }
#define LDS_WAIT() asm volatile("s_waitcnt lgkmcnt(0)" ::: "memory")
#define VM_WAIT() asm volatile("s_waitcnt vmcnt(0)" ::: "memory")
#define SBAR() __builtin_amdgcn_sched_barrier(0)

namespace pg8 {
constexpr int BM = 256, BK = 64, HALF = 128, HTB = HALF * BK * 2, STAGE_BYTES = 8 * HTB, NXCD = 8, WGM = 8;
__host__ __device__ __forceinline__ int lds_byte(int r, int c) { const int st = (r >> 4) * 2 + (c >> 5), rr = r & 15, cc = c & 31, ob = rr * 64 + cc * 2; return st * 1024 + (ob ^ (((ob >> 9) & 1) << 5)); }
__host__ __device__ __forceinline__ void stage_rc(int b, int& R, int& C) { const int st = b / 1024, sb = b % 1024, swz = sb ^ (((sb >> 9) & 1) << 5); R = (st >> 1) * 16 + swz / 64; C = (st & 1) * 32 + (swz % 64) / 2; }
__host__ __device__ __forceinline__ int perm32(int rho) { const int n = rho >> 4, i = rho & 15; return 8 * (i >> 2) + 4 * n + (i & 3); }
struct Unit { int pm, pn; };
struct Gemm { const bf16_t* A; const bf16_t* Bt; int M, N, K, lda, a_pn; };
struct StaticOrder {
    int nM, nN, nwg, G, c;
    __device__ void init(int M, int N, int G_, int c_) { nM = M / BM; nN = N / BM; nwg = nM * nN; G = G_; c = c_; }
    __device__ bool next(int i, Unit& u) const {
        const long L = (long)i * G + c; if (L >= nwg) return false;
        int wgid = (int)L; { const int q = nwg / NXCD, r = nwg % NXCD, xcd = wgid % NXCD, off = wgid / NXCD; wgid = (xcd < r ? xcd * (q + 1) : r * (q + 1) + (xcd - r) * q) + off; }
        const int nig = WGM * nN, gid = wgid / nig, fm = gid * WGM, gsz = (nM - fm) < WGM ? (nM - fm) : WGM;
        u.pm = fm + ((wgid % nig) % gsz); u.pn = (wgid % nig) / gsz; return true;
    }
};
struct EpiQKV {
    static constexpr bool PERM = true;
    bf16_t* Q; size_t split_stride; const float* rstd; float qscale;
    __device__ __forceinline__ void operator()(const f32x4 (&acc)[2][2][4][2], const Unit& u, int wr, int wc, int fr, int fq) const {
        const int row0 = u.pm * BM + wr * 64 + fr; int colt = u.pn * BM; const int t = colt / DM; bf16_t* base = Q + (size_t)t * split_stride; colt -= t * DM;
        const float sc = t == 0 ? qscale : 1.f; const int col0 = colt + wc * 32 + 8 * fq;
#pragma unroll
        for (int ai = 0; ai < 2; ++ai)
#pragma unroll
            for (int m = 0; m < 4; ++m) { const int row = row0 + ai * HALF + m * 16; const float rs = rstd[row] * sc; bf16_t* rowp = base + (size_t)row * DM + col0;
#pragma unroll
                for (int bj = 0; bj < 2; ++bj) { const f32x4 v0 = acc[ai][bj][m][0] * rs, v1 = acc[ai][bj][m][1] * rs;
                    u32x4 w; w.x = cvtpk(v0[0], v0[1]); w.y = cvtpk(v0[2], v0[3]); w.z = cvtpk(v1[0], v1[1]); w.w = cvtpk(v1[2], v1[3]);
                    *(u32x4*)(rowp + bj * HALF) = w; } }
    }
};
struct EpiB16 {
    static constexpr bool PERM = true;
    bf16_t* O; int ldc; const float* rstd;
    __device__ __forceinline__ void operator()(const f32x4 (&acc)[2][2][4][2], const Unit& u, int wr, int wc, int fr, int fq) const {
        const int row0 = u.pm * BM + wr * 64 + fr, col0 = u.pn * BM + wc * 32 + 8 * fq;
#pragma unroll
        for (int ai = 0; ai < 2; ++ai)
#pragma unroll
            for (int m = 0; m < 4; ++m) { const int row = row0 + ai * HALF + m * 16; const float rs = rstd ? rstd[row] : 1.f; bf16_t* rowp = O + (size_t)row * ldc + col0;
#pragma unroll
                for (int bj = 0; bj < 2; ++bj) { const f32x4 v0 = acc[ai][bj][m][0] * rs, v1 = acc[ai][bj][m][1] * rs;
                    u32x4 w; w.x = cvtpk(v0[0], v0[1]); w.y = cvtpk(v0[2], v0[3]); w.z = cvtpk(v1[0], v1[1]); w.w = cvtpk(v1[2], v1[3]);
                    *(u32x4*)(rowp + bj * HALF) = w; } }
    }
};
struct EpiUKV {
    static constexpr bool PERM = true;
    bf16_t* KN; bf16_t* VM; const float* rstd;
    __device__ __forceinline__ void operator()(const f32x4 (&acc)[2][2][4][2], const Unit& u, int wr, int wc, int fr, int fq) const {
        const int row0 = u.pm * BM + wr * 64 + fr, col0 = u.pn * HD + wc * 32 + 8 * fq;
#pragma unroll
        for (int ai = 0; ai < 2; ++ai)
#pragma unroll
            for (int m = 0; m < 4; ++m) { const int row = row0 + ai * HALF + m * 16; const float rs = rstd ? rstd[row] : 1.f;
#pragma unroll
                for (int bj = 0; bj < 2; ++bj) { const f32x4 v0 = acc[ai][bj][m][0] * rs, v1 = acc[ai][bj][m][1] * rs;
                    u32x4 w; w.x = cvtpk(v0[0], v0[1]); w.y = cvtpk(v0[2], v0[3]); w.z = cvtpk(v1[0], v1[1]); w.w = cvtpk(v1[2], v1[3]);
                    *(u32x4*)((bj ? VM : KN) + (size_t)row * DM + col0) = w; } }
    }
};
struct EpiF32 {
    static constexpr bool PERM = false;
    float* C; int ldc; const float* rstd;
    __device__ __forceinline__ void operator()(const f32x4 (&acc)[2][2][4][2], const Unit& u, int wr, int wc, int fr, int fq) const {
        const int row0 = u.pm * BM + wr * 64 + fr, col0 = u.pn * BM + wc * 32 + 4 * fq;
#pragma unroll
        for (int ai = 0; ai < 2; ++ai)
#pragma unroll
            for (int m = 0; m < 4; ++m) { const int row = row0 + ai * HALF + m * 16; const float rs = rstd ? rstd[row] : 1.f; float* rowp = C + (size_t)row * ldc + col0;
#pragma unroll
                for (int bj = 0; bj < 2; ++bj)
#pragma unroll
                    for (int n = 0; n < 2; ++n) *(f32x4*)(rowp + bj * HALF + n * 16) = acc[ai][bj][m][n] * rs; }
    }
};
struct EpiRes {
    static constexpr bool PERM = false;
    float* C; const float* base; int ldc;
    __device__ __forceinline__ void operator()(const f32x4 (&acc)[2][2][4][2], const Unit& u, int wr, int wc, int fr, int fq) const {
        const int row0 = u.pm * BM + wr * 64 + fr, col0 = u.pn * BM + wc * 32 + 4 * fq;
#pragma unroll
        for (int ai = 0; ai < 2; ++ai)
#pragma unroll
            for (int m = 0; m < 4; ++m) { const size_t ro = (size_t)(row0 + ai * HALF + m * 16) * ldc + col0;
#pragma unroll
                for (int bj = 0; bj < 2; ++bj)
#pragma unroll
                    for (int n = 0; n < 2; ++n) { const f32x4 b = *(const f32x4*)(base + ro + bj * HALF + n * 16); *(f32x4*)(C + ro + bj * HALF + n * 16) = acc[ai][bj][m][n] + b; } }
    }
};

template <class Epi>
__device__ __forceinline__ void gemm_phase(LAS unsigned char* lds, const Gemm g, const StaticOrder& S, const Epi& E, const int wid, const int lane) {
    const int tid = wid * 64 + lane, wr = wid >> 2, wc = wid & 3, fr = lane & 15, fq = lane >> 4;
    const int K = g.K, nt = K / BK, lda = g.lda;
    unsigned voffA[2], voffB[2];
#pragma unroll
    for (int i = 0; i < 2; ++i) { int R, C; stage_rc(tid * 16 + i * 8192, R, C); const int Rb = Epi::PERM ? ((R & ~31) + perm32(R & 31)) : R;
        voffA[i] = (unsigned)(R * lda + C) * 2u; voffB[i] = (unsigned)(Rb * K + C) * 2u; }
    const size_t kstep = (size_t)(BK * 2);
    const size_t hstepA = (size_t)HALF * lda * 2, hstepB = (size_t)HALF * K * 2;
    const size_t tstepA = 2 * hstepA, tstepB = 2 * hstepB;
    const unsigned ldsw = (unsigned)wid * 1024u;
    const int aoff = lds_byte(wr * 64 + fr, fq * 8), boff = lds_byte(wc * 32 + fr, fq * 8);
#define PG8_SA(b, h) (((b) * 2 + (h)) * HTB)
#define PG8_SB(b, h) ((4 + (b) * 2 + (h)) * HTB)
#define PG8_STAGE(bufoff, gbase, voff) do { _Pragma("unroll") for (int _i = 0; _i < 2; ++_i) \
        __builtin_amdgcn_global_load_lds((const unsigned*)((const char*)(gbase) + (voff)[_i]), (LAS unsigned*)(lds + (bufoff) + ldsw + _i * 8192), 16, 0, 0); } while (0)
#define PG8_LDA(dst, b, h) do { _Pragma("unroll") for (int m = 0; m < 4; ++m) _Pragma("unroll") for (int k = 0; k < 2; ++k) dst[m][k] = *(const LAS bf16x8*)(lds + PG8_SA(b, h) + aoff + m * 2048 + k * 1024); } while (0)
#define PG8_LDB(dst, b, h) do { _Pragma("unroll") for (int n = 0; n < 2; ++n) _Pragma("unroll") for (int k = 0; k < 2; ++k) dst[n][k] = *(const LAS bf16x8*)(lds + PG8_SB(b, h) + boff + n * 2048 + k * 1024); } while (0)
#define PG8_MMA(ai, bj, At, Bt) do { __builtin_amdgcn_s_setprio(1); _Pragma("unroll") for (int m = 0; m < 4; ++m) _Pragma("unroll") for (int n = 0; n < 2; ++n) _Pragma("unroll") for (int k = 0; k < 2; ++k) \
        acc[ai][bj][m][n] = __builtin_amdgcn_mfma_f32_16x16x32_bf16(Bt[n][k], At[m][k], acc[ai][bj][m][n], 0, 0, 0); __builtin_amdgcn_s_setprio(0); } while (0)
#define PG8_WAIT_V(n) asm volatile("s_waitcnt vmcnt(" #n ")" ::: "memory")
#define PG8_WAIT_L(n) asm volatile("s_waitcnt lgkmcnt(" #n ")" ::: "memory")
#define PG8_BAR __builtin_amdgcn_s_barrier()
#define PG8_SCHED __builtin_amdgcn_sched_barrier(0)
    Unit cur, nxt; int ui = 0;
    if (!S.next(0, cur)) return;
    f32x4 acc[2][2][4][2];
#pragma unroll
    for (int a = 0; a < 2; ++a)
#pragma unroll
        for (int b = 0; b < 2; ++b)
#pragma unroll
            for (int m = 0; m < 4; ++m)
#pragma unroll
                for (int n = 0; n < 2; ++n) acc[a][b][m][n] = (f32x4){0.f, 0.f, 0.f, 0.f};
    bf16x8 At[4][2], B0[2][2], B1[2][2];
    const char* cA = (const char*)g.A + (size_t)cur.pm * tstepA + (size_t)cur.pn * g.a_pn * 2; const char* cB = (const char*)g.Bt + (size_t)cur.pn * tstepB;
    PG8_STAGE(PG8_SB(0, 0), cB, voffB); PG8_STAGE(PG8_SB(0, 1), cB + hstepB, voffB); PG8_STAGE(PG8_SA(0, 0), cA, voffA); PG8_STAGE(PG8_SA(0, 1), cA + hstepA, voffA);
    if (wr == 1) PG8_BAR;
    PG8_WAIT_V(2); PG8_BAR;
    PG8_STAGE(PG8_SB(1, 0), cB + kstep, voffB); PG8_STAGE(PG8_SA(1, 0), cA + kstep, voffA); PG8_STAGE(PG8_SB(1, 1), cB + hstepB + kstep, voffB);
    PG8_WAIT_V(6); PG8_BAR;
#pragma unroll 1
    for (;;) {
        const bool has_next = S.next(ui + 1, nxt);
        const char* nA = has_next ? (const char*)g.A + (size_t)nxt.pm * tstepA + (size_t)nxt.pn * g.a_pn * 2 : cA; const char* nB = has_next ? (const char*)g.Bt + (size_t)nxt.pn * tstepB : cB;
#pragma unroll 1
        for (int t = 0; t < nt; t += 2) {
            const bool last = (t == nt - 2);
            const char* a1 = cA + (size_t)(t + 1) * kstep;
            const char* a2 = last ? nA : cA + (size_t)(t + 2) * kstep; const char* b2 = last ? nB : cB + (size_t)(t + 2) * kstep;
            const char* a3 = a2 + kstep; const char* b3 = b2 + kstep;
            PG8_LDB(B0, 0, 0); PG8_LDB(B1, 0, 1); PG8_SCHED; PG8_LDA(At, 0, 0); PG8_STAGE(PG8_SA(1, 1), a1 + hstepA, voffA);
            PG8_WAIT_V(8); PG8_WAIT_L(0); PG8_BAR; PG8_MMA(0, 0, At, B0); PG8_MMA(0, 1, At, B1); PG8_BAR; PG8_SCHED;
            PG8_LDA(At, 0, 1); PG8_STAGE(PG8_SB(0, 0), b2, voffB); PG8_STAGE(PG8_SB(0, 1), b2 + hstepB, voffB); PG8_STAGE(PG8_SA(0, 0), a2, voffA);
            PG8_WAIT_V(8); PG8_WAIT_L(0); PG8_BAR; PG8_MMA(1, 0, At, B0); PG8_MMA(1, 1, At, B1); PG8_BAR; PG8_SCHED;
            PG8_LDB(B0, 1, 0); PG8_LDB(B1, 1, 1); PG8_SCHED; PG8_LDA(At, 1, 0); PG8_STAGE(PG8_SA(0, 1), a2 + hstepA, voffA);
            PG8_WAIT_V(8); PG8_WAIT_L(0); PG8_BAR; PG8_MMA(0, 0, At, B0); PG8_MMA(0, 1, At, B1); PG8_BAR; PG8_SCHED;
            PG8_LDA(At, 1, 1); PG8_STAGE(PG8_SB(1, 0), b3, voffB); PG8_STAGE(PG8_SB(1, 1), b3 + hstepB, voffB); PG8_STAGE(PG8_SA(1, 0), a3, voffA);
            PG8_WAIT_V(8); PG8_WAIT_L(0); PG8_BAR; PG8_MMA(1, 0, At, B0); PG8_MMA(1, 1, At, B1); PG8_BAR; PG8_SCHED;
        }
        if (wr == 0) PG8_BAR;
        E(acc, cur, wr, wc, fr, fq);
        if (!has_next) break;
#pragma unroll
        for (int a = 0; a < 2; ++a)
#pragma unroll
            for (int b = 0; b < 2; ++b)
#pragma unroll
                for (int m = 0; m < 4; ++m)
#pragma unroll
                    for (int n = 0; n < 2; ++n) acc[a][b][m][n] = (f32x4){0.f, 0.f, 0.f, 0.f};
        cur = nxt; cA = nA; cB = nB; ++ui;
        if (wr == 1) PG8_BAR;
    }
    PG8_WAIT_V(0);
    PG8_BAR;
#undef PG8_SA
#undef PG8_SB
#undef PG8_STAGE
#undef PG8_LDA
#undef PG8_LDB
#undef PG8_MMA
#undef PG8_WAIT_V
#undef PG8_WAIT_L
#undef PG8_BAR
#undef PG8_SCHED
}
}

namespace att {
constexpr int SHM_V = 16384, SHM_K = 16384, SHM_R = 8192;
constexpr int OFF_V = 0, OFF_K = 2 * SHM_V, OFF_R = OFF_K + 2 * SHM_K, OFF_WS = OFF_R + 2 * SHM_R, LDS_BYTES = OFF_WS + NWAVES * 64 * 4;
#define KSWZ(row, colB) ((row) * 256 + ((colB) ^ (((row) & 7) << 4)))
#define RSWZ(row, colB) ((row) * 128 + ((colB) ^ (((row) & 7) << 4)))
__device__ __forceinline__ int v_st(int k, int c) { const int kk = (k & ~0xC) | ((k & 4) << 1) | ((k & 8) >> 1); return ((kk >> 3) * 4 + (c >> 5)) * 512 + ((kk & 7) * 32 + (c & 31)) * 2; }
__device__ __forceinline__ int v_rd_base(int lane) { return ((lane & 3) << 3) | (((lane >> 2) & 3) << 6) | (((lane >> 4) & 1) << 5) | (((lane >> 5) & 1) << 8); }
__device__ __forceinline__ int crow(int r, int hi) { return (r & 3) + 8 * (r >> 2) + 4 * hi; }
__device__ __forceinline__ float pl_sum(float x) { auto rr = __builtin_amdgcn_permlane32_swap(__float_as_uint(x), __float_as_uint(x), false, false); return __uint_as_float(rr[0]) + __uint_as_float(rr[1]); }
__device__ __forceinline__ float pl_max(float x) { auto rr = __builtin_amdgcn_permlane32_swap(__float_as_uint(x), __float_as_uint(x), false, false); return fmaxf(__uint_as_float(rr[0]), __uint_as_float(rr[1])); }

#define PK4(P, B_, OUT) do { unsigned a0 = cvtpk(P[B_+0], P[B_+1]), a1 = cvtpk(P[B_+2], P[B_+3]);                          \
        unsigned b0 = cvtpk(P[B_+4], P[B_+5]), b1 = cvtpk(P[B_+6], P[B_+7]);                                             \
        auto r0 = __builtin_amdgcn_permlane32_swap(a0, b0, false, false); auto r1 = __builtin_amdgcn_permlane32_swap(a1, b1, false, false); \
        u32x4 w = {r0[0], r1[0], r0[1], r1[1]}; OUT = __builtin_bit_cast(bf16x8, w); } while (0)

__device__ __forceinline__ void pv_tile(f32x16* o, unsigned vb, bf16x8 pa0, bf16x8 pa1, bf16x8 pa2, bf16x8 pa3) {
#define TRRD(dst, off) asm volatile("ds_read_b64_tr_b16 %0, %1 offset:%2" : "=&v"(dst) : "v"(vb), "i"(off) : "memory")
#define PV_D0(d0) do { s16x4 l0, l1, l2, l3, h0, h1, h2, h3; constexpr int b_ = (d0) * 512;   \
        TRRD(l0, b_); TRRD(h0, b_ + 2048); TRRD(l1, b_ + 4096); TRRD(h1, b_ + 6144); TRRD(l2, b_ + 8192); TRRD(h2, b_ + 10240); TRRD(l3, b_ + 12288); TRRD(h3, b_ + 14336); \
        asm volatile("s_waitcnt lgkmcnt(0)" ::: "memory"); SBAR();   \
        o[d0] = __builtin_amdgcn_mfma_f32_32x32x16_bf16(pa0, (bf16x8){l0[0], l0[1], l0[2], l0[3], h0[0], h0[1], h0[2], h0[3]}, o[d0], 0, 0, 0);   \
        o[d0] = __builtin_amdgcn_mfma_f32_32x32x16_bf16(pa1, (bf16x8){l1[0], l1[1], l1[2], l1[3], h1[0], h1[1], h1[2], h1[3]}, o[d0], 0, 0, 0);   \
        o[d0] = __builtin_amdgcn_mfma_f32_32x32x16_bf16(pa2, (bf16x8){l2[0], l2[1], l2[2], l2[3], h2[0], h2[1], h2[2], h2[3]}, o[d0], 0, 0, 0);   \
        o[d0] = __builtin_amdgcn_mfma_f32_32x32x16_bf16(pa3, (bf16x8){l3[0], l3[1], l3[2], l3[3], h3[0], h3[1], h3[2], h3[3]}, o[d0], 0, 0, 0); } while (0)
    PV_D0(0); PV_D0(1); PV_D0(2); PV_D0(3);
#undef PV_D0
#undef TRRD
}

__device__ __forceinline__ void sb_tile(f32x16& p0, f32x16& p1, float& R, int dq, int hi) {
    const float NEG = -__builtin_inff();
    asm volatile("" : "+v"(dq));
    float g[8];
#define SB_GRP(P, half, i) do { float Lv[4], zv[4];                                                                              \
        _Pragma("unroll") for (int jj = 0; jj < 4; ++jj) { const int c = jj + 8 * (i) + 32 * (half); const bool ok = dq >= c;  \
            const float z = fminf(P[4 * (i) + jj], 80.f); const float e = __builtin_amdgcn_exp2f(z);                               \
            const float sp = __builtin_amdgcn_logf(1.f + e); Lv[jj] = ok ? -sp : 0.f; zv[jj] = ok ? z : NEG; }                      \
        const float s3 = Lv[3], s2 = Lv[2] + s3, s1 = Lv[1] + s2, s0 = Lv[0] + s1;                                                \
        P[4 * (i) + 0] = zv[0] + s0; P[4 * (i) + 1] = zv[1] + s1; P[4 * (i) + 2] = zv[2] + s2; P[4 * (i) + 3] = zv[3] + s3;      \
        g[(half) * 4 + (i)] = s0; } while (0)
    SB_GRP(p0, 0, 0); SB_GRP(p0, 0, 1); SB_GRP(p0, 0, 2); SB_GRP(p0, 0, 3);
    SB_GRP(p1, 1, 0); SB_GRP(p1, 1, 1); SB_GRP(p1, 1, 2); SB_GRP(p1, 1, 3);
#undef SB_GRP
    float c[8], Tk[8];
#pragma unroll
    for (int k = 0; k < 8; ++k) c[k] = pl_sum(g[k]);
    Tk[7] = 0.f;
#pragma unroll
    for (int k = 6; k >= 0; --k) Tk[k] = Tk[k + 1] + c[k + 1];
    const float tot = Tk[0] + c[0];
#pragma unroll
    for (int k = 0; k < 8; ++k) { const float add = R + Tk[k] + (hi == 0 ? (c[k] - g[k]) : 0.f);
#pragma unroll
        for (int jj = 0; jj < 4; ++jj) { if (k < 4) p0[4 * k + jj] = __builtin_amdgcn_exp2f(p0[4 * k + jj] + add); else p1[4 * (k - 4) + jj] = __builtin_amdgcn_exp2f(p1[4 * (k - 4) + jj] + add); } }
    R += tot;
}

template <int MODE>
__device__ __forceinline__ void attn_unit(LAS unsigned char* lds, const bf16_t* Qp, int qpitch, const bf16_t* Kp, const bf16_t* Vp, int kvpitch,
                                          const bf16_t* Rp, const float* cs, bf16_t* Op, int opitch, int q0, const int wid, const int lane) {
    constexpr int NQF = MODE ? 12 : 8;
    constexpr float SCALE = 0.07216878364870323f;
    constexpr float C2 = LOG2E * SCALE, THR = 8.f;
    const int r32 = lane & 31, hi = lane >> 5;
    const int qrow = q0 + wid * 32 + r32;
    LAS unsigned char* V_lds = lds + OFF_V; LAS unsigned char* K_lds = lds + OFF_K; LAS unsigned char* R_lds = lds + OFF_R;
    LAS float* wsf = (LAS float*)(lds + OFF_WS) + wid * 64;
    bf16x8 qr[NQF];
#pragma unroll
    for (int d0 = 0; d0 < NQF; ++d0) qr[d0] = *(const bf16x8*)(Qp + (size_t)qrow * qpitch + d0 * 16 + hi * 8);
    if constexpr (MODE == 1) {
#pragma unroll
        for (int f = 0; f < 2; ++f) { const int ib = f * 16 + hi * 8; const float* csr = cs + (size_t)qrow * 64 + ib * 2;
            bf16x8 a = qr[8 + f], b = qr[10 + f];
#pragma unroll
            for (int j = 0; j < 8; ++j) { const float co = csr[2 * j], si = csr[2 * j + 1], x1 = bf2f((bf16_t)a[j]), x2 = bf2f((bf16_t)b[j]);
                a[j] = (short)f2bf(x1 * co - x2 * si); b[j] = (short)f2bf(x2 * co + x1 * si); }
            qr[8 + f] = a; qr[10 + f] = b; }
    }
    const int NT = q0 / 64 + 4;
    const unsigned vb0 = (unsigned)(size_t)(V_lds) + (unsigned)v_rd_base(lane);
    unsigned koff[2], voff[2], roff;
#pragma unroll
    for (int i = 0; i < 2; ++i) { const int p = (wid * 2 + i) * 64 + lane;
        { const int row = p >> 4, pc = p & 15; koff[i] = (unsigned)(row * kvpitch + ((pc ^ (row & 7)) * 8)); }
        { const int sub = p >> 5, w = p & 31, kk = (sub >> 2) * 8 + (w >> 2), c = (sub & 3) * 32 + (w & 3) * 8, k = (kk & ~0xC) | ((kk & 4) << 1) | ((kk & 8) >> 1); voff[i] = (unsigned)(k * kvpitch + c); } }
    { const int p = wid * 64 + lane, row = p >> 3, pc = p & 7; roff = (unsigned)(row * 64 + ((pc ^ (row & 7)) * 8)); }
#define TILE_OF(it) (MODE ? (it) : (NT - 1 - (it)))
#define STAGE(jt, bf) do { const size_t kb_ = (size_t)(jt) * 64 * kvpitch;                                                                                   \
        _Pragma("unroll") for (int i_ = 0; i_ < 2; ++i_) {                                                                                                   \
            __builtin_amdgcn_global_load_lds((const unsigned*)(Kp + kb_ + koff[i_]), (LAS unsigned*)(K_lds + (bf) * SHM_K + (wid * 2 + i_) * 1024), 16, 0, 0);   \
            __builtin_amdgcn_global_load_lds((const unsigned*)(Vp + kb_ + voff[i_]), (LAS unsigned*)(V_lds + (bf) * SHM_V + (wid * 2 + i_) * 1024), 16, 0, 0); } \
        if constexpr (MODE == 1) __builtin_amdgcn_global_load_lds((const unsigned*)(Rp + (size_t)(jt) * 64 * 64 + roff), (LAS unsigned*)(R_lds + (bf) * SHM_R + wid * 1024), 16, 0, 0); } while (0)
    float m_reg = -1e30f, l_reg = 0.f, Rrun = 0.f; f32x16 o[4];
#pragma unroll
    for (int d = 0; d < 4; ++d) o[d] = f32x16{};
    STAGE(TILE_OF(0), 0);
    __syncthreads();
    for (int it = 0; it < NT; ++it) {
        const int buf = it & 1, jt = TILE_OF(it), k0 = jt * 64;
        if (it + 1 < NT) STAGE(TILE_OF(it + 1), buf ^ 1);
        f32x16 p0 = f32x16{}, p1 = f32x16{};
        {
            LAS unsigned char* kb = K_lds + buf * SHM_K;
#pragma unroll
            for (int d0 = 0; d0 < 8; ++d0) { LAS unsigned char* a = kb + KSWZ(r32, ((d0 & 3) * 16 + hi * 8) * 2) + (d0 >> 2) * 128;
                const bf16x8 b0 = *(LAS bf16x8*)a, b1 = *(LAS bf16x8*)(a + 32 * 256);
                p0 = __builtin_amdgcn_mfma_f32_32x32x16_bf16(b0, qr[d0], p0, 0, 0, 0);
                p1 = __builtin_amdgcn_mfma_f32_32x32x16_bf16(b1, qr[d0], p1, 0, 0, 0); }
            if constexpr (MODE == 1) {
                LAS unsigned char* rb = R_lds + buf * SHM_R;
#pragma unroll
                for (int d0 = 0; d0 < 4; ++d0) { LAS unsigned char* a = rb + RSWZ(r32, (d0 * 16 + hi * 8) * 2);
                    const bf16x8 b0 = *(LAS bf16x8*)a, b1 = *(LAS bf16x8*)(a + 32 * 128);
                    p0 = __builtin_amdgcn_mfma_f32_32x32x16_bf16(b0, qr[8 + d0], p0, 0, 0, 0);
                    p1 = __builtin_amdgcn_mfma_f32_32x32x16_bf16(b1, qr[8 + d0], p1, 0, 0, 0); }
            }
        }
        bf16x8 pa0, pa1, pa2, pa3;
        if constexpr (MODE == 0) {
            sb_tile(p0, p1, Rrun, qrow - 1 - k0 - 4 * hi, hi);
        } else {
            const float NEG = -__builtin_inff();
            if (k0 + 63 > q0 + wid * 32) {
                int dq = qrow - k0 - 4 * hi; asm volatile("" : "+v"(dq));
#pragma unroll
                for (int r = 0; r < 16; ++r) { const int c = (r & 3) + 8 * (r >> 2); if (dq < c) p0[r] = NEG; if (dq < c + 32) p1[r] = NEG; }
            }
            float pmax = p0[0];
#pragma unroll
            for (int r = 1; r < 16; ++r) pmax = fmaxf(pmax, p0[r]);
#pragma unroll
            for (int r = 0; r < 16; ++r) pmax = fmaxf(pmax, p1[r]);
            pmax = pl_max(pmax);
            float mn, alpha;
            if (__all((pmax - m_reg) * SCALE <= THR)) { mn = m_reg; alpha = 1.f; }
            else { mn = fmaxf(m_reg, pmax); alpha = __builtin_amdgcn_exp2f((m_reg - mn) * C2); m_reg = mn; }
            const float mnL = -mn * C2;
#pragma unroll
            for (int r = 0; r < 16; ++r) { p0[r] = __builtin_amdgcn_exp2f(fmaf(p0[r], C2, mnL)); p1[r] = __builtin_amdgcn_exp2f(fmaf(p1[r], C2, mnL)); }
            float ps = 0.f;
#pragma unroll
            for (int r = 0; r < 16; ++r) ps += p0[r] + p1[r];
            ps = pl_sum(ps);
            l_reg = l_reg * alpha + ps;
            if (__any(alpha < 1.f)) { if (hi == 0) wsf[r32] = alpha; LDS_WAIT();
#pragma unroll
                for (int r = 0; r < 16; ++r) { const float al = wsf[crow(r, hi)];
#pragma unroll
                    for (int d = 0; d < 4; ++d) o[d][r] *= al; } }
        }
        PK4(p0, 0, pa0); PK4(p0, 8, pa1); PK4(p1, 0, pa2); PK4(p1, 8, pa3);
        SBAR();
        pv_tile(o, vb0 + buf * SHM_V, pa0, pa1, pa2, pa3);
        __syncthreads();
    }
    if constexpr (MODE == 1) { if (hi == 0) wsf[r32] = l_reg; LDS_WAIT(); }
    GAS bf16_t* Ow = (GAS bf16_t*)(Op + (size_t)(q0 + wid * 32) * opitch); asm volatile("" : "+s"(Ow));
#pragma unroll
    for (int r = 0; r < 16; ++r) { const int orow = crow(r, hi); float inv = 1.f; if constexpr (MODE == 1) inv = __builtin_amdgcn_rcpf(wsf[orow]);
#pragma unroll
        for (int d0 = 0; d0 < 4; ++d0) { const float v = o[d0][r] * inv; const float vn = __shfl_xor(v, 1);
            if ((r32 & 1) == 0) *(GAS unsigned*)(Ow + (size_t)orow * opitch + d0 * 32 + r32) = pk2(v, vn); } }
    __syncthreads();
#undef TILE_OF
#undef STAGE
}
}

#define XB_TMO      128
#define XB_XCNT(j)  (256  + 64 * (j))
#define XB_XSUB(j)  (1280 + 64 * (j))
#define XB_XGEN(j)  (2304 + 64 * (j))
#define XB_TOP      3328
#define XB_TOPGEN   3392
#define XCD_BAR_WORDS 3456
#define XB_SPIN_CAP (1u << 22)
__device__ __forceinline__ unsigned xb_ld(unsigned* p)              { return __hip_atomic_load(p, __ATOMIC_RELAXED, __HIP_MEMORY_SCOPE_AGENT); }
__device__ __forceinline__ unsigned xb_add(unsigned* p, unsigned v) { return __hip_atomic_fetch_add(p, v, __ATOMIC_RELAXED, __HIP_MEMORY_SCOPE_AGENT); }
__device__ __forceinline__ unsigned xb_xcc_id() { return (unsigned)__builtin_amdgcn_s_getreg((3 << 11) | 20) & 0xFu; }
#define XB_SPIN(cond, bar) do { unsigned _sp = 0; while (cond) { __builtin_amdgcn_s_sleep(1); \
    if ((++_sp & 255u) == 0u) { if (xb_ld(&(bar)[XB_TMO])) break; if (_sp > XB_SPIN_CAP) { atomicAdd(&(bar)[XB_TMO], 1u); break; } } } } while (0)
struct XcdBarrier { unsigned* bar; unsigned x; volatile LAS unsigned* st; };
__device__ __forceinline__ XcdBarrier xcd_barrier_post(unsigned* bar, volatile LAS unsigned* st) {
    XcdBarrier b; b.bar = bar; b.x = xb_xcc_id(); b.st = st;
    if (threadIdx.x == 0) (void)xb_add(&bar[XB_XCNT(b.x)], 1u);
    return b;
}
__device__ __forceinline__ void xcd_barrier_complete(unsigned* bar, unsigned x, unsigned& nloc, unsigned& nx) {
    const unsigned G = gridDim.x * gridDim.y * gridDim.z;
    unsigned sum, cnt, mine, sp = 0u;
    for (;;) {
        sum = 0u; cnt = 0u; mine = 0u;
#pragma unroll
        for (unsigned j = 0; j < 16; ++j) { const unsigned c = xb_ld(&bar[XB_XCNT(j)]); sum += c; cnt += (c > 0u) ? 1u : 0u; mine = (j == x) ? c : mine; }
        if (sum == G) break;
        __builtin_amdgcn_s_sleep(1);
        if ((++sp & 255u) == 0u) { if (xb_ld(&bar[XB_TMO])) break; if (sp > XB_SPIN_CAP) { atomicAdd(&bar[XB_TMO], 1u); break; } }
    }
    nloc = mine > 0u ? mine : 1u; nx = cnt > 0u ? cnt : 1u;
}
__device__ __forceinline__ void xcd_barrier(const XcdBarrier& b, const int wave) {
    asm volatile("s_waitcnt vmcnt(0)" ::: "memory");
    __syncthreads();
    if (wave == 0 && lane_id_v() == 0) {
        unsigned* bar = b.bar;
        __builtin_amdgcn_s_waitcnt(0);
        unsigned nloc = b.st[0], nx = b.st[1];
        if (nloc == 0u) { xcd_barrier_complete(bar, b.x, nloc, nx); b.st[0] = nloc; b.st[1] = nx; }
        const unsigned old = xb_add(&bar[XB_XSUB(b.x)], 1u);
        const unsigned gen = old / nloc;
        if (old + 1u == (gen + 1u) * nloc) {
            __builtin_amdgcn_fence(__ATOMIC_RELEASE, "agent");
            asm volatile("s_waitcnt vmcnt(0)" ::: "memory");
            const unsigned og = xb_add(&bar[XB_TOP], 1u);
            const unsigned tg = og / nx;
            if (og + 1u == (tg + 1u) * nx) xb_add(&bar[XB_TOPGEN], 1u);
            else XB_SPIN(xb_ld(&bar[XB_TOPGEN]) == tg, bar);
            __builtin_amdgcn_fence(__ATOMIC_ACQUIRE, "agent");
            xb_add(&bar[XB_XGEN(b.x)], 1u);
            asm volatile("s_waitcnt vmcnt(0)" ::: "memory");
        } else {
            XB_SPIN(xb_ld(&bar[XB_XGEN(b.x)]) == gen, bar);
            __builtin_amdgcn_fence(__ATOMIC_ACQUIRE, "agent");
            asm volatile("s_waitcnt vmcnt(0)" ::: "memory");
        }
    }
    __syncthreads();
}

constexpr int RING_BYTES = 131072, MISC_OFF = RING_BYTES + 320, LDS_BYTES = 147456;
static_assert(att::LDS_BYTES <= RING_BYTES, "attention LDS");

struct Args { const void* in[21]; float* out; unsigned char* ws; int ph_lo, ph_hi; };
enum { IN_X = 0, IN_POS, IN_SBG, IN_WQKV, IN_WO, IN_KVG, IN_WDKV, IN_KVLG, IN_WUKV, IN_MLAG, IN_WDQ, IN_QLG, IN_WUQ, IN_WMO, IN_PG, IN_PWQ, IN_PK1, IN_PK2, IN_PU, IN_PV, IN_FG };

__device__ __forceinline__ void transpose_item(const float* W, int ldw, int K, int nblk, const float* gain, bf16_t* WT, int row_off, LAS float* scr, int item, int lane) {
    const int kb = item / nblk, nb = item % nblk, k0 = 64 * kb, n0 = 32 * nb;
#pragma unroll 8
    for (int i = 0; i < 32; ++i) { const int kk = 2 * i + (lane >> 5); const float gv = gain ? gain[k0 + kk] : 1.f; scr[kk * 33 + (lane & 31)] = W[(size_t)(k0 + kk) * ldw + n0 + (lane & 31)] * gv; }
    LDS_WAIT(); asm volatile("" ::: "memory");
    const int c = lane & 7;
#pragma unroll
    for (int j = 0; j < 4; ++j) { const int n = (lane >> 3) + 8 * j; const LAS float* s = scr + (8 * c) * 33 + n;
        u32x4 o; o.x = pk2(s[0 * 33], s[1 * 33]); o.y = pk2(s[2 * 33], s[3 * 33]); o.z = pk2(s[4 * 33], s[5 * 33]); o.w = pk2(s[6 * 33], s[7 * 33]);
        *(u32x4*)(WT + (size_t)(row_off + n0 + n) * K + k0 + 8 * c) = o; }
    LDS_WAIT(); asm volatile("" ::: "memory");
}
__device__ __forceinline__ void convert_tables(const float* u, const float* v, const float* g, bf16_t* TU, bf16_t* TV, int gtid, int gthreads) {
    const size_t n8 = (size_t)NEXP * DM / 8;
    for (size_t i = gtid; i < n8; i += gthreads) { const int d = (int)((i * 8) % DM);
        const f32x4 a0 = *(const f32x4*)(u + i * 8), a1 = *(const f32x4*)(u + i * 8 + 4), g0 = *(const f32x4*)(g + d), g1 = *(const f32x4*)(g + d + 4);
        u32x4 w; w.x = pk2(a0[0] * g0[0], a0[1] * g0[1]); w.y = pk2(a0[2] * g0[2], a0[3] * g0[3]); w.z = pk2(a1[0] * g1[0], a1[1] * g1[1]); w.w = pk2(a1[2] * g1[2], a1[3] * g1[3]);
        *(u32x4*)(TU + i * 8) = w;
        const f32x4 b0 = *(const f32x4*)(v + i * 8), b1 = *(const f32x4*)(v + i * 8 + 4);
        u32x4 x; x.x = pk2(b0[0], b0[1]); x.y = pk2(b0[2], b0[3]); x.z = pk2(b1[0], b1[1]); x.w = pk2(b1[2], b1[3]);
        *(u32x4*)(TV + i * 8) = x; }
}
__device__ __forceinline__ void row_to_bf16_rstd(const float* xrow, bf16_t* orow, float* rstd_out, int lane) {
    f32x4 v[8]; float s = 0.f;
#pragma unroll
    for (int j = 0; j < 8; ++j) { v[j] = *(const f32x4*)(xrow + j * 256 + lane * 4); s += v[j][0] * v[j][0] + v[j][1] * v[j][1] + v[j][2] * v[j][2] + v[j][3] * v[j][3]; }
    s = wave_sum(s);
#pragma unroll
    for (int j = 0; j < 8; ++j) { u32x2 w; w.x = pk2(v[j][0], v[j][1]); w.y = pk2(v[j][2], v[j][3]); *(u32x2*)(orow + j * 256 + lane * 4) = w; }
    if (lane == 0) *rstd_out = 1.f / sqrtf(s * (1.f / DM) + EPS);
}

#ifndef PH_MASK
#define PH_MASK 0xFFFFFu
#endif
#define IN(k) (lo <= (k) && (k) < hi)
#define SITE(b) (((PH_MASK) >> (b)) & 1u)
#define SEAM(k) do { if (IN(k) && IN((k) + 1)) xcd_barrier(bar, wave); } while (0)
#define PH_LOCALS const __attribute__((address_space(4))) Args* A_ = (const __attribute__((address_space(4))) Args*)__builtin_amdgcn_kernarg_segment_ptr(); asm volatile("" : "+s"(A_)); \
    unsigned char* ws = A_->ws; float* X = A_->out; float* rstd = (float*)(ws + WS_RSTD); float* cs = (float*)(ws + WS_CS); bf16_t* XB = (bf16_t*)(ws + WS_XB); const float* x_in = (const float*)A_->in[IN_X]; \
    const int lane = lane_id_v(), tid = wave * 64 + lane, gw = bx * NWAVES + wave, NGW = G * NWAVES, gtid = bx * NTHR + tid, gthreads = G * NTHR; \
    (void)X; (void)rstd; (void)cs; (void)XB; (void)x_in; (void)lane; (void)tid; (void)gw; (void)NGW; (void)gtid; (void)gthreads
#define AIN(k) (A_->in[k])

template <int layer>
__device__ __forceinline__ void peer_phases(LAS unsigned char* lds, const int lo, const int hi, const XcdBarrier& bar, const int wave, const int G, const int bx) {
    constexpr int pb = layer ? 15 : 4;
        if (SITE(4) && IN(pb)) { PH_LOCALS; const float* pg = (const float*)AIN(IN_PG) + (size_t)layer * DM;
            for (int m = gw; m < T; m += NGW) row_to_bf16_rstd(X + (size_t)m * DM, XB + (size_t)m * DM, rstd + m, lane);
            if (layer == 1) convert_tables((const float*)AIN(IN_PU) + (size_t)NEXP * DM, (const float*)AIN(IN_PV) + (size_t)NEXP * DM, pg, (bf16_t*)(ws + WS_TU), (bf16_t*)(ws + WS_TV), gtid, gthreads);
        }
        SEAM(pb);
        if (SITE(5) && IN(pb + 1)) { PH_LOCALS;
            pg8::Gemm g{XB, (const bf16_t*)(ws + WS_WPQ) + (size_t)layer * DM * DM, T, DM, DM, DM, 0}; pg8::StaticOrder S; S.init(T, DM, G, bx);
            pg8::EpiB16 E{(bf16_t*)(ws + WS_QP), DM, rstd};
            pg8::gemm_phase<pg8::EpiB16>(lds, g, S, E, wave, lane);
        }
        SEAM(pb + 1);
        if (SITE(6) && IN(pb + 2)) { PH_LOCALS;
            pg8::Gemm g{(const bf16_t*)(ws + WS_QP), (const bf16_t*)(ws + WS_KBD) + (size_t)layer * 2048 * 256, T, DM, 256, DM, 256}; pg8::StaticOrder S; S.init(T, DM, G, bx);
            pg8::EpiF32 E{(float*)(ws + WS_SC), DM, nullptr};
            pg8::gemm_phase<pg8::EpiF32>(lds, g, S, E, wave, lane);
        }
        SEAM(pb + 2);
        if (SITE(7) && IN(pb + 3)) { PH_LOCALS;
            const float* SC = (const float*)(ws + WS_SC); int* IDS = (int*)(ws + WS_IDS); float* GT = (float*)(ws + WS_GATE);
            for (int item = gw; item < T * PH; item += NGW) {
                const int t = item >> 3, hh = item & 7; const float* s = SC + (size_t)t * DM + hh * 256;
                unsigned ka[2], kb[2];
#pragma unroll
                for (int j = 0; j < 2; ++j) { const int idx = lane + 64 * j; unsigned ua = __float_as_uint(s[idx]), ub = __float_as_uint(s[128 + idx]);
                    ua ^= (ua >> 31) ? 0xffffffffu : 0x80000000u; ub ^= (ub >> 31) ? 0xffffffffu : 0x80000000u;
                    ka[j] = (ua & ~127u) | (unsigned)(127 - idx); kb[j] = (ub & ~127u) | (unsigned)(127 - idx); }
                unsigned my1 = 0u, my2 = 0u;
                for (int itx = 0; itx < TOPK; ++itx) {
                    unsigned m1 = wave_max_u32(ka[0] > ka[1] ? ka[0] : ka[1]); if (lane == itx) my1 = m1; if (ka[0] == m1) ka[0] = 0u; if (ka[1] == m1) ka[1] = 0u;
                    unsigned m2 = wave_max_u32(kb[0] > kb[1] ? kb[0] : kb[1]); if (lane == itx) my2 = m2; if (kb[0] == m2) kb[0] = 0u; if (kb[1] == m2) kb[1] = 0u;
                }
                auto dec = [](unsigned k) { unsigned u = k & ~127u; u ^= (u >> 31) ? 0x80000000u : 0xffffffffu; return __uint_as_float(u); };
                const float v1 = dec(my1), v2 = dec(my2);
                const float a1 = __shfl(v1, lane >> 2);
                unsigned kc[4];
#pragma unroll
                for (int jj = 0; jj < 4; ++jj) { const int j = (lane & 3) * 4 + jj; const float sum = a1 + __shfl(v2, j); unsigned us = __float_as_uint(sum); us ^= (us >> 31) ? 0xffffffffu : 0x80000000u;
                    kc[jj] = (us & ~255u) | (unsigned)(255 - (lane * 4 + jj)); }
                unsigned mysel = 0u;
                for (int itx = 0; itx < TOPK; ++itx) {
                    unsigned m = kc[0] > kc[1] ? kc[0] : kc[1]; unsigned m_ = kc[2] > kc[3] ? kc[2] : kc[3]; m = m > m_ ? m : m_;
                    m = wave_max_u32(m); if (lane == itx) mysel = m;
#pragma unroll
                    for (int jj = 0; jj < 4; ++jj) if (kc[jj] == m) kc[jj] = 0u;
                }
                const int cidx = 255 - (int)(mysel & 255u), ci = (cidx >> 4) & 15, cj = cidx & 15;
                const unsigned k1 = (unsigned)__shfl((int)my1, ci), k2 = (unsigned)__shfl((int)my2, cj);
                const int i1 = 127 - (int)(k1 & 127u), i2 = 127 - (int)(k2 & 127u);
                const float sc = dec(k1) + dec(k2);
                const float smax = __shfl(sc, 0);
                float e = (lane < TOPK) ? __expf(sc - smax) : 0.f;
                const float den = wave_sum(e);
                if (lane < TOPK) { IDS[(size_t)t * NSEL + hh * TOPK + lane] = i1 * NKEYS + i2; GT[(size_t)t * NSEL + hh * TOPK + lane] = e / den; }
            }
        }
        SEAM(pb + 3);
        if (SITE(8) && IN(pb + 4)) { PH_LOCALS;
            const bf16_t* TU = (const bf16_t*)(ws + WS_TU); const bf16_t* TV = (const bf16_t*)(ws + WS_TV);
            const int* IDS = (const int*)(ws + WS_IDS); const float* GT = (const float*)(ws + WS_GATE);
            const float* fg = (const float*)AIN(IN_FG);
            for (int t = gw; t < T; t += NGW) {
                float hf[32], acc[32];
#pragma unroll
                for (int j = 0; j < 4; ++j) { const u32x4 w = *(const u32x4*)(XB + (size_t)t * DM + j * 512 + lane * 8);
                    hf[j * 8 + 0] = bflo(w.x); hf[j * 8 + 1] = bfhi(w.x); hf[j * 8 + 2] = bflo(w.y); hf[j * 8 + 3] = bfhi(w.y); hf[j * 8 + 4] = bflo(w.z); hf[j * 8 + 5] = bfhi(w.z); hf[j * 8 + 6] = bflo(w.w); hf[j * 8 + 7] = bfhi(w.w); }
#pragma unroll
                for (int j = 0; j < 32; ++j) acc[j] = 0.f;
                const float rs = rstd[t];
                const int idv0 = IDS[(size_t)t * NSEL + lane], idv1 = IDS[(size_t)t * NSEL + 64 + lane];
                const float gv0 = GT[(size_t)t * NSEL + lane], gv1 = GT[(size_t)t * NSEL + 64 + lane];
                for (int e0 = 0; e0 < NSEL; e0 += 2) {
                    int id[2]; float gt[2];
#pragma unroll
                    for (int k = 0; k < 2; ++k) { const int e = e0 + k; id[k] = __builtin_amdgcn_readlane(e < 64 ? idv0 : idv1, e & 63); gt[k] = __uint_as_float(__builtin_amdgcn_readlane(__float_as_uint(e < 64 ? gv0 : gv1), e & 63)); }
                    u32x4 uw[2][4], vw[2][4];
#pragma unroll
                    for (int k = 0; k < 2; ++k)
#pragma unroll
                        for (int j = 0; j < 4; ++j) { uw[k][j] = *(const u32x4*)(TU + (size_t)id[k] * DM + j * 512 + lane * 8); vw[k][j] = *(const u32x4*)(TV + (size_t)id[k] * DM + j * 512 + lane * 8); }
#pragma unroll
                    for (int k = 0; k < 2; ++k) { float d = 0.f;
#pragma unroll
                        for (int j = 0; j < 4; ++j) { const u32x4 w = uw[k][j];
                            d = fmaf(hf[j * 8 + 0], bflo(w.x), d); d = fmaf(hf[j * 8 + 1], bfhi(w.x), d); d = fmaf(hf[j * 8 + 2], bflo(w.y), d); d = fmaf(hf[j * 8 + 3], bfhi(w.y), d);
                            d = fmaf(hf[j * 8 + 4], bflo(w.z), d); d = fmaf(hf[j * 8 + 5], bfhi(w.z), d); d = fmaf(hf[j * 8 + 6], bflo(w.w), d); d = fmaf(hf[j * 8 + 7], bfhi(w.w), d); }
                        d = wave_sum(d) * rs;
                        const float wgt = gt[k] * 0.5f * d * (1.f + erff(d * 0.7071067811865476f));
#pragma unroll
                        for (int j = 0; j < 4; ++j) { const u32x4 w = vw[k][j];
                            acc[j * 8 + 0] = fmaf(wgt, bflo(w.x), acc[j * 8 + 0]); acc[j * 8 + 1] = fmaf(wgt, bfhi(w.x), acc[j * 8 + 1]); acc[j * 8 + 2] = fmaf(wgt, bflo(w.y), acc[j * 8 + 2]); acc[j * 8 + 3] = fmaf(wgt, bfhi(w.y), acc[j * 8 + 3]);
                            acc[j * 8 + 4] = fmaf(wgt, bflo(w.z), acc[j * 8 + 4]); acc[j * 8 + 5] = fmaf(wgt, bfhi(w.z), acc[j * 8 + 5]); acc[j * 8 + 6] = fmaf(wgt, bflo(w.w), acc[j * 8 + 6]); acc[j * 8 + 7] = fmaf(wgt, bfhi(w.w), acc[j * 8 + 7]); } }
                }
                float ss = 0.f;
#pragma unroll
                for (int j = 0; j < 4; ++j) { float* xr = X + (size_t)t * DM + j * 512 + lane * 8; const f32x4 x0 = *(const f32x4*)xr, x1 = *(const f32x4*)(xr + 4);
#pragma unroll
                    for (int q = 0; q < 4; ++q) { acc[j * 8 + q] += x0[q]; acc[j * 8 + 4 + q] += x1[q]; }
#pragma unroll
                    for (int q = 0; q < 8; ++q) ss += acc[j * 8 + q] * acc[j * 8 + q]; }
                ss = wave_sum(ss);
                const float rn = 1.f / sqrtf(ss * (1.f / DM) + EPS);
                if (layer == 0) {
#pragma unroll
                    for (int j = 0; j < 4; ++j) { float* xr = X + (size_t)t * DM + j * 512 + lane * 8;
                        *(f32x4*)xr = (f32x4){acc[j * 8 + 0], acc[j * 8 + 1], acc[j * 8 + 2], acc[j * 8 + 3]}; *(f32x4*)(xr + 4) = (f32x4){acc[j * 8 + 4], acc[j * 8 + 5], acc[j * 8 + 6], acc[j * 8 + 7]};
                        u32x4 w; w.x = pk2(acc[j * 8 + 0], acc[j * 8 + 1]); w.y = pk2(acc[j * 8 + 2], acc[j * 8 + 3]); w.z = pk2(acc[j * 8 + 4], acc[j * 8 + 5]); w.w = pk2(acc[j * 8 + 6], acc[j * 8 + 7]);
                        *(u32x4*)(XB + (size_t)t * DM + j * 512 + lane * 8) = w; }
                    if (lane == 0) rstd[t] = rn;
                } else {
#pragma unroll
                    for (int j = 0; j < 4; ++j) { float* xr = X + (size_t)t * DM + j * 512 + lane * 8; const float* gp = fg + j * 512 + lane * 8; const f32x4 g0 = *(const f32x4*)gp, g1 = *(const f32x4*)(gp + 4);
                        *(f32x4*)xr = (f32x4){acc[j * 8 + 0] * rn * g0[0], acc[j * 8 + 1] * rn * g0[1], acc[j * 8 + 2] * rn * g0[2], acc[j * 8 + 3] * rn * g0[3]};
                        *(f32x4*)(xr + 4) = (f32x4){acc[j * 8 + 4] * rn * g1[0], acc[j * 8 + 5] * rn * g1[1], acc[j * 8 + 6] * rn * g1[2], acc[j * 8 + 7] * rn * g1[3]}; }
                }
            }
        }
}

__global__ void __launch_bounds__(NTHR, 2) fwd(Args args) {
    extern __shared__ __attribute__((aligned(16))) unsigned char lds_raw[];
    LAS unsigned char* lds = (LAS unsigned char*)lds_raw;
    volatile LAS unsigned* MISC = (volatile LAS unsigned*)(lds + MISC_OFF);
    const int wave = __builtin_amdgcn_readfirstlane(threadIdx.x >> 6);
    const int G = gridDim.x, bx = blockIdx.x;
    unsigned* ctl = (unsigned*)(args.ws + WS_CTL);
    for (int u = threadIdx.x; u < (LDS_BYTES - RING_BYTES) / 4; u += NTHR) ((LAS unsigned*)(lds + RING_BYTES))[u] = 0u;
    __syncthreads();
    XcdBarrier bar; bar.bar = ctl + CW_BAR; bar.x = 0; bar.st = nullptr;
    const int lo = args.ph_lo, hi = args.ph_hi;
    const bool multi = (hi - lo) > 1;
    if (multi) bar = xcd_barrier_post(ctl + CW_BAR, MISC + 8);

    if (SITE(0) && IN(0)) { PH_LOCALS;
        LAS float* scr = (LAS float*)(lds + wave * 16384);
        const float* sbg = (const float*)AIN(IN_SBG); const float* kvg = (const float*)AIN(IN_KVG); const float* mlag = (const float*)AIN(IN_MLAG);
        const float* kvlg = (const float*)AIN(IN_KVLG); const float* qlg = (const float*)AIN(IN_QLG); const float* pg = (const float*)AIN(IN_PG);
        constexpr int I_QKV = 32 * 192, I_WO = 32 * 64, I_DKV = 32 * 18, I_DQ = 32 * 16, I_UKV = 8 * 128, I_UQ = 8 * 96, I_MO = 32 * 64, I_PQ = 32 * 64;
        constexpr int NITEMS = I_QKV + I_WO + I_DKV + I_DQ + I_UKV + I_UQ + I_MO + 2 * I_PQ;
        for (int it = gw; it < NITEMS; it += NGW) {
            int r = it;
            if (r < I_QKV) { transpose_item((const float*)AIN(IN_WQKV), 6144, 2048, 192, sbg, (bf16_t*)(ws + WS_WQKV), 0, scr, r, lane); continue; } r -= I_QKV;
            if (r < I_WO) { transpose_item((const float*)AIN(IN_WO), 2048, 2048, 64, nullptr, (bf16_t*)(ws + WS_WO), 0, scr, r, lane); continue; } r -= I_WO;
            if (r < I_DKV) { transpose_item((const float*)AIN(IN_WDKV), 576, 2048, 18, kvg, (bf16_t*)(ws + WS_WDKQ), 0, scr, r, lane); continue; } r -= I_DKV;
            if (r < I_DQ) { transpose_item((const float*)AIN(IN_WDQ), 512, 2048, 16, mlag, (bf16_t*)(ws + WS_WDKQ), 576, scr, r, lane); continue; } r -= I_DQ;
            if (r < I_UKV) { transpose_item((const float*)AIN(IN_WUKV), 4096, 512, 128, kvlg, (bf16_t*)(ws + WS_WUKV), 0, scr, r, lane); continue; } r -= I_UKV;
            if (r < I_UQ) { transpose_item((const float*)AIN(IN_WUQ), 3072, 512, 96, qlg, (bf16_t*)(ws + WS_WUQ), 0, scr, r, lane); continue; } r -= I_UQ;
            if (r < I_MO) { transpose_item((const float*)AIN(IN_WMO), 2048, 2048, 64, nullptr, (bf16_t*)(ws + WS_WMO), 0, scr, r, lane); continue; } r -= I_MO;
            if (r < I_PQ) { transpose_item((const float*)AIN(IN_PWQ), 2048, 2048, 64, pg, (bf16_t*)(ws + WS_WPQ), 0, scr, r, lane); continue; } r -= I_PQ;
            transpose_item((const float*)AIN(IN_PWQ) + (size_t)DM * DM, 2048, 2048, 64, pg + DM, (bf16_t*)(ws + WS_WPQ) + (size_t)DM * DM, 0, scr, r, lane);
        }
        { u32x4 z = {0u, 0u, 0u, 0u}; bf16_t* p = (bf16_t*)(ws + WS_WDKQ) + (size_t)1088 * DM; for (int i = gtid; i < 192 * DM / 8; i += gthreads) *(u32x4*)(p + (size_t)i * 8) = z; }
        { const float* k1 = (const float*)AIN(IN_PK1); const float* k2 = (const float*)AIN(IN_PK2); bf16_t* kbd = (bf16_t*)(ws + WS_KBD);
          for (int i = gtid; i < 2 * 2048 * 256; i += gthreads) { const int kk = i & 255, n = (i >> 8) & 255, hh = (i >> 16) & 7, l = i >> 19; float v = 0.f;
              if (n < 128) { if (kk < 128) v = k1[(((size_t)l * PH + hh) * NKEYS + n) * 128 + kk]; } else { if (kk >= 128) v = k2[(((size_t)l * PH + hh) * NKEYS + (n - 128)) * 128 + (kk - 128)]; }
              kbd[i] = (bf16_t)f2bf(v); } }
        convert_tables((const float*)AIN(IN_PU), (const float*)AIN(IN_PV), pg, (bf16_t*)(ws + WS_TU), (bf16_t*)(ws + WS_TV), gtid, gthreads);
        for (int m = gw; m < T; m += NGW) row_to_bf16_rstd(x_in + (size_t)m * DM, XB + (size_t)m * DM, rstd + m, lane);
        { const int* pos = (const int*)AIN(IN_POS);
          for (int i = gtid; i < T * 32; i += gthreads) { const int t = i >> 5, j = i & 31; const float inv = powf(10000.f, -(float)(2 * j) / 64.f); const float ang = (float)pos[t] * inv;
              cs[2 * i] = cosf(ang); cs[2 * i + 1] = sinf(ang); } }
    }
    SEAM(0);

    {
        {
            if (SITE(1) && IN(1)) { PH_LOCALS;
                pg8::Gemm g{XB, (const bf16_t*)(ws + WS_WQKV), T, 3 * DM, DM, DM, 0}; pg8::StaticOrder S; S.init(T, 3 * DM, G, bx);
                pg8::EpiQKV E{(bf16_t*)(ws + WS_Q), (size_t)(WS_K - WS_Q) / 2, rstd, 0.08838834764831845f * LOG2E};
                pg8::gemm_phase<pg8::EpiQKV>(lds, g, S, E, wave, lane);
            }
            SEAM(1);
            if (SITE(2) && IN(2)) { PH_LOCALS;
                const int bh = bx >> 1, half = bx & 1, b = bh >> 4, h = bh & 15;
                if (bx < 256) {
                    const bf16_t* Qp = (const bf16_t*)(ws + WS_Q) + (size_t)b * SEQ * DM + h * HD; const bf16_t* Kp = (const bf16_t*)(ws + WS_K) + (size_t)b * SEQ * DM + h * HD;
                    const bf16_t* Vp = (const bf16_t*)(ws + WS_V) + (size_t)b * SEQ * DM + h * HD; bf16_t* Op = XB + (size_t)b * SEQ * DM + h * HD;
                    for (int i = 0; i < 8; ++i) { const int qb = 15 - (2 * i + ((i & 1) ^ half));
                        att::attn_unit<0>(lds, Qp, DM, Kp, Vp, DM, nullptr, nullptr, Op, DM, qb * 256, wave, lane); }
                }
            }
            SEAM(2);
            if (SITE(3) && IN(3)) { PH_LOCALS;
                pg8::Gemm g{XB, (const bf16_t*)(ws + WS_WO), T, DM, DM, DM, 0}; pg8::StaticOrder S; S.init(T, DM, G, bx);
                pg8::EpiRes E{X, x_in, DM};
                pg8::gemm_phase<pg8::EpiRes>(lds, g, S, E, wave, lane);
            }
            SEAM(3);
        }
        peer_phases<0>(lds, lo, hi, bar, wave, G, bx);
        SEAM(8);
        {
            if (SITE(9) && IN(9)) { PH_LOCALS;
                pg8::Gemm g{XB, (const bf16_t*)(ws + WS_WDKQ), T, NDKQ, DM, DM, 0}; pg8::StaticOrder S; S.init(T, NDKQ, G, bx);
                pg8::EpiF32 E{(float*)(ws + WS_DKQ), NDKQ, rstd};
                pg8::gemm_phase<pg8::EpiF32>(lds, g, S, E, wave, lane);
            }
            SEAM(9);
            if (SITE(10) && IN(10)) { PH_LOCALS;
                const float* dkq = (const float*)(ws + WS_DKQ); bf16_t* CB = (bf16_t*)(ws + WS_CB); bf16_t* CQB = (bf16_t*)(ws + WS_CQB); bf16_t* KR = (bf16_t*)(ws + WS_KR);
                for (int m = gw; m < T; m += NGW) { const float* r = dkq + (size_t)m * NDKQ;
                    const f32x4 a0 = *(const f32x4*)(r + lane * 8), a1 = *(const f32x4*)(r + lane * 8 + 4);
                    const f32x4 q0 = *(const f32x4*)(r + 576 + lane * 8), q1 = *(const f32x4*)(r + 576 + lane * 8 + 4);
                    float sa = a0[0] * a0[0] + a0[1] * a0[1] + a0[2] * a0[2] + a0[3] * a0[3] + a1[0] * a1[0] + a1[1] * a1[1] + a1[2] * a1[2] + a1[3] * a1[3];
                    float sq = q0[0] * q0[0] + q0[1] * q0[1] + q0[2] * q0[2] + q0[3] * q0[3] + q1[0] * q1[0] + q1[1] * q1[1] + q1[2] * q1[2] + q1[3] * q1[3];
                    sa = wave_sum(sa); sq = wave_sum(sq);
                    const float ra = 1.f / sqrtf(sa * (1.f / KVL) + EPS), rq = 1.f / sqrtf(sq * (1.f / QL) + EPS);
                    u32x4 w; w.x = pk2(a0[0] * ra, a0[1] * ra); w.y = pk2(a0[2] * ra, a0[3] * ra); w.z = pk2(a1[0] * ra, a1[1] * ra); w.w = pk2(a1[2] * ra, a1[3] * ra);
                    *(u32x4*)(CB + (size_t)m * KVL + lane * 8) = w;
                    u32x4 y; y.x = pk2(q0[0] * rq, q0[1] * rq); y.y = pk2(q0[2] * rq, q0[3] * rq); y.z = pk2(q1[0] * rq, q1[1] * rq); y.w = pk2(q1[2] * rq, q1[3] * rq);
                    *(u32x4*)(CQB + (size_t)m * QL + lane * 8) = y;
                    if (lane < 32) { const float x1 = r[512 + lane], x2 = r[512 + 32 + lane], co = cs[((size_t)m * 32 + lane) * 2], si = cs[((size_t)m * 32 + lane) * 2 + 1];
                        KR[(size_t)m * 64 + lane] = (bf16_t)f2bf(x1 * co - x2 * si); KR[(size_t)m * 64 + 32 + lane] = (bf16_t)f2bf(x2 * co + x1 * si); } }
            }
            SEAM(10);
            if (SITE(11) && IN(11)) { PH_LOCALS;
                pg8::Gemm g{(const bf16_t*)(ws + WS_CB), (const bf16_t*)(ws + WS_WUKV), T, 4096, KVL, KVL, 0}; pg8::StaticOrder S; S.init(T, 4096, G, bx);
                pg8::EpiUKV E{(bf16_t*)(ws + WS_KN), (bf16_t*)(ws + WS_VM), nullptr};
                pg8::gemm_phase<pg8::EpiUKV>(lds, g, S, E, wave, lane);
            }
            SEAM(11);
            if (SITE(12) && IN(12)) { PH_LOCALS;
                pg8::Gemm g{(const bf16_t*)(ws + WS_CQB), (const bf16_t*)(ws + WS_WUQ), T, 3072, QL, QL, 0}; pg8::StaticOrder S; S.init(T, 3072, G, bx);
                pg8::EpiB16 E{(bf16_t*)(ws + WS_QM), 3072, nullptr};
                pg8::gemm_phase<pg8::EpiB16>(lds, g, S, E, wave, lane);
            }
            SEAM(12);
            if (SITE(13) && IN(13)) { PH_LOCALS;
                const int bh = bx >> 1, half = bx & 1, b = bh >> 4, h = bh & 15;
                if (bx < 256) {
                    const bf16_t* Qp = (const bf16_t*)(ws + WS_QM) + (size_t)b * SEQ * 3072 + h * 192; const bf16_t* Kp = (const bf16_t*)(ws + WS_KN) + (size_t)b * SEQ * DM + h * HD;
                    const bf16_t* Vp = (const bf16_t*)(ws + WS_VM) + (size_t)b * SEQ * DM + h * HD; const bf16_t* Rp = (const bf16_t*)(ws + WS_KR) + (size_t)b * SEQ * 64;
                    bf16_t* Op = XB + (size_t)b * SEQ * DM + h * HD;
                    for (int i = 0; i < 8; ++i) { const int qb = 15 - (2 * i + ((i & 1) ^ half));
                        att::attn_unit<1>(lds, Qp, 3072, Kp, Vp, DM, Rp, cs + (size_t)b * SEQ * 64, Op, DM, qb * 256, wave, lane); }
                }
            }
            SEAM(13);
            if (SITE(14) && IN(14)) { PH_LOCALS;
                pg8::Gemm g{XB, (const bf16_t*)(ws + WS_WMO), T, DM, DM, DM, 0}; pg8::StaticOrder S; S.init(T, DM, G, bx);
                pg8::EpiRes E{X, X, DM};
                pg8::gemm_phase<pg8::EpiRes>(lds, g, S, E, wave, lane);
            }
            SEAM(14);
        }
        peer_phases<1>(lds, lo, hi, bar, wave, G, bx);
    }
#undef IN
#undef SEAM
}

extern "C" void kernel_launch(void* const* d_in, const int* in_sizes, int n_in, void* d_out, int out_size, void* d_ws, size_t ws_size, hipStream_t stream) {
    static int grid = 0;
    if (grid == 0) {
        if (n_in != 21 || out_size != T * DM || ws_size < WS_END) { fprintf(stderr, "kernel_launch: unexpected shapes (n_in %d out %d ws %zu need %zu)\n", n_in, out_size, ws_size, (size_t)WS_END); grid = -1; return; }
        int dev = 0, cus = 0, per_cu = 0;
        if (hipGetDevice(&dev) != hipSuccess || hipDeviceGetAttribute(&cus, hipDeviceAttributeMultiprocessorCount, dev) != hipSuccess) { grid = -1; return; }
        if (hipFuncSetAttribute((const void*)fwd, hipFuncAttributeMaxDynamicSharedMemorySize, LDS_BYTES) != hipSuccess) { fprintf(stderr, "kernel_launch: hipFuncSetAttribute failed\n"); grid = -1; return; }
        if (hipOccupancyMaxActiveBlocksPerMultiprocessor(&per_cu, (const void*)fwd, NTHR, LDS_BYTES) != hipSuccess || per_cu < 1) fprintf(stderr, "kernel_launch: occupancy query reports %d\n", per_cu);
        (void)hipGetLastError();
        grid = cus < 256 ? cus : 256;
    }
    if (grid < 0) return;
    (void)hipMemsetAsync((char*)d_ws + WS_CTL, 0, CTL_ZERO_BYTES, stream);
    Args a{};
    for (int i = 0; i < 21; ++i) a.in[i] = d_in[i];
    a.out = (float*)d_out; a.ws = (unsigned char*)d_ws;
#if MK_ONE_LAUNCH
    a.ph_lo = 0; a.ph_hi = 20;
    hipLaunchKernelGGL(fwd, dim3(grid), dim3(NTHR), LDS_BYTES, stream, a);
#else
    for (int ph = 0; ph < 20; ++ph) { a.ph_lo = ph; a.ph_hi = ph + 1; hipLaunchKernelGGL(fwd, dim3(grid), dim3(NTHR), LDS_BYTES, stream, a); }
#endif
}
```

```cpp
#include <hip/hip_runtime.h>
#include <cstdio>
#include <cstdint>

#ifndef MK_ONE_LAUNCH
#define MK_ONE_LAUNCH 1
#endif

#define LAS __attribute__((address_space(3)))
#define GAS __attribute__((address_space(1)))
typedef unsigned short bf16_t;
typedef short bf16x8 __attribute__((ext_vector_type(8)));
typedef short s16x4 __attribute__((ext_vector_type(4)));
typedef float f32x2 __attribute__((ext_vector_type(2)));
typedef float f32x4 __attribute__((ext_vector_type(4)));
typedef float f32x16 __attribute__((ext_vector_type(16)));
typedef unsigned u32x2 __attribute__((ext_vector_type(2)));
typedef unsigned u32x4 __attribute__((ext_vector_type(4)));

constexpr int NB = 8, SEQ = 4096, DM = 2048, T = NB * SEQ, NH = 16, HD = 128;
constexpr int KVL = 512, QKR = 64, QL = 512, NEXP = 16384, PH = 8, NKEYS = 128, TOPK = 16, NSEL = PH * TOPK;
constexpr int NDKQ = 1280;
constexpr float EPS = 1e-6f;
constexpr float LOG2E = 1.4426950408889634f;
constexpr int NWAVES = 8, NTHR = 512;

constexpr size_t MiB = 1u << 20;
constexpr size_t WS_CTL = 0, CTL_ZERO_BYTES = 1 * MiB;
constexpr size_t WS_RSTD = 1 * MiB;
constexpr size_t WS_CS = 2 * MiB;
constexpr size_t WS_WQKV = 16 * MiB;
constexpr size_t WS_WO = 40 * MiB;
constexpr size_t WS_WDKQ = 48 * MiB;
constexpr size_t WS_WUKV = 54 * MiB;
constexpr size_t WS_WUQ = 58 * MiB;
constexpr size_t WS_WMO = 62 * MiB;
constexpr size_t WS_WPQ = 70 * MiB;
constexpr size_t WS_KBD = 86 * MiB;
constexpr size_t WS_TU = 96 * MiB;
constexpr size_t WS_TV = 160 * MiB;
constexpr size_t WS_CB = 96 * MiB;
constexpr size_t WS_CQB = 128 * MiB;
constexpr size_t WS_XB = 224 * MiB;
constexpr size_t WS_R0 = 352 * MiB;
constexpr size_t WS_Q = WS_R0, WS_K = WS_R0 + 128 * MiB, WS_V = WS_R0 + 256 * MiB;
constexpr size_t WS_KN = WS_R0, WS_VM = WS_R0 + 128 * MiB, WS_QM = WS_R0 + 256 * MiB;
constexpr size_t WS_KR = WS_R0 + 448 * MiB;
constexpr size_t WS_QP = WS_R0, WS_SC = WS_R0 + 128 * MiB, WS_IDS = WS_R0 + 384 * MiB, WS_GATE = WS_R0 + 400 * MiB;
constexpr size_t WS_DKQ = WS_R0 + 256 * MiB;
constexpr size_t WS_END = WS_R0 + 452 * MiB;

constexpr int CW_TMO = 0, CW_CHK = 2, CW_BAR = 4096;

__device__ __forceinline__ unsigned f2bf(float f) { unsigned u = __builtin_bit_cast(unsigned, f); return (u + 0x7fffu + ((u >> 16) & 1u)) >> 16; }
__device__ __forceinline__ unsigned pk2(float lo, float hi) { return f2bf(lo) | (f2bf(hi) << 16); }
__device__ __forceinline__ float bflo(unsigned w) { return __builtin_bit_cast(float, w << 16); }
__device__ __forceinline__ float bfhi(unsigned w) { return __builtin_bit_cast(float, w & 0xffff0000u); }
__device__ __forceinline__ float bf2f(bf16_t h) { return __builtin_bit_cast(float, (unsigned)h << 16); }
__device__ __forceinline__ unsigned cvtpk(float lo, float hi) { unsigned r; asm volatile("v_cvt_pk_bf16_f32 %0, %1, %2" : "=v"(r) : "v"(lo), "v"(hi)); return r; }
__device__ __forceinline__ float wave_sum(float v) {
#pragma unroll
    for (int o = 1; o < 64; o <<= 1) v += __shfl_xor(v, o);
    return v;
}
__device__ __forceinline__ unsigned wave_max_u32(unsigned v) {
#pragma unroll
    for (int o = 1; o < 64; o <<= 1) { unsigned w = (unsigned)__shfl_xor((int)v, o); v = v > w ? v : w; }
    return v;
}
__device__ __forceinline__ int lane_id_v() { int l; asm volatile("v_mbcnt_lo_u32_b32 %0, -1, 0\n\tv_mbcnt_hi_u32_b32 %0, -1, %0" : "=v"(l)); return l; }
#define LDS_WAIT() asm volatile("s_waitcnt lgkmcnt(0)" ::: "memory")
#define VM_WAIT() asm volatile("s_waitcnt vmcnt(0)" ::: "memory")
#define SBAR() __builtin_amdgcn_sched_barrier(0)

namespace pg8 {
constexpr int BM = 256, BK = 64, HALF = 128, HTB = HALF * BK * 2, STAGE_BYTES = 8 * HTB, NXCD = 8, WGM = 8;
__host__ __device__ __forceinline__ int lds_byte(int r, int c) { const int st = (r >> 4) * 2 + (c >> 5), rr = r & 15, cc = c & 31, ob = rr * 64 + cc * 2; return st * 1024 + (ob ^ (((ob >> 9) & 1) << 5)); }
__host__ __device__ __forceinline__ void stage_rc(int b, int& R, int& C) { const int st = b / 1024, sb = b % 1024, swz = sb ^ (((sb >> 9) & 1) << 5); R = (st >> 1) * 16 + swz / 64; C = (st & 1) * 32 + (swz % 64) / 2; }
__host__ __device__ __forceinline__ int perm32(int rho) { const int n = rho >> 4, i = rho & 15; return 8 * (i >> 2) + 4 * n + (i & 3); }
struct Unit { int pm, pn; };
struct Gemm { const bf16_t* A; const bf16_t* Bt; int M, N, K, lda, a_pn; };
struct StaticOrder {
    int nM, nN, nwg, G, c;
    __device__ void init(int M, int N, int G_, int c_) { nM = M / BM; nN = N / BM; nwg = nM * nN; G = G_; c = c_; }
    __device__ bool next(int i, Unit& u) const {
        const long L = (long)i * G + c; if (L >= nwg) return false;
        int wgid = (int)L; { const int q = nwg / NXCD, r = nwg % NXCD, xcd = wgid % NXCD, off = wgid / NXCD; wgid = (xcd < r ? xcd * (q + 1) : r * (q + 1) + (xcd - r) * q) + off; }
        const int nig = WGM * nN, gid = wgid / nig, fm = gid * WGM, gsz = (nM - fm) < WGM ? (nM - fm) : WGM;
        u.pm = fm + ((wgid % nig) % gsz); u.pn = (wgid % nig) / gsz; return true;
    }
};
struct EpiQKV {
    static constexpr bool PERM = true;
    bf16_t* Q; size_t split_stride; const float* rstd; float qscale;
    __device__ __forceinline__ void operator()(const f32x4 (&acc)[2][2][4][2], const Unit& u, int wr, int wc, int fr, int fq) const {
        const int row0 = u.pm * BM + wr * 64 + fr; int colt = u.pn * BM; const int t = colt / DM; bf16_t* base = Q + (size_t)t * split_stride; colt -= t * DM;
        const float sc = t == 0 ? qscale : 1.f; const int col0 = colt + wc * 32 + 8 * fq;
#pragma unroll
        for (int ai = 0; ai < 2; ++ai)
#pragma unroll
            for (int m = 0; m < 4; ++m) { const int row = row0 + ai * HALF + m * 16; const float rs = rstd[row] * sc; bf16_t* rowp = base + (size_t)row * DM + col0;
#pragma unroll
                for (int bj = 0; bj < 2; ++bj) { const f32x4 v0 = acc[ai][bj][m][0] * rs, v1 = acc[ai][bj][m][1] * rs;
                    u32x4 w; w.x = cvtpk(v0[0], v0[1]); w.y = cvtpk(v0[2], v0[3]); w.z = cvtpk(v1[0], v1[1]); w.w = cvtpk(v1[2], v1[3]);
                    *(u32x4*)(rowp + bj * HALF) = w; } }
    }
};
struct EpiB16 {
    static constexpr bool PERM = true;
    bf16_t* O; int ldc; const float* rstd;
    __device__ __forceinline__ void operator()(const f32x4 (&acc)[2][2][4][2], const Unit& u, int wr, int wc, int fr, int fq) const {
        const int row0 = u.pm * BM + wr * 64 + fr, col0 = u.pn * BM + wc * 32 + 8 * fq;
#pragma unroll
        for (int ai = 0; ai < 2; ++ai)
#pragma unroll
            for (int m = 0; m < 4; ++m) { const int row = row0 + ai * HALF + m * 16; const float rs = rstd ? rstd[row] : 1.f; bf16_t* rowp = O + (size_t)row * ldc + col0;
#pragma unroll
                for (int bj = 0; bj < 2; ++bj) { const f32x4 v0 = acc[ai][bj][m][0] * rs, v1 = acc[ai][bj][m][1] * rs;
                    u32x4 w; w.x = cvtpk(v0[0], v0[1]); w.y = cvtpk(v0[2], v0[3]); w.z = cvtpk(v1[0], v1[1]); w.w = cvtpk(v1[2], v1[3]);
                    *(u32x4*)(rowp + bj * HALF) = w; } }
    }
};
struct EpiUKV {
    static constexpr bool PERM = true;
    bf16_t* KN; bf16_t* VM; const float* rstd;
    __device__ __forceinline__ void operator()(const f32x4 (&acc)[2][2][4][2], const Unit& u, int wr, int wc, int fr, int fq) const {
        const int row0 = u.pm * BM + wr * 64 + fr, col0 = u.pn * HD + wc * 32 + 8 * fq;
#pragma unroll
        for (int ai = 0; ai < 2; ++ai)
#pragma unroll
            for (int m = 0; m < 4; ++m) { const int row = row0 + ai * HALF + m * 16; const float rs = rstd ? rstd[row] : 1.f;
#pragma unroll
                for (int bj = 0; bj < 2; ++bj) { const f32x4 v0 = acc[ai][bj][m][0] * rs, v1 = acc[ai][bj][m][1] * rs;
                    u32x4 w; w.x = cvtpk(v0[0], v0[1]); w.y = cvtpk(v0[2], v0[3]); w.z = cvtpk(v1[0], v1[1]); w.w = cvtpk(v1[2], v1[3]);
                    *(u32x4*)((bj ? VM : KN) + (size_t)row * DM + col0) = w; } }
    }
};
struct EpiF32 {
    static constexpr bool PERM = false;
    float* C; int ldc; const float* rstd;
    __device__ __forceinline__ void operator()(const f32x4 (&acc)[2][2][4][2], const Unit& u, int wr, int wc, int fr, int fq) const {
        const int row0 = u.pm * BM + wr * 64 + fr, col0 = u.pn * BM + wc * 32 + 4 * fq;
#pragma unroll
        for (int ai = 0; ai < 2; ++ai)
#pragma unroll
            for (int m = 0; m < 4; ++m) { const int row = row0 + ai * HALF + m * 16; const float rs = rstd ? rstd[row] : 1.f; float* rowp = C + (size_t)row * ldc + col0;
#pragma unroll
                for (int bj = 0; bj < 2; ++bj)
#pragma unroll
                    for (int n = 0; n < 2; ++n) *(f32x4*)(rowp + bj * HALF + n * 16) = acc[ai][bj][m][n] * rs; }
    }
};
struct EpiRes {
    static constexpr bool PERM = false;
    float* C; const float* base; int ldc;
    __device__ __forceinline__ void operator()(const f32x4 (&acc)[2][2][4][2], const Unit& u, int wr, int wc, int fr, int fq) const {
        const int row0 = u.pm * BM + wr * 64 + fr, col0 = u.pn * BM + wc * 32 + 4 * fq;
#pragma unroll
        for (int ai = 0; ai < 2; ++ai)
#pragma unroll
            for (int m = 0; m < 4; ++m) { const size_t ro = (size_t)(row0 + ai * HALF + m * 16) * ldc + col0;
#pragma unroll
                for (int bj = 0; bj < 2; ++bj)
#pragma unroll
                    for (int n = 0; n < 2; ++n) { const f32x4 b = *(const f32x4*)(base + ro + bj * HALF + n * 16); *(f32x4*)(C + ro + bj * HALF + n * 16) = acc[ai][bj][m][n] + b; } }
    }
};

template <class Epi>
__device__ __forceinline__ void gemm_phase(LAS unsigned char* lds, const Gemm g, const StaticOrder& S, const Epi& E, const int wid, const int lane) {
    const int tid = wid * 64 + lane, wr = wid >> 2, wc = wid & 3, fr = lane & 15, fq = lane >> 4;
    const int K = g.K, nt = K / BK, lda = g.lda;
    unsigned voffA[2], voffB[2];
#pragma unroll
    for (int i = 0; i < 2; ++i) { int R, C; stage_rc(tid * 16 + i * 8192, R, C); const int Rb = Epi::PERM ? ((R & ~31) + perm32(R & 31)) : R;
        voffA[i] = (unsigned)(R * lda + C) * 2u; voffB[i] = (unsigned)(Rb * K + C) * 2u; }
    const size_t kstep = (size_t)(BK * 2);
    const size_t hstepA = (size_t)HALF * lda * 2, hstepB = (size_t)HALF * K * 2;
    const size_t tstepA = 2 * hstepA, tstepB = 2 * hstepB;
    const unsigned ldsw = (unsigned)wid * 1024u;
    const int aoff = lds_byte(wr * 64 + fr, fq * 8), boff = lds_byte(wc * 32 + fr, fq * 8);
#define PG8_SA(b, h) (((b) * 2 + (h)) * HTB)
#define PG8_SB(b, h) ((4 + (b) * 2 + (h)) * HTB)
#define PG8_STAGE(bufoff, gbase, voff) do { _Pragma("unroll") for (int _i = 0; _i < 2; ++_i) \
        __builtin_amdgcn_global_load_lds((const unsigned*)((const char*)(gbase) + (voff)[_i]), (LAS unsigned*)(lds + (bufoff) + ldsw + _i * 8192), 16, 0, 0); } while (0)
#define PG8_LDA(dst, b, h) do { _Pragma("unroll") for (int m = 0; m < 4; ++m) _Pragma("unroll") for (int k = 0; k < 2; ++k) dst[m][k] = *(const LAS bf16x8*)(lds + PG8_SA(b, h) + aoff + m * 2048 + k * 1024); } while (0)
#define PG8_LDB(dst, b, h) do { _Pragma("unroll") for (int n = 0; n < 2; ++n) _Pragma("unroll") for (int k = 0; k < 2; ++k) dst[n][k] = *(const LAS bf16x8*)(lds + PG8_SB(b, h) + boff + n * 2048 + k * 1024); } while (0)
#define PG8_MMA(ai, bj, At, Bt) do { __builtin_amdgcn_s_setprio(1); _Pragma("unroll") for (int m = 0; m < 4; ++m) _Pragma("unroll") for (int n = 0; n < 2; ++n) _Pragma("unroll") for (int k = 0; k < 2; ++k) \
        acc[ai][bj][m][n] = __builtin_amdgcn_mfma_f32_16x16x32_bf16(Bt[n][k], At[m][k], acc[ai][bj][m][n], 0, 0, 0); __builtin_amdgcn_s_setprio(0); } while (0)
#define PG8_WAIT_V(n) asm volatile("s_waitcnt vmcnt(" #n ")" ::: "memory")
#define PG8_WAIT_L(n) asm volatile("s_waitcnt lgkmcnt(" #n ")" ::: "memory")
#define PG8_BAR __builtin_amdgcn_s_barrier()
#define PG8_SCHED __builtin_amdgcn_sched_barrier(0)
    Unit cur, nxt; int ui = 0;
    if (!S.next(0, cur)) return;
    f32x4 acc[2][2][4][2];
#pragma unroll
    for (int a = 0; a < 2; ++a)
#pragma unroll
        for (int b = 0; b < 2; ++b)
#pragma unroll
            for (int m = 0; m < 4; ++m)
#pragma unroll
                for (int n = 0; n < 2; ++n) acc[a][b][m][n] = (f32x4){0.f, 0.f, 0.f, 0.f};
    bf16x8 At[4][2], B0[2][2], B1[2][2];
    const char* cA = (const char*)g.A + (size_t)cur.pm * tstepA + (size_t)cur.pn * g.a_pn * 2; const char* cB = (const char*)g.Bt + (size_t)cur.pn * tstepB;
    PG8_STAGE(PG8_SB(0, 0), cB, voffB); PG8_STAGE(PG8_SB(0, 1), cB + hstepB, voffB); PG8_STAGE(PG8_SA(0, 0), cA, voffA); PG8_STAGE(PG8_SA(0, 1), cA + hstepA, voffA);
    if (wr == 1) PG8_BAR;
    PG8_WAIT_V(2); PG8_BAR;
    PG8_STAGE(PG8_SB(1, 0), cB + kstep, voffB); PG8_STAGE(PG8_SA(1, 0), cA + kstep, voffA); PG8_STAGE(PG8_SB(1, 1), cB + hstepB + kstep, voffB);
    PG8_WAIT_V(6); PG8_BAR;
#pragma unroll 1
    for (;;) {
        const bool has_next = S.next(ui + 1, nxt);
        const char* nA = has_next ? (const char*)g.A + (size_t)nxt.pm * tstepA + (size_t)nxt.pn * g.a_pn * 2 : cA; const char* nB = has_next ? (const char*)g.Bt + (size_t)nxt.pn * tstepB : cB;
#pragma unroll 1
        for (int t = 0; t < nt; t += 2) {
            const bool last = (t == nt - 2);
            const char* a1 = cA + (size_t)(t + 1) * kstep;
            const char* a2 = last ? nA : cA + (size_t)(t + 2) * kstep; const char* b2 = last ? nB : cB + (size_t)(t + 2) * kstep;
            const char* a3 = a2 + kstep; const char* b3 = b2 + kstep;
            PG8_LDB(B0, 0, 0); PG8_LDB(B1, 0, 1); PG8_SCHED; PG8_LDA(At, 0, 0); PG8_STAGE(PG8_SA(1, 1), a1 + hstepA, voffA);
            PG8_WAIT_V(8); PG8_WAIT_L(0); PG8_BAR; PG8_MMA(0, 0, At, B0); PG8_MMA(0, 1, At, B1); PG8_BAR; PG8_SCHED;
            PG8_LDA(At, 0, 1); PG8_STAGE(PG8_SB(0, 0), b2, voffB); PG8_STAGE(PG8_SB(0, 1), b2 + hstepB, voffB); PG8_STAGE(PG8_SA(0, 0), a2, voffA);
            PG8_WAIT_V(8); PG8_WAIT_L(0); PG8_BAR; PG8_MMA(1, 0, At, B0); PG8_MMA(1, 1, At, B1); PG8_BAR; PG8_SCHED;
            PG8_LDB(B0, 1, 0); PG8_LDB(B1, 1, 1); PG8_SCHED; PG8_LDA(At, 1, 0); PG8_STAGE(PG8_SA(0, 1), a2 + hstepA, voffA);
            PG8_WAIT_V(8); PG8_WAIT_L(0); PG8_BAR; PG8_MMA(0, 0, At, B0); PG8_MMA(0, 1, At, B1); PG8_BAR; PG8_SCHED;
            PG8_LDA(At, 1, 1); PG8_STAGE(PG8_SB(1, 0), b3, voffB); PG8_STAGE(PG8_SB(1, 1), b3 + hstepB, voffB); PG8_STAGE(PG8_SA(1, 0), a3, voffA);
            PG8_WAIT_V(8); PG8_WAIT_L(0); PG8_BAR; PG8_MMA(1, 0, At, B0); PG8_MMA(1, 1, At, B1); PG8_BAR; PG8_SCHED;
        }
        if (wr == 0) PG8_BAR;
        E(acc, cur, wr, wc, fr, fq);
        if (!has_next) break;
#pragma unroll
        for (int a = 0; a < 2; ++a)
#pragma unroll
            for (int b = 0; b < 2; ++b)
#pragma unroll
                for (int m = 0; m < 4; ++m)
#pragma unroll
                    for (int n = 0; n < 2; ++n) acc[a][b][m][n] = (f32x4){0.f, 0.f, 0.f, 0.f};
        cur = nxt; cA = nA; cB = nB; ++ui;
        if (wr == 1) PG8_BAR;
    }
    PG8_WAIT_V(0);
    PG8_BAR;
#undef PG8_SA
#undef PG8_SB
#undef PG8_STAGE
#undef PG8_LDA
#undef PG8_LDB
#undef PG8_MMA
#undef PG8_WAIT_V
#undef PG8_WAIT_L
#undef PG8_BAR
#undef PG8_SCHED
}
}

namespace att {
constexpr int SHM_V = 16384, SHM_K = 16384, SHM_R = 8192;
constexpr int OFF_V = 0, OFF_K = 2 * SHM_V, OFF_R = OFF_K + 2 * SHM_K, OFF_WS = OFF_R + 2 * SHM_R, LDS_BYTES = OFF_WS + NWAVES * 64 * 4;
#define KSWZ(row, colB) ((row) * 256 + ((colB) ^ (((row) & 7) << 4)))
#define RSWZ(row, colB) ((row) * 128 + ((colB) ^ (((row) & 7) << 4)))
__device__ __forceinline__ int v_st(int k, int c) { const int kk = (k & ~0xC) | ((k & 4) << 1) | ((k & 8) >> 1); return ((kk >> 3) * 4 + (c >> 5)) * 512 + ((kk & 7) * 32 + (c & 31)) * 2; }
__device__ __forceinline__ int v_rd_base(int lane) { return ((lane & 3) << 3) | (((lane >> 2) & 3) << 6) | (((lane >> 4) & 1) << 5) | (((lane >> 5) & 1) << 8); }
__device__ __forceinline__ int crow(int r, int hi) { return (r & 3) + 8 * (r >> 2) + 4 * hi; }
__device__ __forceinline__ float pl_sum(float x) { auto rr = __builtin_amdgcn_permlane32_swap(__float_as_uint(x), __float_as_uint(x), false, false); return __uint_as_float(rr[0]) + __uint_as_float(rr[1]); }
__device__ __forceinline__ float pl_max(float x) { auto rr = __builtin_amdgcn_permlane32_swap(__float_as_uint(x), __float_as_uint(x), false, false); return fmaxf(__uint_as_float(rr[0]), __uint_as_float(rr[1])); }

#define PK4(P, B_, OUT) do { unsigned a0 = cvtpk(P[B_+0], P[B_+1]), a1 = cvtpk(P[B_+2], P[B_+3]);                          \
        unsigned b0 = cvtpk(P[B_+4], P[B_+5]), b1 = cvtpk(P[B_+6], P[B_+7]);                                             \
        auto r0 = __builtin_amdgcn_permlane32_swap(a0, b0, false, false); auto r1 = __builtin_amdgcn_permlane32_swap(a1, b1, false, false); \
        u32x4 w = {r0[0], r1[0], r0[1], r1[1]}; OUT = __builtin_bit_cast(bf16x8, w); } while (0)

__device__ __forceinline__ void pv_tile(f32x16* o, unsigned vb, bf16x8 pa0, bf16x8 pa1, bf16x8 pa2, bf16x8 pa3) {
#define TRRD(dst, off) asm volatile("ds_read_b64_tr_b16 %0, %1 offset:%2" : "=&v"(dst) : "v"(vb), "i"(off) : "memory")
#define PV_D0(d0) do { s16x4 l0, l1, l2, l3, h0, h1, h2, h3; constexpr int b_ = (d0) * 512;   \
        TRRD(l0, b_); TRRD(h0, b_ + 2048); TRRD(l1, b_ + 4096); TRRD(h1, b_ + 6144); TRRD(l2, b_ + 8192); TRRD(h2, b_ + 10240); TRRD(l3, b_ + 12288); TRRD(h3, b_ + 14336); \
        asm volatile("s_waitcnt lgkmcnt(0)" ::: "memory"); SBAR();   \
        o[d0] = __builtin_amdgcn_mfma_f32_32x32x16_bf16(pa0, (bf16x8){l0[0], l0[1], l0[2], l0[3], h0[0], h0[1], h0[2], h0[3]}, o[d0], 0, 0, 0);   \
        o[d0] = __builtin_amdgcn_mfma_f32_32x32x16_bf16(pa1, (bf16x8){l1[0], l1[1], l1[2], l1[3], h1[0], h1[1], h1[2], h1[3]}, o[d0], 0, 0, 0);   \
        o[d0] = __builtin_amdgcn_mfma_f32_32x32x16_bf16(pa2, (bf16x8){l2[0], l2[1], l2[2], l2[3], h2[0], h2[1], h2[2], h2[3]}, o[d0], 0, 0, 0);   \
        o[d0] = __builtin_amdgcn_mfma_f32_32x32x16_bf16(pa3, (bf16x8){l3[0], l3[1], l3[2], l3[3], h3[0], h3[1], h3[2], h3[3]}, o[d0], 0, 0, 0); } while (0)
    PV_D0(0); PV_D0(1); PV_D0(2); PV_D0(3);
#undef PV_D0
#undef TRRD
}

__device__ __forceinline__ void sb_tile(f32x16& p0, f32x16& p1, float& R, int dq, int hi) {
    const float NEG = -__builtin_inff();
    asm volatile("" : "+v"(dq));
    float g[8];
#define SB_GRP(P, half, i) do { float Lv[4], zv[4];                                                                              \
        _Pragma("unroll") for (int jj = 0; jj < 4; ++jj) { const int c = jj + 8 * (i) + 32 * (half); const bool ok = dq >= c;  \
            const float z = fminf(P[4 * (i) + jj], 80.f); const float e = __builtin_amdgcn_exp2f(z);                               \
            const float sp = __builtin_amdgcn_logf(1.f + e); Lv[jj] = ok ? -sp : 0.f; zv[jj] = ok ? z : NEG; }                      \
        const float s3 = Lv[3], s2 = Lv[2] + s3, s1 = Lv[1] + s2, s0 = Lv[0] + s1;                                                \
        P[4 * (i) + 0] = zv[0] + s0; P[4 * (i) + 1] = zv[1] + s1; P[4 * (i) + 2] = zv[2] + s2; P[4 * (i) + 3] = zv[3] + s3;      \
        g[(half) * 4 + (i)] = s0; } while (0)
    SB_GRP(p0, 0, 0); SB_GRP(p0, 0, 1); SB_GRP(p0, 0, 2); SB_GRP(p0, 0, 3);
    SB_GRP(p1, 1, 0); SB_GRP(p1, 1, 1); SB_GRP(p1, 1, 2); SB_GRP(p1, 1, 3);
#undef SB_GRP
    float c[8], Tk[8];
#pragma unroll
    for (int k = 0; k < 8; ++k) c[k] = pl_sum(g[k]);
    Tk[7] = 0.f;
#pragma unroll
    for (int k = 6; k >= 0; --k) Tk[k] = Tk[k + 1] + c[k + 1];
    const float tot = Tk[0] + c[0];
#pragma unroll
    for (int k = 0; k < 8; ++k) { const float add = R + Tk[k] + (hi == 0 ? (c[k] - g[k]) : 0.f);
#pragma unroll
        for (int jj = 0; jj < 4; ++jj) { if (k < 4) p0[4 * k + jj] = __builtin_amdgcn_exp2f(p0[4 * k + jj] + add); else p1[4 * (k - 4) + jj] = __builtin_amdgcn_exp2f(p1[4 * (k - 4) + jj] + add); } }
    R += tot;
}

template <int MODE>
__device__ __forceinline__ void attn_unit(LAS unsigned char* lds, const bf16_t* Qp, int qpitch, const bf16_t* Kp, const bf16_t* Vp, int kvpitch,
                                          const bf16_t* Rp, const float* cs, bf16_t* Op, int opitch, int q0, const int wid, const int lane) {
    constexpr int NQF = MODE ? 12 : 8;
    constexpr float SCALE = 0.07216878364870323f;
    constexpr float C2 = LOG2E * SCALE, THR = 8.f;
    const int r32 = lane & 31, hi = lane >> 5;
    const int qrow = q0 + wid * 32 + r32;
    LAS unsigned char* V_lds = lds + OFF_V; LAS unsigned char* K_lds = lds + OFF_K; LAS unsigned char* R_lds = lds + OFF_R;
    LAS float* wsf = (LAS float*)(lds + OFF_WS) + wid * 64;
    bf16x8 qr[NQF];
#pragma unroll
    for (int d0 = 0; d0 < NQF; ++d0) qr[d0] = *(const bf16x8*)(Qp + (size_t)qrow * qpitch + d0 * 16 + hi * 8);
    if constexpr (MODE == 1) {
#pragma unroll
        for (int f = 0; f < 2; ++f) { const int ib = f * 16 + hi * 8; const float* csr = cs + (size_t)qrow * 64 + ib * 2;
            bf16x8 a = qr[8 + f], b = qr[10 + f];
#pragma unroll
            for (int j = 0; j < 8; ++j) { const float co = csr[2 * j], si = csr[2 * j + 1], x1 = bf2f((bf16_t)a[j]), x2 = bf2f((bf16_t)b[j]);
                a[j] = (short)f2bf(x1 * co - x2 * si); b[j] = (short)f2bf(x2 * co + x1 * si); }
            qr[8 + f] = a; qr[10 + f] = b; }
    }
    const int NT = q0 / 64 + 4;
    const unsigned vb0 = (unsigned)(size_t)(V_lds) + (unsigned)v_rd_base(lane);
    unsigned koff[2], voff[2], roff;
#pragma unroll
    for (int i = 0; i < 2; ++i) { const int p = (wid * 2 + i) * 64 + lane;
        { const int row = p >> 4, pc = p & 15; koff[i] = (unsigned)(row * kvpitch + ((pc ^ (row & 7)) * 8)); }
        { const int sub = p >> 5, w = p & 31, kk = (sub >> 2) * 8 + (w >> 2), c = (sub & 3) * 32 + (w & 3) * 8, k = (kk & ~0xC) | ((kk & 4) << 1) | ((kk & 8) >> 1); voff[i] = (unsigned)(k * kvpitch + c); } }
    { const int p = wid * 64 + lane, row = p >> 3, pc = p & 7; roff = (unsigned)(row * 64 + ((pc ^ (row & 7)) * 8)); }
#define TILE_OF(it) (MODE ? (it) : (NT - 1 - (it)))
#define STAGE(jt, bf) do { const size_t kb_ = (size_t)(jt) * 64 * kvpitch;                                                                                   \
        _Pragma("unroll") for (int i_ = 0; i_ < 2; ++i_) {                                                                                                   \
            __builtin_amdgcn_global_load_lds((const unsigned*)(Kp + kb_ + koff[i_]), (LAS unsigned*)(K_lds + (bf) * SHM_K + (wid * 2 + i_) * 1024), 16, 0, 0);   \
            __builtin_amdgcn_global_load_lds((const unsigned*)(Vp + kb_ + voff[i_]), (LAS unsigned*)(V_lds + (bf) * SHM_V + (wid * 2 + i_) * 1024), 16, 0, 0); } \
        if constexpr (MODE == 1) __builtin_amdgcn_global_load_lds((const unsigned*)(Rp + (size_t)(jt) * 64 * 64 + roff), (LAS unsigned*)(R_lds + (bf) * SHM_R + wid * 1024), 16, 0, 0); } while (0)
    float m_reg = -1e30f, l_reg = 0.f, Rrun = 0.f; f32x16 o[4];
#pragma unroll
    for (int d = 0; d < 4; ++d) o[d] = f32x16{};
    STAGE(TILE_OF(0), 0);
    __syncthreads();
    for (int it = 0; it < NT; ++it) {
        const int buf = it & 1, jt = TILE_OF(it), k0 = jt * 64;
        if (it + 1 < NT) STAGE(TILE_OF(it + 1), buf ^ 1);
        f32x16 p0 = f32x16{}, p1 = f32x16{};
        {
            LAS unsigned char* kb = K_lds + buf * SHM_K;
#pragma unroll
            for (int d0 = 0; d0 < 8; ++d0) { LAS unsigned char* a = kb + KSWZ(r32, ((d0 & 3) * 16 + hi * 8) * 2) + (d0 >> 2) * 128;
                const bf16x8 b0 = *(LAS bf16x8*)a, b1 = *(LAS bf16x8*)(a + 32 * 256);
                p0 = __builtin_amdgcn_mfma_f32_32x32x16_bf16(b0, qr[d0], p0, 0, 0, 0);
                p1 = __builtin_amdgcn_mfma_f32_32x32x16_bf16(b1, qr[d0], p1, 0, 0, 0); }
            if constexpr (MODE == 1) {
                LAS unsigned char* rb = R_lds + buf * SHM_R;
#pragma unroll
                for (int d0 = 0; d0 < 4; ++d0) { LAS unsigned char* a = rb + RSWZ(r32, (d0 * 16 + hi * 8) * 2);
                    const bf16x8 b0 = *(LAS bf16x8*)a, b1 = *(LAS bf16x8*)(a + 32 * 128);
                    p0 = __builtin_amdgcn_mfma_f32_32x32x16_bf16(b0, qr[8 + d0], p0, 0, 0, 0);
                    p1 = __builtin_amdgcn_mfma_f32_32x32x16_bf16(b1, qr[8 + d0], p1, 0, 0, 0); }
            }
        }
        bf16x8 pa0, pa1, pa2, pa3;
        if constexpr (MODE == 0) {
            sb_tile(p0, p1, Rrun, qrow - 1 - k0 - 4 * hi, hi);
        } else {
            const float NEG = -__builtin_inff();
            if (k0 + 63 > q0 + wid * 32) {
                int dq = qrow - k0 - 4 * hi; asm volatile("" : "+v"(dq));
#pragma unroll
                for (int r = 0; r < 16; ++r) { const int c = (r & 3) + 8 * (r >> 2); if (dq < c) p0[r] = NEG; if (dq < c + 32) p1[r] = NEG; }
            }
            float pmax = p0[0];
#pragma unroll
            for (int r = 1; r < 16; ++r) pmax = fmaxf(pmax, p0[r]);
#pragma unroll
            for (int r = 0; r < 16; ++r) pmax = fmaxf(pmax, p1[r]);
            pmax = pl_max(pmax);
            float mn, alpha;
            if (__all((pmax - m_reg) * SCALE <= THR)) { mn = m_reg; alpha = 1.f; }
            else { mn = fmaxf(m_reg, pmax); alpha = __builtin_amdgcn_exp2f((m_reg - mn) * C2); m_reg = mn; }
            const float mnL = -mn * C2;
#pragma unroll
            for (int r = 0; r < 16; ++r) { p0[r] = __builtin_amdgcn_exp2f(fmaf(p0[r], C2, mnL)); p1[r] = __builtin_amdgcn_exp2f(fmaf(p1[r], C2, mnL)); }
            float ps = 0.f;
#pragma unroll
            for (int r = 0; r < 16; ++r) ps += p0[r] + p1[r];
            ps = pl_sum(ps);
            l_reg = l_reg * alpha + ps;
            if (__any(alpha < 1.f)) { if (hi == 0) wsf[r32] = alpha; LDS_WAIT();
#pragma unroll
                for (int r = 0; r < 16; ++r) { const float al = wsf[crow(r, hi)];
#pragma unroll
                    for (int d = 0; d < 4; ++d) o[d][r] *= al; } }
        }
        PK4(p0, 0, pa0); PK4(p0, 8, pa1); PK4(p1, 0, pa2); PK4(p1, 8, pa3);
        SBAR();
        pv_tile(o, vb0 + buf * SHM_V, pa0, pa1, pa2, pa3);
        __syncthreads();
    }
    if constexpr (MODE == 1) { if (hi == 0) wsf[r32] = l_reg; LDS_WAIT(); }
    GAS bf16_t* Ow = (GAS bf16_t*)(Op + (size_t)(q0 + wid * 32) * opitch); asm volatile("" : "+s"(Ow));
#pragma unroll
    for (int r = 0; r < 16; ++r) { const int orow = crow(r, hi); float inv = 1.f; if constexpr (MODE == 1) inv = __builtin_amdgcn_rcpf(wsf[orow]);
#pragma unroll
        for (int d0 = 0; d0 < 4; ++d0) { const float v = o[d0][r] * inv; const float vn = __shfl_xor(v, 1);
            if ((r32 & 1) == 0) *(GAS unsigned*)(Ow + (size_t)orow * opitch + d0 * 32 + r32) = pk2(v, vn); } }
    __syncthreads();
#undef TILE_OF
#undef STAGE
}
}

#define XB_TMO      128
#define XB_XCNT(j)  (256  + 64 * (j))
#define XB_XSUB(j)  (1280 + 64 * (j))
#define XB_XGEN(j)  (2304 + 64 * (j))
#define XB_TOP      3328
#define XB_TOPGEN   3392
#define XCD_BAR_WORDS 3456
#define XB_SPIN_CAP (1u << 22)
__device__ __forceinline__ unsigned xb_ld(unsigned* p)              { return __hip_atomic_load(p, __ATOMIC_RELAXED, __HIP_MEMORY_SCOPE_AGENT); }
__device__ __forceinline__ unsigned xb_add(unsigned* p, unsigned v) { return __hip_atomic_fetch_add(p, v, __ATOMIC_RELAXED, __HIP_MEMORY_SCOPE_AGENT); }
__device__ __forceinline__ unsigned xb_xcc_id() { return (unsigned)__builtin_amdgcn_s_getreg((3 << 11) | 20) & 0xFu; }
#define XB_SPIN(cond, bar) do { unsigned _sp = 0; while (cond) { __builtin_amdgcn_s_sleep(1); \
    if ((++_sp & 255u) == 0u) { if (xb_ld(&(bar)[XB_TMO])) break; if (_sp > XB_SPIN_CAP) { atomicAdd(&(bar)[XB_TMO], 1u); break; } } } } while (0)
struct XcdBarrier { unsigned* bar; unsigned x; volatile LAS unsigned* st; };
__device__ __forceinline__ XcdBarrier xcd_barrier_post(unsigned* bar, volatile LAS unsigned* st) {
    XcdBarrier b; b.bar = bar; b.x = xb_xcc_id(); b.st = st;
    if (threadIdx.x == 0) (void)xb_add(&bar[XB_XCNT(b.x)], 1u);
    return b;
}
__device__ __forceinline__ void xcd_barrier_complete(unsigned* bar, unsigned x, unsigned& nloc, unsigned& nx) {
    const unsigned G = gridDim.x * gridDim.y * gridDim.z;
    unsigned sum, cnt, mine, sp = 0u;
    for (;;) {
        sum = 0u; cnt = 0u; mine = 0u;
#pragma unroll
        for (unsigned j = 0; j < 16; ++j) { const unsigned c = xb_ld(&bar[XB_XCNT(j)]); sum += c; cnt += (c > 0u) ? 1u : 0u; mine = (j == x) ? c : mine; }
        if (sum == G) break;
        __builtin_amdgcn_s_sleep(1);
        if ((++sp & 255u) == 0u) { if (xb_ld(&bar[XB_TMO])) break; if (sp > XB_SPIN_CAP) { atomicAdd(&bar[XB_TMO], 1u); break; } }
    }
    nloc = mine > 0u ? mine : 1u; nx = cnt > 0u ? cnt : 1u;
}
__device__ __forceinline__ void xcd_barrier(const XcdBarrier& b, const int wave) {
    asm volatile("s_waitcnt vmcnt(0)" ::: "memory");
    __syncthreads();
    if (wave == 0 && lane_id_v() == 0) {
        unsigned* bar = b.bar;
        __builtin_amdgcn_s_waitcnt(0);
        unsigned nloc = b.st[0], nx = b.st[1];
        if (nloc == 0u) { xcd_barrier_complete(bar, b.x, nloc, nx); b.st[0] = nloc; b.st[1] = nx; }
        const unsigned old = xb_add(&bar[XB_XSUB(b.x)], 1u);
        const unsigned gen = old / nloc;
        if (old + 1u == (gen + 1u) * nloc) {
            __builtin_amdgcn_fence(__ATOMIC_RELEASE, "agent");
            asm volatile("s_waitcnt vmcnt(0)" ::: "memory");
            const unsigned og = xb_add(&bar[XB_TOP], 1u);
            const unsigned tg = og / nx;
            if (og + 1u == (tg + 1u) * nx) xb_add(&bar[XB_TOPGEN], 1u);
            else XB_SPIN(xb_ld(&bar[XB_TOPGEN]) == tg, bar);
            __builtin_amdgcn_fence(__ATOMIC_ACQUIRE, "agent");
            xb_add(&bar[XB_XGEN(b.x)], 1u);
            asm volatile("s_waitcnt vmcnt(0)" ::: "memory");
        } else {
            XB_SPIN(xb_ld(&bar[XB_XGEN(b.x)]) == gen, bar);
            __builtin_amdgcn_fence(__ATOMIC_ACQUIRE, "agent");
            asm volatile("s_waitcnt vmcnt(0)" ::: "memory");
        }
    }
    __syncthreads();
}

constexpr int RING_BYTES = 131072, MISC_OFF = RING_BYTES + 320, LDS_BYTES = 147456;
static_assert(att::LDS_BYTES <= RING_BYTES, "attention LDS");

struct Args { const void* in[21]; float* out; unsigned char* ws; int ph_lo, ph_hi; };
enum { IN_X = 0, IN_POS, IN_SBG, IN_WQKV, IN_WO, IN_KVG, IN_WDKV, IN_KVLG, IN_WUKV, IN_MLAG, IN_WDQ, IN_QLG, IN_WUQ, IN_WMO, IN_PG, IN_PWQ, IN_PK1, IN_PK2, IN_PU, IN_PV, IN_FG };

__device__ __forceinline__ void transpose_item(const float* W, int ldw, int K, int nblk, const float* gain, bf16_t* WT, int row_off, LAS float* scr, int item, int lane) {
    const int kb = item / nblk, nb = item % nblk, k0 = 64 * kb, n0 = 32 * nb;
#pragma unroll 8
    for (int i = 0; i < 32; ++i) { const int kk = 2 * i + (lane >> 5); const float gv = gain ? gain[k0 + kk] : 1.f; scr[kk * 33 + (lane & 31)] = W[(size_t)(k0 + kk) * ldw + n0 + (lane & 31)] * gv; }
    LDS_WAIT(); asm volatile("" ::: "memory");
    const int c = lane & 7;
#pragma unroll
    for (int j = 0; j < 4; ++j) { const int n = (lane >> 3) + 8 * j; const LAS float* s = scr + (8 * c) * 33 + n;
        u32x4 o; o.x = pk2(s[0 * 33], s[1 * 33]); o.y = pk2(s[2 * 33], s[3 * 33]); o.z = pk2(s[4 * 33], s[5 * 33]); o.w = pk2(s[6 * 33], s[7 * 33]);
        *(u32x4*)(WT + (size_t)(row_off + n0 + n) * K + k0 + 8 * c) = o; }
    LDS_WAIT(); asm volatile("" ::: "memory");
}
__device__ __forceinline__ void convert_tables(const float* u, const float* v, const float* g, bf16_t* TU, bf16_t* TV, int gtid, int gthreads) {
    const size_t n8 = (size_t)NEXP * DM / 8;
    for (size_t i = gtid; i < n8; i += gthreads) { const int d = (int)((i * 8) % DM);
        const f32x4 a0 = *(const f32x4*)(u + i * 8), a1 = *(const f32x4*)(u + i * 8 + 4), g0 = *(const f32x4*)(g + d), g1 = *(const f32x4*)(g + d + 4);
        u32x4 w; w.x = pk2(a0[0] * g0[0], a0[1] * g0[1]); w.y = pk2(a0[2] * g0[2], a0[3] * g0[3]); w.z = pk2(a1[0] * g1[0], a1[1] * g1[1]); w.w = pk2(a1[2] * g1[2], a1[3] * g1[3]);
        *(u32x4*)(TU + i * 8) = w;
        const f32x4 b0 = *(const f32x4*)(v + i * 8), b1 = *(const f32x4*)(v + i * 8 + 4);
        u32x4 x; x.x = pk2(b0[0], b0[1]); x.y = pk2(b0[2], b0[3]); x.z = pk2(b1[0], b1[1]); x.w = pk2(b1[2], b1[3]);
        *(u32x4*)(TV + i * 8) = x; }
}
__device__ __forceinline__ void row_to_bf16_rstd(const float* xrow, bf16_t* orow, float* rstd_out, int lane) {
    f32x4 v[8]; float s = 0.f;
#pragma unroll
    for (int j = 0; j < 8; ++j) { v[j] = *(const f32x4*)(xrow + j * 256 + lane * 4); s += v[j][0] * v[j][0] + v[j][1] * v[j][1] + v[j][2] * v[j][2] + v[j][3] * v[j][3]; }
    s = wave_sum(s);
#pragma unroll
    for (int j = 0; j < 8; ++j) { u32x2 w; w.x = pk2(v[j][0], v[j][1]); w.y = pk2(v[j][2], v[j][3]); *(u32x2*)(orow + j * 256 + lane * 4) = w; }
    if (lane == 0) *rstd_out = 1.f / sqrtf(s * (1.f / DM) + EPS);
}

#ifndef PH_MASK
#define PH_MASK 0xFFFFFu
#endif
#define IN(k) (lo <= (k) && (k) < hi)
#define SITE(b) (((PH_MASK) >> (b)) & 1u)
#define SEAM(k) do { if (IN(k) && IN((k) + 1)) xcd_barrier(bar, wave); } while (0)
#define PH_LOCALS const __attribute__((address_space(4))) Args* A_ = (const __attribute__((address_space(4))) Args*)__builtin_amdgcn_kernarg_segment_ptr(); asm volatile("" : "+s"(A_)); \
    unsigned char* ws = A_->ws; float* X = A_->out; float* rstd = (float*)(ws + WS_RSTD); float* cs = (float*)(ws + WS_CS); bf16_t* XB = (bf16_t*)(ws + WS_XB); const float* x_in = (const float*)A_->in[IN_X]; \
    const int lane = lane_id_v(), tid = wave * 64 + lane, gw = bx * NWAVES + wave, NGW = G * NWAVES, gtid = bx * NTHR + tid, gthreads = G * NTHR; \
    (void)X; (void)rstd; (void)cs; (void)XB; (void)x_in; (void)lane; (void)tid; (void)gw; (void)NGW; (void)gtid; (void)gthreads
#define AIN(k) (A_->in[k])

template <int layer>
__device__ __forceinline__ void peer_phases(LAS unsigned char* lds, const int lo, const int hi, const XcdBarrier& bar, const int wave, const int G, const int bx) {
    constexpr int pb = layer ? 15 : 4;
        if (SITE(4) && IN(pb)) { PH_LOCALS; const float* pg = (const float*)AIN(IN_PG) + (size_t)layer * DM;
            for (int m = gw; m < T; m += NGW) row_to_bf16_rstd(X + (size_t)m * DM, XB + (size_t)m * DM, rstd + m, lane);
            if (layer == 1) convert_tables((const float*)AIN(IN_PU) + (size_t)NEXP * DM, (const float*)AIN(IN_PV) + (size_t)NEXP * DM, pg, (bf16_t*)(ws + WS_TU), (bf16_t*)(ws + WS_TV), gtid, gthreads);
        }
        SEAM(pb);
        if (SITE(5) && IN(pb + 1)) { PH_LOCALS;
            pg8::Gemm g{XB, (const bf16_t*)(ws + WS_WPQ) + (size_t)layer * DM * DM, T, DM, DM, DM, 0}; pg8::StaticOrder S; S.init(T, DM, G, bx);
            pg8::EpiB16 E{(bf16_t*)(ws + WS_QP), DM, rstd};
            pg8::gemm_phase<pg8::EpiB16>(lds, g, S, E, wave, lane);
        }
        SEAM(pb + 1);
        if (SITE(6) && IN(pb + 2)) { PH_LOCALS;
            pg8::Gemm g{(const bf16_t*)(ws + WS_QP), (const bf16_t*)(ws + WS_KBD) + (size_t)layer * 2048 * 256, T, DM, 256, DM, 256}; pg8::StaticOrder S; S.init(T, DM, G, bx);
            pg8::EpiF32 E{(float*)(ws + WS_SC), DM, nullptr};
            pg8::gemm_phase<pg8::EpiF32>(lds, g, S, E, wave, lane);
        }
        SEAM(pb + 2);
        if (SITE(7) && IN(pb + 3)) { PH_LOCALS;
            const float* SC = (const float*)(ws + WS_SC); int* IDS = (int*)(ws + WS_IDS); float* GT = (float*)(ws + WS_GATE);
            for (int item = gw; item < T * PH; item += NGW) {
                const int t = item >> 3, hh = item & 7; const float* s = SC + (size_t)t * DM + hh * 256;
                unsigned ka[2], kb[2];
#pragma unroll
                for (int j = 0; j < 2; ++j) { const int idx = lane + 64 * j; unsigned ua = __float_as_uint(s[idx]), ub = __float_as_uint(s[128 + idx]);
                    ua ^= (ua >> 31) ? 0xffffffffu : 0x80000000u; ub ^= (ub >> 31) ? 0xffffffffu : 0x80000000u;
                    ka[j] = (ua & ~127u) | (unsigned)(127 - idx); kb[j] = (ub & ~127u) | (unsigned)(127 - idx); }
                unsigned my1 = 0u, my2 = 0u;
                for (int itx = 0; itx < TOPK; ++itx) {
                    unsigned m1 = wave_max_u32(ka[0] > ka[1] ? ka[0] : ka[1]); if (lane == itx) my1 = m1; if (ka[0] == m1) ka[0] = 0u; if (ka[1] == m1) ka[1] = 0u;
                    unsigned m2 = wave_max_u32(kb[0] > kb[1] ? kb[0] : kb[1]); if (lane == itx) my2 = m2; if (kb[0] == m2) kb[0] = 0u; if (kb[1] == m2) kb[1] = 0u;
                }
                auto dec = [](unsigned k) { unsigned u = k & ~127u; u ^= (u >> 31) ? 0x80000000u : 0xffffffffu; return __uint_as_float(u); };
                const float v1 = dec(my1), v2 = dec(my2);
                const float a1 = __shfl(v1, lane >> 2);
                unsigned kc[4];
#pragma unroll
                for (int jj = 0; jj < 4; ++jj) { const int j = (lane & 3) * 4 + jj; const float sum = a1 + __shfl(v2, j); unsigned us = __float_as_uint(sum); us ^= (us >> 31) ? 0xffffffffu : 0x80000000u;
                    kc[jj] = (us & ~255u) | (unsigned)(255 - (lane * 4 + jj)); }
                unsigned mysel = 0u;
                for (int itx = 0; itx < TOPK; ++itx) {
                    unsigned m = kc[0] > kc[1] ? kc[0] : kc[1]; unsigned m_ = kc[2] > kc[3] ? kc[2] : kc[3]; m = m > m_ ? m : m_;
                    m = wave_max_u32(m); if (lane == itx) mysel = m;
#pragma unroll
                    for (int jj = 0; jj < 4; ++jj) if (kc[jj] == m) kc[jj] = 0u;
                }
                const int cidx = 255 - (int)(mysel & 255u), ci = (cidx >> 4) & 15, cj = cidx & 15;
                const unsigned k1 = (unsigned)__shfl((int)my1, ci), k2 = (unsigned)__shfl((int)my2, cj);
                const int i1 = 127 - (int)(k1 & 127u), i2 = 127 - (int)(k2 & 127u);
                const float sc = dec(k1) + dec(k2);
                const float smax = __shfl(sc, 0);
                float e = (lane < TOPK) ? __expf(sc - smax) : 0.f;
                const float den = wave_sum(e);
                if (lane < TOPK) { IDS[(size_t)t * NSEL + hh * TOPK + lane] = i1 * NKEYS + i2; GT[(size_t)t * NSEL + hh * TOPK + lane] = e / den; }
            }
        }
        SEAM(pb + 3);
        if (SITE(8) && IN(pb + 4)) { PH_LOCALS;
            const bf16_t* TU = (const bf16_t*)(ws + WS_TU); const bf16_t* TV = (const bf16_t*)(ws + WS_TV);
            const int* IDS = (const int*)(ws + WS_IDS); const float* GT = (const float*)(ws + WS_GATE);
            const float* fg = (const float*)AIN(IN_FG);
            for (int t = gw; t < T; t += NGW) {
                float hf[32], acc[32];
#pragma unroll
                for (int j = 0; j < 4; ++j) { const u32x4 w = *(const u32x4*)(XB + (size_t)t * DM + j * 512 + lane * 8);
                    hf[j * 8 + 0] = bflo(w.x); hf[j * 8 + 1] = bfhi(w.x); hf[j * 8 + 2] = bflo(w.y); hf[j * 8 + 3] = bfhi(w.y); hf[j * 8 + 4] = bflo(w.z); hf[j * 8 + 5] = bfhi(w.z); hf[j * 8 + 6] = bflo(w.w); hf[j * 8 + 7] = bfhi(w.w); }
#pragma unroll
                for (int j = 0; j < 32; ++j) acc[j] = 0.f;
                const float rs = rstd[t];
                const int idv0 = IDS[(size_t)t * NSEL + lane], idv1 = IDS[(size_t)t * NSEL + 64 + lane];
                const float gv0 = GT[(size_t)t * NSEL + lane], gv1 = GT[(size_t)t * NSEL + 64 + lane];
                for (int e0 = 0; e0 < NSEL; e0 += 2) {
                    int id[2]; float gt[2];
#pragma unroll
                    for (int k = 0; k < 2; ++k) { const int e = e0 + k; id[k] = __builtin_amdgcn_readlane(e < 64 ? idv0 : idv1, e & 63); gt[k] = __uint_as_float(__builtin_amdgcn_readlane(__float_as_uint(e < 64 ? gv0 : gv1), e & 63)); }
                    u32x4 uw[2][4], vw[2][4];
#pragma unroll
                    for (int k = 0; k < 2; ++k)
#pragma unroll
                        for (int j = 0; j < 4; ++j) { uw[k][j] = *(const u32x4*)(TU + (size_t)id[k] * DM + j * 512 + lane * 8); vw[k][j] = *(const u32x4*)(TV + (size_t)id[k] * DM + j * 512 + lane * 8); }
#pragma unroll
                    for (int k = 0; k < 2; ++k) { float d = 0.f;
#pragma unroll
                        for (int j = 0; j < 4; ++j) { const u32x4 w = uw[k][j];
                            d = fmaf(hf[j * 8 + 0], bflo(w.x), d); d = fmaf(hf[j * 8 + 1], bfhi(w.x), d); d = fmaf(hf[j * 8 + 2], bflo(w.y), d); d = fmaf(hf[j * 8 + 3], bfhi(w.y), d);
                            d = fmaf(hf[j * 8 + 4], bflo(w.z), d); d = fmaf(hf[j * 8 + 5], bfhi(w.z), d); d = fmaf(hf[j * 8 + 6], bflo(w.w), d); d = fmaf(hf[j * 8 + 7], bfhi(w.w), d); }
                        d = wave_sum(d) * rs;
                        const float wgt = gt[k] * 0.5f * d * (1.f + erff(d * 0.7071067811865476f));
#pragma unroll
                        for (int j = 0; j < 4; ++j) { const u32x4 w = vw[k][j];
                            acc[j * 8 + 0] = fmaf(wgt, bflo(w.x), acc[j * 8 + 0]); acc[j * 8 + 1] = fmaf(wgt, bfhi(w.x), acc[j * 8 + 1]); acc[j * 8 + 2] = fmaf(wgt, bflo(w.y), acc[j * 8 + 2]); acc[j * 8 + 3] = fmaf(wgt, bfhi(w.y), acc[j * 8 + 3]);
                            acc[j * 8 + 4] = fmaf(wgt, bflo(w.z), acc[j * 8 + 4]); acc[j * 8 + 5] = fmaf(wgt, bfhi(w.z), acc[j * 8 + 5]); acc[j * 8 + 6] = fmaf(wgt, bflo(w.w), acc[j * 8 + 6]); acc[j * 8 + 7] = fmaf(wgt, bfhi(w.w), acc[j * 8 + 7]); } }
                }
                float ss = 0.f;
#pragma unroll
                for (int j = 0; j < 4; ++j) { float* xr = X + (size_t)t * DM + j * 512 + lane * 8; const f32x4 x0 = *(const f32x4*)xr, x1 = *(const f32x4*)(xr + 4);
#pragma unroll
                    for (int q = 0; q < 4; ++q) { acc[j * 8 + q] += x0[q]; acc[j * 8 + 4 + q] += x1[q]; }
#pragma unroll
                    for (int q = 0; q < 8; ++q) ss += acc[j * 8 + q] * acc[j * 8 + q]; }
                ss = wave_sum(ss);
                const float rn = 1.f / sqrtf(ss * (1.f / DM) + EPS);
                if (layer == 0) {
#pragma unroll
                    for (int j = 0; j < 4; ++j) { float* xr = X + (size_t)t * DM + j * 512 + lane * 8;
                        *(f32x4*)xr = (f32x4){acc[j * 8 + 0], acc[j * 8 + 1], acc[j * 8 + 2], acc[j * 8 + 3]}; *(f32x4*)(xr + 4) = (f32x4){acc[j * 8 + 4], acc[j * 8 + 5], acc[j * 8 + 6], acc[j * 8 + 7]};
                        u32x4 w; w.x = pk2(acc[j * 8 + 0], acc[j * 8 + 1]); w.y = pk2(acc[j * 8 + 2], acc[j * 8 + 3]); w.z = pk2(acc[j * 8 + 4], acc[j * 8 + 5]); w.w = pk2(acc[j * 8 + 6], acc[j * 8 + 7]);
                        *(u32x4*)(XB + (size_t)t * DM + j * 512 + lane * 8) = w; }
                    if (lane == 0) rstd[t] = rn;
                } else {
#pragma unroll
                    for (int j = 0; j < 4; ++j) { float* xr = X + (size_t)t * DM + j * 512 + lane * 8; const float* gp = fg + j * 512 + lane * 8; const f32x4 g0 = *(const f32x4*)gp, g1 = *(const f32x4*)(gp + 4);
                        *(f32x4*)xr = (f32x4){acc[j * 8 + 0] * rn * g0[0], acc[j * 8 + 1] * rn * g0[1], acc[j * 8 + 2] * rn * g0[2], acc[j * 8 + 3] * rn * g0[3]};
                        *(f32x4*)(xr + 4) = (f32x4){acc[j * 8 + 4] * rn * g1[0], acc[j * 8 + 5] * rn * g1[1], acc[j * 8 + 6] * rn * g1[2], acc[j * 8 + 7] * rn * g1[3]}; }
                }
            }
        }
}

__global__ void __launch_bounds__(NTHR, 2) fwd(Args args) {
    extern __shared__ __attribute__((aligned(16))) unsigned char lds_raw[];
    LAS unsigned char* lds = (LAS unsigned char*)lds_raw;
    volatile LAS unsigned* MISC = (volatile LAS unsigned*)(lds + MISC_OFF);
    const int wave = __builtin_amdgcn_readfirstlane(threadIdx.x >> 6);
    const int G = gridDim.x, bx = blockIdx.x;
    unsigned* ctl = (unsigned*)(args.ws + WS_CTL);
    for (int u = threadIdx.x; u < (LDS_BYTES - RING_BYTES) / 4; u += NTHR) ((LAS unsigned*)(lds + RING_BYTES))[u] = 0u;
    __syncthreads();
    XcdBarrier bar; bar.bar = ctl + CW_BAR; bar.x = 0; bar.st = nullptr;
    const int lo = args.ph_lo, hi = args.ph_hi;
    const bool multi = (hi - lo) > 1;
    if (multi) bar = xcd_barrier_post(ctl + CW_BAR, MISC + 8);

    if (SITE(0) && IN(0)) { PH_LOCALS;
        LAS float* scr = (LAS float*)(lds + wave * 16384);
        const float* sbg = (const float*)AIN(IN_SBG); const float* kvg = (const float*)AIN(IN_KVG); const float* mlag = (const float*)AIN(IN_MLAG);
        const float* kvlg = (const float*)AIN(IN_KVLG); const float* qlg = (const float*)AIN(IN_QLG); const float* pg = (const float*)AIN(IN_PG);
        constexpr int I_QKV = 32 * 192, I_WO = 32 * 64, I_DKV = 32 * 18, I_DQ = 32 * 16, I_UKV = 8 * 128, I_UQ = 8 * 96, I_MO = 32 * 64, I_PQ = 32 * 64;
        constexpr int NITEMS = I_QKV + I_WO + I_DKV + I_DQ + I_UKV + I_UQ + I_MO + 2 * I_PQ;
        for (int it = gw; it < NITEMS; it += NGW) {
            int r = it;
            if (r < I_QKV) { transpose_item((const float*)AIN(IN_WQKV), 6144, 2048, 192, sbg, (bf16_t*)(ws + WS_WQKV), 0, scr, r, lane); continue; } r -= I_QKV;
            if (r < I_WO) { transpose_item((const float*)AIN(IN_WO), 2048, 2048, 64, nullptr, (bf16_t*)(ws + WS_WO), 0, scr, r, lane); continue; } r -= I_WO;
            if (r < I_DKV) { transpose_item((const float*)AIN(IN_WDKV), 576, 2048, 18, kvg, (bf16_t*)(ws + WS_WDKQ), 0, scr, r, lane); continue; } r -= I_DKV;
            if (r < I_DQ) { transpose_item((const float*)AIN(IN_WDQ), 512, 2048, 16, mlag, (bf16_t*)(ws + WS_WDKQ), 576, scr, r, lane); continue; } r -= I_DQ;
            if (r < I_UKV) { transpose_item((const float*)AIN(IN_WUKV), 4096, 512, 128, kvlg, (bf16_t*)(ws + WS_WUKV), 0, scr, r, lane); continue; } r -= I_UKV;
            if (r < I_UQ) { transpose_item((const float*)AIN(IN_WUQ), 3072, 512, 96, qlg, (bf16_t*)(ws + WS_WUQ), 0, scr, r, lane); continue; } r -= I_UQ;
            if (r < I_MO) { transpose_item((const float*)AIN(IN_WMO), 2048, 2048, 64, nullptr, (bf16_t*)(ws + WS_WMO), 0, scr, r, lane); continue; } r -= I_MO;
            if (r < I_PQ) { transpose_item((const float*)AIN(IN_PWQ), 2048, 2048, 64, pg, (bf16_t*)(ws + WS_WPQ), 0, scr, r, lane); continue; } r -= I_PQ;
            transpose_item((const float*)AIN(IN_PWQ) + (size_t)DM * DM, 2048, 2048, 64, pg + DM, (bf16_t*)(ws + WS_WPQ) + (size_t)DM * DM, 0, scr, r, lane);
        }
        { u32x4 z = {0u, 0u, 0u, 0u}; bf16_t* p = (bf16_t*)(ws + WS_WDKQ) + (size_t)1088 * DM; for (int i = gtid; i < 192 * DM / 8; i += gthreads) *(u32x4*)(p + (size_t)i * 8) = z; }
        { const float* k1 = (const float*)AIN(IN_PK1); const float* k2 = (const float*)AIN(IN_PK2); bf16_t* kbd = (bf16_t*)(ws + WS_KBD);
          for (int i = gtid; i < 2 * 2048 * 256; i += gthreads) { const int kk = i & 255, n = (i >> 8) & 255, hh = (i >> 16) & 7, l = i >> 19; float v = 0.f;
              if (n < 128) { if (kk < 128) v = k1[(((size_t)l * PH + hh) * NKEYS + n) * 128 + kk]; } else { if (kk >= 128) v = k2[(((size_t)l * PH + hh) * NKEYS + (n - 128)) * 128 + (kk - 128)]; }
              kbd[i] = (bf16_t)f2bf(v); } }
        convert_tables((const float*)AIN(IN_PU), (const float*)AIN(IN_PV), pg, (bf16_t*)(ws + WS_TU), (bf16_t*)(ws + WS_TV), gtid, gthreads);
        for (int m = gw; m < T; m += NGW) row_to_bf16_rstd(x_in + (size_t)m * DM, XB + (size_t)m * DM, rstd + m, lane);
        { const int* pos = (const int*)AIN(IN_POS);
          for (int i = gtid; i < T * 32; i += gthreads) { const int t = i >> 5, j = i & 31; const float inv = powf(10000.f, -(float)(2 * j) / 64.f); const float ang = (float)pos[t] * inv;
              cs[2 * i] = cosf(ang); cs[2 * i + 1] = sinf(ang); } }
    }
    SEAM(0);

    {
        {
            if (SITE(1) && IN(1)) { PH_LOCALS;
                pg8::Gemm g{XB, (const bf16_t*)(ws + WS_WQKV), T, 3 * DM, DM, DM, 0}; pg8::StaticOrder S; S.init(T, 3 * DM, G, bx);
                pg8::EpiQKV E{(bf16_t*)(ws + WS_Q), (size_t)(WS_K - WS_Q) / 2, rstd, 0.08838834764831845f * LOG2E};
                pg8::gemm_phase<pg8::EpiQKV>(lds, g, S, E, wave, lane);
            }
            SEAM(1);
            if (SITE(2) && IN(2)) { PH_LOCALS;
                const int bh = bx >> 1, half = bx & 1, b = bh >> 4, h = bh & 15;
                if (bx < 256) {
                    const bf16_t* Qp = (const bf16_t*)(ws + WS_Q) + (size_t)b * SEQ * DM + h * HD; const bf16_t* Kp = (const bf16_t*)(ws + WS_K) + (size_t)b * SEQ * DM + h * HD;
                    const bf16_t* Vp = (const bf16_t*)(ws + WS_V) + (size_t)b * SEQ * DM + h * HD; bf16_t* Op = XB + (size_t)b * SEQ * DM + h * HD;
                    for (int i = 0; i < 8; ++i) { const int qb = 15 - (2 * i + ((i & 1) ^ half));
                        att::attn_unit<0>(lds, Qp, DM, Kp, Vp, DM, nullptr, nullptr, Op, DM, qb * 256, wave, lane); }
                }
            }
            SEAM(2);
            if (SITE(3) && IN(3)) { PH_LOCALS;
                pg8::Gemm g{XB, (const bf16_t*)(ws + WS_WO), T, DM, DM, DM, 0}; pg8::StaticOrder S; S.init(T, DM, G, bx);
                pg8::EpiRes E{X, x_in, DM};
                pg8::gemm_phase<pg8::EpiRes>(lds, g, S, E, wave, lane);
            }
            SEAM(3);
        }
        peer_phases<0>(lds, lo, hi, bar, wave, G, bx);
        SEAM(8);
        {
            if (SITE(9) && IN(9)) { PH_LOCALS;
                pg8::Gemm g{XB, (const bf16_t*)(ws + WS_WDKQ), T, NDKQ, DM, DM, 0}; pg8::StaticOrder S; S.init(T, NDKQ, G, bx);
                pg8::EpiF32 E{(float*)(ws + WS_DKQ), NDKQ, rstd};
                pg8::gemm_phase<pg8::EpiF32>(lds, g, S, E, wave, lane);
            }
            SEAM(9);
            if (SITE(10) && IN(10)) { PH_LOCALS;
                const float* dkq = (const float*)(ws + WS_DKQ); bf16_t* CB = (bf16_t*)(ws + WS_CB); bf16_t* CQB = (bf16_t*)(ws + WS_CQB); bf16_t* KR = (bf16_t*)(ws + WS_KR);
                for (int m = gw; m < T; m += NGW) { const float* r = dkq + (size_t)m * NDKQ;
                    const f32x4 a0 = *(const f32x4*)(r + lane * 8), a1 = *(const f32x4*)(r + lane * 8 + 4);
                    const f32x4 q0 = *(const f32x4*)(r + 576 + lane * 8), q1 = *(const f32x4*)(r + 576 + lane * 8 + 4);
                    float sa = a0[0] * a0[0] + a0[1] * a0[1] + a0[2] * a0[2] + a0[3] * a0[3] + a1[0] * a1[0] + a1[1] * a1[1] + a1[2] * a1[2] + a1[3] * a1[3];
                    float sq = q0[0] * q0[0] + q0[1] * q0[1] + q0[2] * q0[2] + q0[3] * q0[3] + q1[0] * q1[0] + q1[1] * q1[1] + q1[2] * q1[2] + q1[3] * q1[3];
                    sa = wave_sum(sa); sq = wave_sum(sq);
                    const float ra = 1.f / sqrtf(sa * (1.f / KVL) + EPS), rq = 1.f / sqrtf(sq * (1.f / QL) + EPS);
                    u32x4 w; w.x = pk2(a0[0] * ra, a0[1] * ra); w.y = pk2(a0[2] * ra, a0[3] * ra); w.z = pk2(a1[0] * ra, a1[1] * ra); w.w = pk2(a1[2] * ra, a1[3] * ra);
                    *(u32x4*)(CB + (size_t)m * KVL + lane * 8) = w;
                    u32x4 y; y.x = pk2(q0[0] * rq, q0[1] * rq); y.y = pk2(q0[2] * rq, q0[3] * rq); y.z = pk2(q1[0] * rq, q1[1] * rq); y.w = pk2(q1[2] * rq, q1[3] * rq);
                    *(u32x4*)(CQB + (size_t)m * QL + lane * 8) = y;
                    if (lane < 32) { const float x1 = r[512 + lane], x2 = r[512 + 32 + lane], co = cs[((size_t)m * 32 + lane) * 2], si = cs[((size_t)m * 32 + lane) * 2 + 1];
                        KR[(size_t)m * 64 + lane] = (bf16_t)f2bf(x1 * co - x2 * si); KR[(size_t)m * 64 + 32 + lane] = (bf16_t)f2bf(x2 * co + x1 * si); } }
            }
            SEAM(10);
            if (SITE(11) && IN(11)) { PH_LOCALS;
                pg8::Gemm g{(const bf16_t*)(ws + WS_CB), (const bf16_t*)(ws + WS_WUKV), T, 4096, KVL, KVL, 0}; pg8::StaticOrder S; S.init(T, 4096, G, bx);
                pg8::EpiUKV E{(bf16_t*)(ws + WS_KN), (bf16_t*)(ws + WS_VM), nullptr};
                pg8::gemm_phase<pg8::EpiUKV>(lds, g, S, E, wave, lane);
            }
            SEAM(11);
            if (SITE(12) && IN(12)) { PH_LOCALS;
                pg8::Gemm g{(const bf16_t*)(ws + WS_CQB), (const bf16_t*)(ws + WS_WUQ), T, 3072, QL, QL, 0}; pg8::StaticOrder S; S.init(T, 3072, G, bx);
                pg8::EpiB16 E{(bf16_t*)(ws + WS_QM), 3072, nullptr};
                pg8::gemm_phase<pg8::EpiB16>(lds, g, S, E, wave, lane);
            }
            SEAM(12);
            if (SITE(13) && IN(13)) { PH_LOCALS;
                const int bh = bx >> 1, half = bx & 1, b = bh >> 4, h = bh & 15;
                if (bx < 256) {
                    const bf16_t* Qp = (const bf16_t*)(ws + WS_QM) + (size_t)b * SEQ * 3072 + h * 192; const bf16_t* Kp = (const bf16_t*)(ws + WS_KN) + (size_t)b * SEQ * DM + h * HD;
                    const bf16_t* Vp = (const bf16_t*)(ws + WS_VM) + (size_t)b * SEQ * DM + h * HD; const bf16_t* Rp = (const bf16_t*)(ws + WS_KR) + (size_t)b * SEQ * 64;
                    bf16_t* Op = XB + (size_t)b * SEQ * DM + h * HD;
                    for (int i = 0; i < 8; ++i) { const int qb = 15 - (2 * i + ((i & 1) ^ half));
                        att::attn_unit<1>(lds, Qp, 3072, Kp, Vp, DM, Rp, cs + (size_t)b * SEQ * 64, Op, DM, qb * 256, wave, lane); }
                }
            }
            SEAM(13);
            if (SITE(14) && IN(14)) { PH_LOCALS;
                pg8::Gemm g{XB, (const bf16_t*)(ws + WS_WMO), T, DM, DM, DM, 0}; pg8::StaticOrder S; S.init(T, DM, G, bx);
                pg8::EpiRes E{X, X, DM};
                pg8::gemm_phase<pg8::EpiRes>(lds, g, S, E, wave, lane);
            }
            SEAM(14);
        }
        peer_phases<1>(lds, lo, hi, bar, wave, G, bx);
    }
#undef IN
#undef SEAM
}

extern "C" void kernel_launch(void* const* d_in, const int* in_sizes, int n_in, void* d_out, int out_size, void* d_ws, size_t ws_size, hipStream_t stream) {
    static int grid = 0;
    if (grid == 0) {
        if (n_in != 21 || out_size != T * DM || ws_size < WS_END) { fprintf(stderr, "kernel_launch: unexpected shapes (n_in %d out %d ws %zu need %zu)\n", n_in, out_size, ws_size, (size_t)WS_END); grid = -1; return; }
        int dev = 0, cus = 0, per_cu = 0;
        if (hipGetDevice(&dev) != hipSuccess || hipDeviceGetAttribute(&cus, hipDeviceAttributeMultiprocessorCount, dev) != hipSuccess) { grid = -1; return; }
        if (hipFuncSetAttribute((const void*)fwd, hipFuncAttributeMaxDynamicSharedMemorySize, LDS_BYTES) != hipSuccess) { fprintf(stderr, "kernel_launch: hipFuncSetAttribute failed\n"); grid = -1; return; }
        if (hipOccupancyMaxActiveBlocksPerMultiprocessor(&per_cu, (const void*)fwd, NTHR, LDS_BYTES) != hipSuccess || per_cu < 1) fprintf(stderr, "kernel_launch: occupancy query reports %d\n", per_cu);
        (void)hipGetLastError();
        grid = cus < 256 ? cus : 256;
    }
    if (grid < 0) return;
    (void)hipMemsetAsync((char*)d_ws + WS_CTL, 0, CTL_ZERO_BYTES, stream);
    Args a{};
    for (int i = 0; i < 21; ++i) a.in[i] = d_in[i];
    a.out = (float*)d_out; a.ws = (unsigned char*)d_ws;
#if MK_ONE_LAUNCH
    a.ph_lo = 0; a.ph_hi = 20;
    hipLaunchKernelGGL(fwd, dim3(grid), dim3(NTHR), LDS_BYTES, stream, a);
#else
    for (int ph = 0; ph < 20; ++ph) { a.ph_lo = ph; a.ph_hi = ph + 1; hipLaunchKernelGGL(fwd, dim3(grid), dim3(NTHR), LDS_BYTES, stream, a); }
#endif
}
```

```cpp
#include <hip/hip_runtime.h>
#include <cstdio>
#include <cstdint>

#ifndef MK_ONE_LAUNCH
#define MK_ONE_LAUNCH 1
#endif

#define LAS __attribute__((address_space(3)))
#define GAS __attribute__((address_space(1)))
typedef unsigned short bf16_t;
typedef short bf16x8 __attribute__((ext_vector_type(8)));
typedef short s16x4 __attribute__((ext_vector_type(4)));
typedef float f32x2 __attribute__((ext_vector_type(2)));
typedef float f32x4 __attribute__((ext_vector_type(4)));
typedef float f32x16 __attribute__((ext_vector_type(16)));
typedef unsigned u32x2 __attribute__((ext_vector_type(2)));
typedef unsigned u32x4 __attribute__((ext_vector_type(4)));
typedef __bf16 bf16v2 __attribute__((ext_vector_type(2)));
__device__ __forceinline__ float dot2bf(unsigned a, unsigned b, float c) { return __builtin_amdgcn_fdot2_f32_bf16(__builtin_bit_cast(bf16v2, a), __builtin_bit_cast(bf16v2, b), c, false); }

constexpr int NB = 8, SEQ = 4096, DM = 2048, T = NB * SEQ, NH = 16, HD = 128;
constexpr int KVL = 512, QKR = 64, QL = 512, NEXP = 16384, PH = 8, NKEYS = 128, TOPK = 16, NSEL = PH * TOPK;
constexpr int NDKQ = 1280;
constexpr float EPS = 1e-6f;
constexpr float LOG2E = 1.4426950408889634f;
constexpr int NWAVES = 8, NTHR = 512;

constexpr size_t MiB = 1u << 20;
constexpr size_t WS_CTL = 0, CTL_ZERO_BYTES = 1 * MiB;
constexpr size_t WS_RSTD = 1 * MiB;
constexpr size_t WS_CS = 2 * MiB;
constexpr size_t WS_WQKV = 16 * MiB;
constexpr size_t WS_WO = 40 * MiB;
constexpr size_t WS_WDKQ = 48 * MiB;
constexpr size_t WS_WUKV = 54 * MiB;
constexpr size_t WS_WUQ = 58 * MiB;
constexpr size_t WS_WMO = 62 * MiB;
constexpr size_t WS_WPQ = 70 * MiB;
constexpr size_t WS_KBD = 86 * MiB;
constexpr size_t WS_TU = 96 * MiB;
constexpr size_t WS_TV = 160 * MiB;
constexpr size_t WS_CB = 96 * MiB;
constexpr size_t WS_CQB = 128 * MiB;
constexpr size_t WS_XB = 224 * MiB;
constexpr size_t WS_R0 = 352 * MiB;
constexpr size_t WS_Q = WS_R0, WS_K = WS_R0 + 128 * MiB, WS_V = WS_R0 + 256 * MiB;
constexpr size_t WS_KN = WS_R0, WS_VM = WS_R0 + 128 * MiB, WS_QM = WS_R0 + 256 * MiB;
constexpr size_t WS_KR = WS_R0 + 448 * MiB;
constexpr size_t WS_QP = WS_R0, WS_SC = WS_R0 + 128 * MiB, WS_IDS = WS_R0 + 384 * MiB, WS_GATE = WS_R0 + 400 * MiB;
constexpr size_t WS_DKQ = WS_R0 + 256 * MiB;
constexpr size_t WS_END = WS_R0 + 452 * MiB;

constexpr int CW_TMO = 0, CW_CHK = 2, CW_BAR = 4096;

__device__ __forceinline__ unsigned f2bf(float f) { unsigned u = __builtin_bit_cast(unsigned, f); return (u + 0x7fffu + ((u >> 16) & 1u)) >> 16; }
__device__ __forceinline__ unsigned pk2(float lo, float hi) { return f2bf(lo) | (f2bf(hi) << 16); }
__device__ __forceinline__ float bflo(unsigned w) { return __builtin_bit_cast(float, w << 16); }
__device__ __forceinline__ float bfhi(unsigned w) { return __builtin_bit_cast(float, w & 0xffff0000u); }
__device__ __forceinline__ float bf2f(bf16_t h) { return __builtin_bit_cast(float, (unsigned)h << 16); }
__device__ __forceinline__ unsigned cvtpk(float lo, float hi) { unsigned r; asm volatile("v_cvt_pk_bf16_f32 %0, %1, %2" : "=v"(r) : "v"(lo), "v"(hi)); return r; }
__device__ __forceinline__ float wave_sum(float v) {
#pragma unroll
    for (int o = 1; o < 64; o <<= 1) v += __shfl_xor(v, o);
    return v;
}
__device__ __forceinline__ unsigned wave_max_u32(unsigned v) {
#pragma unroll
    for (int o = 1; o < 64; o <<= 1) { unsigned w = (unsigned)__shfl_xor((int)v, o); v = v > w ? v : w; }
    return v;
}
__device__ __forceinline__ int lane_id_v() { int l; asm volatile("v_mbcnt_lo_u32_b32 %0, -1, 0\n\tv_mbcnt_hi_u32_b32 %0, -1, %0" : "=v"(l)); return l; }
#define LDS_WAIT() asm volatile("s_waitcnt lgkmcnt(0)" ::: "memory")
#define VM_WAIT() asm volatile("s_waitcnt vmcnt(0)" ::: "memory")
#define SBAR() __builtin_amdgcn_sched_barrier(0)

namespace pg8 {
constexpr int BM = 256, BK = 64, HALF = 128, HTB = HALF * BK * 2, STAGE_BYTES = 8 * HTB, NXCD = 8, WGM = 8;
__host__ __device__ __forceinline__ int lds_byte(int r, int c) { const int st = (r >> 4) * 2 + (c >> 5), rr = r & 15, cc = c & 31, ob = rr * 64 + cc * 2; return st * 1024 + (ob ^ (((ob >> 9) & 1) << 5)); }
__host__ __device__ __forceinline__ void stage_rc(int b, int& R, int& C) { const int st = b / 1024, sb = b % 1024, swz = sb ^ (((sb >> 9) & 1) << 5); R = (st >> 1) * 16 + swz / 64; C = (st & 1) * 32 + (swz % 64) / 2; }
__host__ __device__ __forceinline__ int perm32(int rho) { const int n = rho >> 4, i = rho & 15; return 8 * (i >> 2) + 4 * n + (i & 3); }
struct Unit { int pm, pn; };
struct Gemm { const bf16_t* A; const bf16_t* Bt; int M, N, K, lda, a_pn; };
struct StaticOrder {
    int nM, nN, nwg, G, c;
    __device__ void init(int M, int N, int G_, int c_) { nM = M / BM; nN = N / BM; nwg = nM * nN; G = G_; c = c_; }
    __device__ bool next(int i, Unit& u) const {
        const long L = (long)i * G + c; if (L >= nwg) return false;
        int wgid = (int)L; { const int q = nwg / NXCD, r = nwg % NXCD, xcd = wgid % NXCD, off = wgid / NXCD; wgid = (xcd < r ? xcd * (q + 1) : r * (q + 1) + (xcd - r) * q) + off; }
        const int nig = WGM * nN, gid = wgid / nig, fm = gid * WGM, gsz = (nM - fm) < WGM ? (nM - fm) : WGM;
        u.pm = fm + ((wgid % nig) % gsz); u.pn = (wgid % nig) / gsz; return true;
    }
};
struct EpiQKV {
    static constexpr bool PERM = true;
    bf16_t* Q; size_t split_stride; const float* rstd; float qscale;
    __device__ __forceinline__ void operator()(const f32x4 (&acc)[2][2][4][2], const Unit& u, int wr, int wc, int fr, int fq) const {
        const int row0 = u.pm * BM + wr * 64 + fr; int colt = u.pn * BM; const int t = colt / DM; bf16_t* base = Q + (size_t)t * split_stride; colt -= t * DM;
        const float sc = t == 0 ? qscale : 1.f; const int col0 = colt + wc * 32 + 8 * fq;
#pragma unroll
        for (int ai = 0; ai < 2; ++ai)
#pragma unroll
            for (int m = 0; m < 4; ++m) { const int row = row0 + ai * HALF + m * 16; const float rs = rstd[row] * sc; bf16_t* rowp = base + (size_t)row * DM + col0;
#pragma unroll
                for (int bj = 0; bj < 2; ++bj) { const f32x4 v0 = acc[ai][bj][m][0] * rs, v1 = acc[ai][bj][m][1] * rs;
                    u32x4 w; w.x = cvtpk(v0[0], v0[1]); w.y = cvtpk(v0[2], v0[3]); w.z = cvtpk(v1[0], v1[1]); w.w = cvtpk(v1[2], v1[3]);
                    *(u32x4*)(rowp + bj * HALF) = w; } }
    }
};
struct EpiB16 {
    static constexpr bool PERM = true;
    bf16_t* O; int ldc; const float* rstd;
    __device__ __forceinline__ void operator()(const f32x4 (&acc)[2][2][4][2], const Unit& u, int wr, int wc, int fr, int fq) const {
        const int row0 = u.pm * BM + wr * 64 + fr, col0 = u.pn * BM + wc * 32 + 8 * fq;
#pragma unroll
        for (int ai = 0; ai < 2; ++ai)
#pragma unroll
            for (int m = 0; m < 4; ++m) { const int row = row0 + ai * HALF + m * 16; const float rs = rstd ? rstd[row] : 1.f; bf16_t* rowp = O + (size_t)row * ldc + col0;
#pragma unroll
                for (int bj = 0; bj < 2; ++bj) { const f32x4 v0 = acc[ai][bj][m][0] * rs, v1 = acc[ai][bj][m][1] * rs;
                    u32x4 w; w.x = cvtpk(v0[0], v0[1]); w.y = cvtpk(v0[2], v0[3]); w.z = cvtpk(v1[0], v1[1]); w.w = cvtpk(v1[2], v1[3]);
                    *(u32x4*)(rowp + bj * HALF) = w; } }
    }
};
struct EpiUKV {
    static constexpr bool PERM = true;
    bf16_t* KN; bf16_t* VM; const float* rstd;
    __device__ __forceinline__ void operator()(const f32x4 (&acc)[2][2][4][2], const Unit& u, int wr, int wc, int fr, int fq) const {
        const int row0 = u.pm * BM + wr * 64 + fr, col0 = u.pn * HD + wc * 32 + 8 * fq;
#pragma unroll
        for (int ai = 0; ai < 2; ++ai)
#pragma unroll
            for (int m = 0; m < 4; ++m) { const int row = row0 + ai * HALF + m * 16; const float rs = rstd ? rstd[row] : 1.f;
#pragma unroll
                for (int bj = 0; bj < 2; ++bj) { const f32x4 v0 = acc[ai][bj][m][0] * rs, v1 = acc[ai][bj][m][1] * rs;
                    u32x4 w; w.x = cvtpk(v0[0], v0[1]); w.y = cvtpk(v0[2], v0[3]); w.z = cvtpk(v1[0], v1[1]); w.w = cvtpk(v1[2], v1[3]);
                    *(u32x4*)((bj ? VM : KN) + (size_t)row * DM + col0) = w; } }
    }
};
struct EpiF32 {
    static constexpr bool PERM = false;
    float* C; int ldc; const float* rstd;
    __device__ __forceinline__ void operator()(const f32x4 (&acc)[2][2][4][2], const Unit& u, int wr, int wc, int fr, int fq) const {
        const int row0 = u.pm * BM + wr * 64 + fr, col0 = u.pn * BM + wc * 32 + 4 * fq;
#pragma unroll
        for (int ai = 0; ai < 2; ++ai)
#pragma unroll
            for (int m = 0; m < 4; ++m) { const int row = row0 + ai * HALF + m * 16; const float rs = rstd ? rstd[row] : 1.f; float* rowp = C + (size_t)row * ldc + col0;
#pragma unroll
                for (int bj = 0; bj < 2; ++bj)
#pragma unroll
                    for (int n = 0; n < 2; ++n) *(f32x4*)(rowp + bj * HALF + n * 16) = acc[ai][bj][m][n] * rs; }
    }
};
struct EpiRes {
    static constexpr bool PERM = false;
    float* C; const float* base; int ldc;
    __device__ __forceinline__ void operator()(const f32x4 (&acc)[2][2][4][2], const Unit& u, int wr, int wc, int fr, int fq) const {
        const int row0 = u.pm * BM + wr * 64 + fr, col0 = u.pn * BM + wc * 32 + 4 * fq;
#pragma unroll
        for (int ai = 0; ai < 2; ++ai)
#pragma unroll
            for (int m = 0; m < 4; ++m) { const size_t ro = (size_t)(row0 + ai * HALF + m * 16) * ldc + col0;
#pragma unroll
                for (int bj = 0; bj < 2; ++bj)
#pragma unroll
                    for (int n = 0; n < 2; ++n) { const f32x4 b = *(const f32x4*)(base + ro + bj * HALF + n * 16); *(f32x4*)(C + ro + bj * HALF + n * 16) = acc[ai][bj][m][n] + b; } }
    }
};

template <class Epi>
__device__ __forceinline__ void gemm_phase(LAS unsigned char* lds, const Gemm g, const StaticOrder& S, const Epi& E, const int wid, const int lane) {
    const int tid = wid * 64 + lane, wr = wid >> 2, wc = wid & 3, fr = lane & 15, fq = lane >> 4;
    const int K = g.K, nt = K / BK, lda = g.lda;
    unsigned voffA[2], voffB[2];
#pragma unroll
    for (int i = 0; i < 2; ++i) { int R, C; stage_rc(tid * 16 + i * 8192, R, C); const int Rb = Epi::PERM ? ((R & ~31) + perm32(R & 31)) : R;
        voffA[i] = (unsigned)(R * lda + C) * 2u; voffB[i] = (unsigned)(Rb * K + C) * 2u; }
    const size_t kstep = (size_t)(BK * 2);
    const size_t hstepA = (size_t)HALF * lda * 2, hstepB = (size_t)HALF * K * 2;
    const size_t tstepA = 2 * hstepA, tstepB = 2 * hstepB;
    const unsigned ldsw = (unsigned)wid * 1024u;
    const int aoff = lds_byte(wr * 64 + fr, fq * 8), boff = lds_byte(wc * 32 + fr, fq * 8);
#define PG8_SA(b, h) (((b) * 2 + (h)) * HTB)
#define PG8_SB(b, h) ((4 + (b) * 2 + (h)) * HTB)
#define PG8_STAGE(bufoff, gbase, voff) do { _Pragma("unroll") for (int _i = 0; _i < 2; ++_i) \
        __builtin_amdgcn_global_load_lds((const unsigned*)((const char*)(gbase) + (voff)[_i]), (LAS unsigned*)(lds + (bufoff) + ldsw + _i * 8192), 16, 0, 0); } while (0)
#define PG8_LDA(dst, b, h) do { _Pragma("unroll") for (int m = 0; m < 4; ++m) _Pragma("unroll") for (int k = 0; k < 2; ++k) dst[m][k] = *(const LAS bf16x8*)(lds + PG8_SA(b, h) + aoff + m * 2048 + k * 1024); } while (0)
#define PG8_LDB(dst, b, h) do { _Pragma("unroll") for (int n = 0; n < 2; ++n) _Pragma("unroll") for (int k = 0; k < 2; ++k) dst[n][k] = *(const LAS bf16x8*)(lds + PG8_SB(b, h) + boff + n * 2048 + k * 1024); } while (0)
#define PG8_MMA(ai, bj, At, Bt) do { __builtin_amdgcn_s_setprio(1); _Pragma("unroll") for (int m = 0; m < 4; ++m) _Pragma("unroll") for (int n = 0; n < 2; ++n) _Pragma("unroll") for (int k = 0; k < 2; ++k) \
        acc[ai][bj][m][n] = __builtin_amdgcn_mfma_f32_16x16x32_bf16(Bt[n][k], At[m][k], acc[ai][bj][m][n], 0, 0, 0); __builtin_amdgcn_s_setprio(0); } while (0)
#define PG8_WAIT_V(n) asm volatile("s_waitcnt vmcnt(" #n ")" ::: "memory")
#define PG8_WAIT_L(n) asm volatile("s_waitcnt lgkmcnt(" #n ")" ::: "memory")
#define PG8_BAR __builtin_amdgcn_s_barrier()
#define PG8_SCHED __builtin_amdgcn_sched_barrier(0)
    Unit cur, nxt; int ui = 0;
    if (!S.next(0, cur)) return;
    f32x4 acc[2][2][4][2];
#pragma unroll
    for (int a = 0; a < 2; ++a)
#pragma unroll
        for (int b = 0; b < 2; ++b)
#pragma unroll
            for (int m = 0; m < 4; ++m)
#pragma unroll
                for (int n = 0; n < 2; ++n) acc[a][b][m][n] = (f32x4){0.f, 0.f, 0.f, 0.f};
    bf16x8 At[4][2], B0[2][2], B1[2][2];
    const char* cA = (const char*)g.A + (size_t)cur.pm * tstepA + (size_t)cur.pn * g.a_pn * 2; const char* cB = (const char*)g.Bt + (size_t)cur.pn * tstepB;
    PG8_STAGE(PG8_SB(0, 0), cB, voffB); PG8_STAGE(PG8_SB(0, 1), cB + hstepB, voffB); PG8_STAGE(PG8_SA(0, 0), cA, voffA); PG8_STAGE(PG8_SA(0, 1), cA + hstepA, voffA);
    if (wr == 1) PG8_BAR;
    PG8_WAIT_V(2); PG8_BAR;
    PG8_STAGE(PG8_SB(1, 0), cB + kstep, voffB); PG8_STAGE(PG8_SA(1, 0), cA + kstep, voffA); PG8_STAGE(PG8_SB(1, 1), cB + hstepB + kstep, voffB);
    PG8_WAIT_V(6); PG8_BAR;
#pragma unroll 1
    for (;;) {
        const bool has_next = S.next(ui + 1, nxt);
        const char* nA = has_next ? (const char*)g.A + (size_t)nxt.pm * tstepA + (size_t)nxt.pn * g.a_pn * 2 : cA; const char* nB = has_next ? (const char*)g.Bt + (size_t)nxt.pn * tstepB : cB;
#pragma unroll 1
        for (int t = 0; t < nt; t += 2) {
            const bool last = (t == nt - 2);
            const char* a1 = cA + (size_t)(t + 1) * kstep;
            const char* a2 = last ? nA : cA + (size_t)(t + 2) * kstep; const char* b2 = last ? nB : cB + (size_t)(t + 2) * kstep;
            const char* a3 = a2 + kstep; const char* b3 = b2 + kstep;
            PG8_LDB(B0, 0, 0); PG8_LDB(B1, 0, 1); PG8_SCHED; PG8_LDA(At, 0, 0); PG8_STAGE(PG8_SA(1, 1), a1 + hstepA, voffA);
            PG8_WAIT_V(8); PG8_WAIT_L(0); PG8_BAR; PG8_MMA(0, 0, At, B0); PG8_MMA(0, 1, At, B1); PG8_BAR; PG8_SCHED;
            PG8_LDA(At, 0, 1); PG8_STAGE(PG8_SB(0, 0), b2, voffB); PG8_STAGE(PG8_SB(0, 1), b2 + hstepB, voffB); PG8_STAGE(PG8_SA(0, 0), a2, voffA);
            PG8_WAIT_V(8); PG8_WAIT_L(0); PG8_BAR; PG8_MMA(1, 0, At, B0); PG8_MMA(1, 1, At, B1); PG8_BAR; PG8_SCHED;
            PG8_LDB(B0, 1, 0); PG8_LDB(B1, 1, 1); PG8_SCHED; PG8_LDA(At, 1, 0); PG8_STAGE(PG8_SA(0, 1), a2 + hstepA, voffA);
            PG8_WAIT_V(8); PG8_WAIT_L(0); PG8_BAR; PG8_MMA(0, 0, At, B0); PG8_MMA(0, 1, At, B1); PG8_BAR; PG8_SCHED;
            PG8_LDA(At, 1, 1); PG8_STAGE(PG8_SB(1, 0), b3, voffB); PG8_STAGE(PG8_SB(1, 1), b3 + hstepB, voffB); PG8_STAGE(PG8_SA(1, 0), a3, voffA);
            PG8_WAIT_V(8); PG8_WAIT_L(0); PG8_BAR; PG8_MMA(1, 0, At, B0); PG8_MMA(1, 1, At, B1); PG8_BAR; PG8_SCHED;
        }
        if (wr == 0) PG8_BAR;
        E(acc, cur, wr, wc, fr, fq);
        if (!has_next) break;
#pragma unroll
        for (int a = 0; a < 2; ++a)
#pragma unroll
            for (int b = 0; b < 2; ++b)
#pragma unroll
                for (int m = 0; m < 4; ++m)
#pragma unroll
                    for (int n = 0; n < 2; ++n) acc[a][b][m][n] = (f32x4){0.f, 0.f, 0.f, 0.f};
        cur = nxt; cA = nA; cB = nB; ++ui;
        if (wr == 1) PG8_BAR;
    }
    PG8_WAIT_V(0);
    PG8_BAR;
#undef PG8_SA
#undef PG8_SB
#undef PG8_STAGE
#undef PG8_LDA
#undef PG8_LDB
#undef PG8_MMA
#undef PG8_WAIT_V
#undef PG8_WAIT_L
#undef PG8_BAR
#undef PG8_SCHED
}
}

namespace att {
constexpr int SHM_V = 16384, SHM_K = 16384, SHM_R = 8192;
constexpr int OFF_V = 0, OFF_K = 2 * SHM_V, OFF_R = OFF_K + 2 * SHM_K, OFF_WS = OFF_R + 2 * SHM_R, LDS_BYTES = OFF_WS + NWAVES * 64 * 4;
#define KSWZ(row, colB) ((row) * 256 + ((colB) ^ (((row) & 7) << 4)))
#define RSWZ(row, colB) ((row) * 128 + ((colB) ^ (((row) & 7) << 4)))
__device__ __forceinline__ int v_st(int k, int c) { const int kk = (k & ~0xC) | ((k & 4) << 1) | ((k & 8) >> 1); return ((kk >> 3) * 4 + (c >> 5)) * 512 + ((kk & 7) * 32 + (c & 31)) * 2; }
__device__ __forceinline__ int v_rd_base(int lane) { return ((lane & 3) << 3) | (((lane >> 2) & 3) << 6) | (((lane >> 4) & 1) << 5) | (((lane >> 5) & 1) << 8); }
__device__ __forceinline__ int crow(int r, int hi) { return (r & 3) + 8 * (r >> 2) + 4 * hi; }
__device__ __forceinline__ float pl_sum(float x) { auto rr = __builtin_amdgcn_permlane32_swap(__float_as_uint(x), __float_as_uint(x), false, false); return __uint_as_float(rr[0]) + __uint_as_float(rr[1]); }
__device__ __forceinline__ float pl_max(float x) { auto rr = __builtin_amdgcn_permlane32_swap(__float_as_uint(x), __float_as_uint(x), false, false); return fmaxf(__uint_as_float(rr[0]), __uint_as_float(rr[1])); }

#define PK4(P, B_, OUT) do { unsigned a0 = cvtpk(P[B_+0], P[B_+1]), a1 = cvtpk(P[B_+2], P[B_+3]);                          \
        unsigned b0 = cvtpk(P[B_+4], P[B_+5]), b1 = cvtpk(P[B_+6], P[B_+7]);                                             \
        auto r0 = __builtin_amdgcn_permlane32_swap(a0, b0, false, false); auto r1 = __builtin_amdgcn_permlane32_swap(a1, b1, false, false); \
        u32x4 w = {r0[0], r1[0], r0[1], r1[1]}; OUT = __builtin_bit_cast(bf16x8, w); } while (0)

__device__ __forceinline__ void pv_tile(f32x16* o, unsigned vb, bf16x8 pa0, bf16x8 pa1, bf16x8 pa2, bf16x8 pa3) {
#define TRRD(dst, off) asm volatile("ds_read_b64_tr_b16 %0, %1 offset:%2" : "=&v"(dst) : "v"(vb), "i"(off) : "memory")
#define PV_D0(d0) do { s16x4 l0, l1, l2, l3, h0, h1, h2, h3; constexpr int b_ = (d0) * 512;   \
        TRRD(l0, b_); TRRD(h0, b_ + 2048); TRRD(l1, b_ + 4096); TRRD(h1, b_ + 6144); TRRD(l2, b_ + 8192); TRRD(h2, b_ + 10240); TRRD(l3, b_ + 12288); TRRD(h3, b_ + 14336); \
        asm volatile("s_waitcnt lgkmcnt(0)" ::: "memory"); SBAR();   \
        o[d0] = __builtin_amdgcn_mfma_f32_32x32x16_bf16(pa0, (bf16x8){l0[0], l0[1], l0[2], l0[3], h0[0], h0[1], h0[2], h0[3]}, o[d0], 0, 0, 0);   \
        o[d0] = __builtin_amdgcn_mfma_f32_32x32x16_bf16(pa1, (bf16x8){l1[0], l1[1], l1[2], l1[3], h1[0], h1[1], h1[2], h1[3]}, o[d0], 0, 0, 0);   \
        o[d0] = __builtin_amdgcn_mfma_f32_32x32x16_bf16(pa2, (bf16x8){l2[0], l2[1], l2[2], l2[3], h2[0], h2[1], h2[2], h2[3]}, o[d0], 0, 0, 0);   \
        o[d0] = __builtin_amdgcn_mfma_f32_32x32x16_bf16(pa3, (bf16x8){l3[0], l3[1], l3[2], l3[3], h3[0], h3[1], h3[2], h3[3]}, o[d0], 0, 0, 0); } while (0)
    PV_D0(0); PV_D0(1); PV_D0(2); PV_D0(3);
#undef PV_D0
#undef TRRD
}

__device__ __forceinline__ void sb_tile(f32x16& p0, f32x16& p1, float& R, int dq, int hi) {
    const float NEG = -__builtin_inff();
    asm volatile("" : "+v"(dq));
    float g[8];
#define SB_GRP(P, half, i) do { float Lv[4], zv[4];                                                                              \
        _Pragma("unroll") for (int jj = 0; jj < 4; ++jj) { const int c = jj + 8 * (i) + 32 * (half); const bool ok = dq >= c;  \
            const float z = fminf(P[4 * (i) + jj], 80.f); const float e = __builtin_amdgcn_exp2f(z);                               \
            const float sp = __builtin_amdgcn_logf(1.f + e); Lv[jj] = ok ? -sp : 0.f; zv[jj] = ok ? z : NEG; }                      \
        const float s3 = Lv[3], s2 = Lv[2] + s3, s1 = Lv[1] + s2, s0 = Lv[0] + s1;                                                \
        P[4 * (i) + 0] = zv[0] + s0; P[4 * (i) + 1] = zv[1] + s1; P[4 * (i) + 2] = zv[2] + s2; P[4 * (i) + 3] = zv[3] + s3;      \
        g[(half) * 4 + (i)] = s0; } while (0)
    SB_GRP(p0, 0, 0); SB_GRP(p0, 0, 1); SB_GRP(p0, 0, 2); SB_GRP(p0, 0, 3);
    SB_GRP(p1, 1, 0); SB_GRP(p1, 1, 1); SB_GRP(p1, 1, 2); SB_GRP(p1, 1, 3);
#undef SB_GRP
    float c[8], Tk[8];
#pragma unroll
    for (int k = 0; k < 8; ++k) c[k] = pl_sum(g[k]);
    Tk[7] = 0.f;
#pragma unroll
    for (int k = 6; k >= 0; --k) Tk[k] = Tk[k + 1] + c[k + 1];
    const float tot = Tk[0] + c[0];
#pragma unroll
    for (int k = 0; k < 8; ++k) { const float add = R + Tk[k] + (hi == 0 ? (c[k] - g[k]) : 0.f);
#pragma unroll
        for (int jj = 0; jj < 4; ++jj) { if (k < 4) p0[4 * k + jj] = __builtin_amdgcn_exp2f(p0[4 * k + jj] + add); else p1[4 * (k - 4) + jj] = __builtin_amdgcn_exp2f(p1[4 * (k - 4) + jj] + add); } }
    R += tot;
}

template <int MODE>
__device__ __forceinline__ void attn_unit(LAS unsigned char* lds, const bf16_t* Qp, int qpitch, const bf16_t* Kp, const bf16_t* Vp, int kvpitch,
                                          const bf16_t* Rp, const float* cs, bf16_t* Op, int opitch, int q0, const int wid, const int lane) {
    constexpr int NQF = MODE ? 12 : 8;
    constexpr float SCALE = 0.07216878364870323f;
    constexpr float C2 = LOG2E * SCALE, THR = 8.f;
    const int r32 = lane & 31, hi = lane >> 5;
    const int qrow = q0 + wid * 32 + r32;
    LAS unsigned char* V_lds = lds + OFF_V; LAS unsigned char* K_lds = lds + OFF_K; LAS unsigned char* R_lds = lds + OFF_R;
    LAS float* wsf = (LAS float*)(lds + OFF_WS) + wid * 64;
    bf16x8 qr[NQF];
#pragma unroll
    for (int d0 = 0; d0 < NQF; ++d0) qr[d0] = *(const bf16x8*)(Qp + (size_t)qrow * qpitch + d0 * 16 + hi * 8);
    if constexpr (MODE == 1) {
#pragma unroll
        for (int f = 0; f < 2; ++f) { const int ib = f * 16 + hi * 8; const float* csr = cs + (size_t)qrow * 64 + ib * 2;
            bf16x8 a = qr[8 + f], b = qr[10 + f];
#pragma unroll
            for (int j = 0; j < 8; ++j) { const float co = csr[2 * j], si = csr[2 * j + 1], x1 = bf2f((bf16_t)a[j]), x2 = bf2f((bf16_t)b[j]);
                a[j] = (short)f2bf(x1 * co - x2 * si); b[j] = (short)f2bf(x2 * co + x1 * si); }
            qr[8 + f] = a; qr[10 + f] = b; }
    }
    const int NT = q0 / 64 + 4;
    const unsigned vb0 = (unsigned)(size_t)(V_lds) + (unsigned)v_rd_base(lane);
    unsigned koff[2], voff[2], roff;
#pragma unroll
    for (int i = 0; i < 2; ++i) { const int p = (wid * 2 + i) * 64 + lane;
        { const int row = p >> 4, pc = p & 15; koff[i] = (unsigned)(row * kvpitch + ((pc ^ (row & 7)) * 8)); }
        { const int sub = p >> 5, w = p & 31, kk = (sub >> 2) * 8 + (w >> 2), c = (sub & 3) * 32 + (w & 3) * 8, k = (kk & ~0xC) | ((kk & 4) << 1) | ((kk & 8) >> 1); voff[i] = (unsigned)(k * kvpitch + c); } }
    { const int p = wid * 64 + lane, row = p >> 3, pc = p & 7; roff = (unsigned)(row * 64 + ((pc ^ (row & 7)) * 8)); }
#define TILE_OF(it) (MODE ? (it) : (NT - 1 - (it)))
#define STAGE(jt, bf) do { const size_t kb_ = (size_t)(jt) * 64 * kvpitch;                                                                                   \
        _Pragma("unroll") for (int i_ = 0; i_ < 2; ++i_) {                                                                                                   \
            __builtin_amdgcn_global_load_lds((const unsigned*)(Kp + kb_ + koff[i_]), (LAS unsigned*)(K_lds + (bf) * SHM_K + (wid * 2 + i_) * 1024), 16, 0, 0);   \
            __builtin_amdgcn_global_load_lds((const unsigned*)(Vp + kb_ + voff[i_]), (LAS unsigned*)(V_lds + (bf) * SHM_V + (wid * 2 + i_) * 1024), 16, 0, 0); } \
        if constexpr (MODE == 1) __builtin_amdgcn_global_load_lds((const unsigned*)(Rp + (size_t)(jt) * 64 * 64 + roff), (LAS unsigned*)(R_lds + (bf) * SHM_R + wid * 1024), 16, 0, 0); } while (0)
    float m_reg = -1e30f, l_reg = 0.f, Rrun = 0.f; f32x16 o[4];
#pragma unroll
    for (int d = 0; d < 4; ++d) o[d] = f32x16{};
    STAGE(TILE_OF(0), 0);
    __syncthreads();
    for (int it = 0; it < NT; ++it) {
        const int buf = it & 1, jt = TILE_OF(it), k0 = jt * 64;
        if (it + 1 < NT) STAGE(TILE_OF(it + 1), buf ^ 1);
        f32x16 p0 = f32x16{}, p1 = f32x16{};
        {
            LAS unsigned char* kb = K_lds + buf * SHM_K;
#pragma unroll
            for (int d0 = 0; d0 < 8; ++d0) { LAS unsigned char* a = kb + KSWZ(r32, ((d0 & 3) * 16 + hi * 8) * 2) + (d0 >> 2) * 128;
                const bf16x8 b0 = *(LAS bf16x8*)a, b1 = *(LAS bf16x8*)(a + 32 * 256);
                p0 = __builtin_amdgcn_mfma_f32_32x32x16_bf16(b0, qr[d0], p0, 0, 0, 0);
                p1 = __builtin_amdgcn_mfma_f32_32x32x16_bf16(b1, qr[d0], p1, 0, 0, 0); }
            if constexpr (MODE == 1) {
                LAS unsigned char* rb = R_lds + buf * SHM_R;
#pragma unroll
                for (int d0 = 0; d0 < 4; ++d0) { LAS unsigned char* a = rb + RSWZ(r32, (d0 * 16 + hi * 8) * 2);
                    const bf16x8 b0 = *(LAS bf16x8*)a, b1 = *(LAS bf16x8*)(a + 32 * 128);
                    p0 = __builtin_amdgcn_mfma_f32_32x32x16_bf16(b0, qr[8 + d0], p0, 0, 0, 0);
                    p1 = __builtin_amdgcn_mfma_f32_32x32x16_bf16(b1, qr[8 + d0], p1, 0, 0, 0); }
            }
        }
        bf16x8 pa0, pa1, pa2, pa3;
        if constexpr (MODE == 0) {
            sb_tile(p0, p1, Rrun, qrow - 1 - k0 - 4 * hi, hi);
        } else {
            const float NEG = -__builtin_inff();
            if (k0 + 63 > q0 + wid * 32) {
                int dq = qrow - k0 - 4 * hi; asm volatile("" : "+v"(dq));
#pragma unroll
                for (int r = 0; r < 16; ++r) { const int c = (r & 3) + 8 * (r >> 2); if (dq < c) p0[r] = NEG; if (dq < c + 32) p1[r] = NEG; }
            }
            float pmax = p0[0];
#pragma unroll
            for (int r = 1; r < 16; ++r) pmax = fmaxf(pmax, p0[r]);
#pragma unroll
            for (int r = 0; r < 16; ++r) pmax = fmaxf(pmax, p1[r]);
            pmax = pl_max(pmax);
            float mn, alpha;
            if (__all((pmax - m_reg) * SCALE <= THR)) { mn = m_reg; alpha = 1.f; }
            else { mn = fmaxf(m_reg, pmax); alpha = __builtin_amdgcn_exp2f((m_reg - mn) * C2); m_reg = mn; }
            const float mnL = -mn * C2;
#pragma unroll
            for (int r = 0; r < 16; ++r) { p0[r] = __builtin_amdgcn_exp2f(fmaf(p0[r], C2, mnL)); p1[r] = __builtin_amdgcn_exp2f(fmaf(p1[r], C2, mnL)); }
            float ps = 0.f;
#pragma unroll
            for (int r = 0; r < 16; ++r) ps += p0[r] + p1[r];
            ps = pl_sum(ps);
            l_reg = l_reg * alpha + ps;
            if (__any(alpha < 1.f)) { if (hi == 0) wsf[r32] = alpha; LDS_WAIT();
#pragma unroll
                for (int r = 0; r < 16; ++r) { const float al = wsf[crow(r, hi)];
#pragma unroll
                    for (int d = 0; d < 4; ++d) o[d][r] *= al; } }
        }
        PK4(p0, 0, pa0); PK4(p0, 8, pa1); PK4(p1, 0, pa2); PK4(p1, 8, pa3);
        SBAR();
        pv_tile(o, vb0 + buf * SHM_V, pa0, pa1, pa2, pa3);
        __syncthreads();
    }
    if constexpr (MODE == 1) { if (hi == 0) wsf[r32] = l_reg; LDS_WAIT(); }
    GAS bf16_t* Ow = (GAS bf16_t*)(Op + (size_t)(q0 + wid * 32) * opitch); asm volatile("" : "+s"(Ow));
#pragma unroll
    for (int r = 0; r < 16; ++r) { const int orow = crow(r, hi); float inv = 1.f; if constexpr (MODE == 1) inv = __builtin_amdgcn_rcpf(wsf[orow]);
#pragma unroll
        for (int d0 = 0; d0 < 4; ++d0) { const float v = o[d0][r] * inv; const float vn = __shfl_xor(v, 1);
            if ((r32 & 1) == 0) *(GAS unsigned*)(Ow + (size_t)orow * opitch + d0 * 32 + r32) = pk2(v, vn); } }
    __syncthreads();
#undef TILE_OF
#undef STAGE
}
}

#define XB_TMO      128
#define XB_XCNT(j)  (256  + 64 * (j))
#define XB_XSUB(j)  (1280 + 64 * (j))
#define XB_XGEN(j)  (2304 + 64 * (j))
#define XB_TOP      3328
#define XB_TOPGEN   3392
#define XCD_BAR_WORDS 3456
#define XB_SPIN_CAP (1u << 22)
__device__ __forceinline__ unsigned xb_ld(unsigned* p)              { return __hip_atomic_load(p, __ATOMIC_RELAXED, __HIP_MEMORY_SCOPE_AGENT); }
__device__ __forceinline__ unsigned xb_add(unsigned* p, unsigned v) { return __hip_atomic_fetch_add(p, v, __ATOMIC_RELAXED, __HIP_MEMORY_SCOPE_AGENT); }
__device__ __forceinline__ unsigned xb_xcc_id() { return (unsigned)__builtin_amdgcn_s_getreg((3 << 11) | 20) & 0xFu; }
#define XB_SPIN(cond, bar) do { unsigned _sp = 0; while (cond) { __builtin_amdgcn_s_sleep(1); \
    if ((++_sp & 255u) == 0u) { if (xb_ld(&(bar)[XB_TMO])) break; if (_sp > XB_SPIN_CAP) { atomicAdd(&(bar)[XB_TMO], 1u); break; } } } } while (0)
struct XcdBarrier { unsigned* bar; unsigned x; volatile LAS unsigned* st; };
__device__ __forceinline__ XcdBarrier xcd_barrier_post(unsigned* bar, volatile LAS unsigned* st) {
    XcdBarrier b; b.bar = bar; b.x = xb_xcc_id(); b.st = st;
    if (threadIdx.x == 0) (void)xb_add(&bar[XB_XCNT(b.x)], 1u);
    return b;
}
__device__ __forceinline__ void xcd_barrier_complete(unsigned* bar, unsigned x, unsigned& nloc, unsigned& nx) {
    const unsigned G = gridDim.x * gridDim.y * gridDim.z;
    unsigned sum, cnt, mine, sp = 0u;
    for (;;) {
        sum = 0u; cnt = 0u; mine = 0u;
#pragma unroll
        for (unsigned j = 0; j < 16; ++j) { const unsigned c = xb_ld(&bar[XB_XCNT(j)]); sum += c; cnt += (c > 0u) ? 1u : 0u; mine = (j == x) ? c : mine; }
        if (sum == G) break;
        __builtin_amdgcn_s_sleep(1);
        if ((++sp & 255u) == 0u) { if (xb_ld(&bar[XB_TMO])) break; if (sp > XB_SPIN_CAP) { atomicAdd(&bar[XB_TMO], 1u); break; } }
    }
    nloc = mine > 0u ? mine : 1u; nx = cnt > 0u ? cnt : 1u;
}
__device__ __forceinline__ void xcd_barrier(const XcdBarrier& b, const int wave) {
    asm volatile("s_waitcnt vmcnt(0)" ::: "memory");
    __syncthreads();
    if (wave == 0 && lane_id_v() == 0) {
        unsigned* bar = b.bar;
        __builtin_amdgcn_s_waitcnt(0);
        unsigned nloc = b.st[0], nx = b.st[1];
        if (nloc == 0u) { xcd_barrier_complete(bar, b.x, nloc, nx); b.st[0] = nloc; b.st[1] = nx; }
        const unsigned old = xb_add(&bar[XB_XSUB(b.x)], 1u);
        const unsigned gen = old / nloc;
        if (old + 1u == (gen + 1u) * nloc) {
            __builtin_amdgcn_fence(__ATOMIC_RELEASE, "agent");
            asm volatile("s_waitcnt vmcnt(0)" ::: "memory");
            const unsigned og = xb_add(&bar[XB_TOP], 1u);
            const unsigned tg = og / nx;
            if (og + 1u == (tg + 1u) * nx) xb_add(&bar[XB_TOPGEN], 1u);
            else XB_SPIN(xb_ld(&bar[XB_TOPGEN]) == tg, bar);
            __builtin_amdgcn_fence(__ATOMIC_ACQUIRE, "agent");
            xb_add(&bar[XB_XGEN(b.x)], 1u);
            asm volatile("s_waitcnt vmcnt(0)" ::: "memory");
        } else {
            XB_SPIN(xb_ld(&bar[XB_XGEN(b.x)]) == gen, bar);
            __builtin_amdgcn_fence(__ATOMIC_ACQUIRE, "agent");
            asm volatile("s_waitcnt vmcnt(0)" ::: "memory");
        }
    }
    __syncthreads();
}

constexpr int RING_BYTES = 131072, MISC_OFF = RING_BYTES + 320, LDS_BYTES = 147456;
static_assert(att::LDS_BYTES <= RING_BYTES, "attention LDS");

struct Args { const void* in[21]; float* out; unsigned char* ws; int ph_lo, ph_hi; };
enum { IN_X = 0, IN_POS, IN_SBG, IN_WQKV, IN_WO, IN_KVG, IN_WDKV, IN_KVLG, IN_WUKV, IN_MLAG, IN_WDQ, IN_QLG, IN_WUQ, IN_WMO, IN_PG, IN_PWQ, IN_PK1, IN_PK2, IN_PU, IN_PV, IN_FG };

__device__ __forceinline__ void transpose_item(const float* W, int ldw, int K, int nblk, const float* gain, bf16_t* WT, int row_off, LAS float* scr, int item, int lane) {
    const int kb = item / nblk, nb = item % nblk, k0 = 64 * kb, n0 = 32 * nb;
#pragma unroll 8
    for (int i = 0; i < 32; ++i) { const int kk = 2 * i + (lane >> 5); const float gv = gain ? gain[k0 + kk] : 1.f; scr[kk * 33 + (lane & 31)] = W[(size_t)(k0 + kk) * ldw + n0 + (lane & 31)] * gv; }
    LDS_WAIT(); asm volatile("" ::: "memory");
    const int c = lane & 7;
#pragma unroll
    for (int j = 0; j < 4; ++j) { const int n = (lane >> 3) + 8 * j; const LAS float* s = scr + (8 * c) * 33 + n;
        u32x4 o; o.x = pk2(s[0 * 33], s[1 * 33]); o.y = pk2(s[2 * 33], s[3 * 33]); o.z = pk2(s[4 * 33], s[5 * 33]); o.w = pk2(s[6 * 33], s[7 * 33]);
        *(u32x4*)(WT + (size_t)(row_off + n0 + n) * K + k0 + 8 * c) = o; }
    LDS_WAIT(); asm volatile("" ::: "memory");
}
__device__ __forceinline__ void convert_tables(const float* u, const float* v, const float* g, bf16_t* TU, bf16_t* TV, int gtid, int gthreads) {
    const size_t n8 = (size_t)NEXP * DM / 8;
    for (size_t i = gtid; i < n8; i += gthreads) { const int d = (int)((i * 8) % DM); const size_t e = (i * 8) / DM;
        const size_t dst = ((size_t)(d >> 6) * NEXP + e) * 64 + (d & 63);
        const f32x4 a0 = *(const f32x4*)(u + i * 8), a1 = *(const f32x4*)(u + i * 8 + 4), g0 = *(const f32x4*)(g + d), g1 = *(const f32x4*)(g + d + 4);
        u32x4 w; w.x = pk2(a0[0] * g0[0], a0[1] * g0[1]); w.y = pk2(a0[2] * g0[2], a0[3] * g0[3]); w.z = pk2(a1[0] * g1[0], a1[1] * g1[1]); w.w = pk2(a1[2] * g1[2], a1[3] * g1[3]);
        *(u32x4*)(TU + dst) = w;
        const f32x4 b0 = *(const f32x4*)(v + i * 8), b1 = *(const f32x4*)(v + i * 8 + 4);
        u32x4 x; x.x = pk2(b0[0], b0[1]); x.y = pk2(b0[2], b0[3]); x.z = pk2(b1[0], b1[1]); x.w = pk2(b1[2], b1[3]);
        *(u32x4*)(TV + dst) = x; }
}
__device__ __forceinline__ void row_to_bf16_rstd(const float* xrow, bf16_t* orow, float* rstd_out, int lane) {
    f32x4 v[8]; float s = 0.f;
#pragma unroll
    for (int j = 0; j < 8; ++j) { v[j] = *(const f32x4*)(xrow + j * 256 + lane * 4); s += v[j][0] * v[j][0] + v[j][1] * v[j][1] + v[j][2] * v[j][2] + v[j][3] * v[j][3]; }
    s = wave_sum(s);
#pragma unroll
    for (int j = 0; j < 8; ++j) { u32x2 w; w.x = pk2(v[j][0], v[j][1]); w.y = pk2(v[j][2], v[j][3]); *(u32x2*)(orow + j * 256 + lane * 4) = w; }
    if (lane == 0) *rstd_out = 1.f / sqrtf(s * (1.f / DM) + EPS);
}

template <int layer>
__device__ __forceinline__ void peer_gather(LAS unsigned char* lds, unsigned char* ws, float* X, bf16_t* XB, float* rstd, const float* fg, const int wave, const int lane, const int bx) {
    constexpr int GOFF = 0, GPW = 65536, GSS = 131072 + 1024;
    const bf16_t* TU = (const bf16_t*)(ws + WS_TU); const bf16_t* TV = (const bf16_t*)(ws + WS_TV);
    const int* IDS = (const int*)(ws + WS_IDS); const float* GT = (const float*)(ws + WS_GATE);
    const int g = lane >> 3, sub = lane & 7;
    const int tw0 = wave * 16;
    const int t0 = bx * 128;
    for (int tt = 0; tt < 16; ++tt) { const int tl = tw0 + tt; const size_t t = (size_t)(t0 + tl);
#pragma unroll
        for (int k = 0; k < 2; ++k) { const int s_ = lane + 64 * k; const int id = IDS[t * NSEL + s_];
            const int pos = tl * 128 + (s_ & 7) * 16 + (s_ >> 3);
            *(LAS unsigned*)(lds + GOFF + pos * 4) = (unsigned)id * 128u; *(LAS float*)(lds + GPW + pos * 4) = 0.f; }
        if (lane < 8) *(LAS float*)(lds + GSS + (tl * 8 + lane) * 4) = 0.f; }
    LDS_WAIT();
#pragma unroll 1
    for (int kc = 0; kc < 32; ++kc) {
        const char* slab = (const char*)TU + (size_t)kc * ((size_t)NEXP * 128) + sub * 16;
#pragma unroll 1
        for (int tt = 0; tt < 16; ++tt) { const int tl = tw0 + tt;
            const u32x4 h4 = *(const u32x4*)(XB + (size_t)(t0 + tl) * DM + kc * 64 + sub * 8);
            u32x4 of[4];
#pragma unroll
            for (int q = 0; q < 4; ++q) of[q] = *(LAS u32x4*)(lds + GOFF + (tl * 128 + g * 16 + q * 4) * 4);
            u32x4 uv[16];
#pragma unroll
            for (int i = 0; i < 16; ++i) uv[i] = *(const u32x4*)(slab + of[i >> 2][i & 3]);
            float d[16];
#pragma unroll
            for (int i = 0; i < 16; ++i) { float a = 0.f;
                a = dot2bf(uv[i].x, h4.x, a); a = dot2bf(uv[i].y, h4.y, a); a = dot2bf(uv[i].z, h4.z, a); a = dot2bf(uv[i].w, h4.w, a);
                a += __shfl_xor(a, 1); a += __shfl_xor(a, 2); a += __shfl_xor(a, 4); d[i] = a; }
            if (sub == 0) {
#pragma unroll
                for (int q = 0; q < 4; ++q) { LAS f32x4* p = (LAS f32x4*)(lds + GPW + (tl * 128 + g * 16 + q * 4) * 4); f32x4 v = *p;
                    v[0] += d[q * 4 + 0]; v[1] += d[q * 4 + 1]; v[2] += d[q * 4 + 2]; v[3] += d[q * 4 + 3]; *p = v; } }
        }
    }
    LDS_WAIT();
    for (int tt = 0; tt < 16; ++tt) { const int tl = tw0 + tt; const size_t t = (size_t)(t0 + tl); const float rs = rstd[t];
#pragma unroll
        for (int k = 0; k < 2; ++k) { const int s_ = lane + 64 * k; const int pos = tl * 128 + (s_ & 7) * 16 + (s_ >> 3);
            LAS float* p = (LAS float*)(lds + GPW + pos * 4); const float dd = *p * rs;
            *p = GT[t * NSEL + s_] * 0.5f * dd * (1.f + erff(dd * 0.7071067811865476f)); } }
    LDS_WAIT();
#pragma unroll 1
    for (int dc = 0; dc < 32; ++dc) {
        const char* slab = (const char*)TV + (size_t)dc * ((size_t)NEXP * 128) + sub * 16;
#pragma unroll 1
        for (int tt = 0; tt < 16; ++tt) { const int tl = tw0 + tt; const size_t t = (size_t)(t0 + tl);
            u32x4 of[4]; f32x4 wq[4];
#pragma unroll
            for (int q = 0; q < 4; ++q) { of[q] = *(LAS u32x4*)(lds + GOFF + (tl * 128 + g * 16 + q * 4) * 4); wq[q] = *(LAS f32x4*)(lds + GPW + (tl * 128 + g * 16 + q * 4) * 4); }
            u32x4 vv[16];
#pragma unroll
            for (int i = 0; i < 16; ++i) vv[i] = *(const u32x4*)(slab + of[i >> 2][i & 3]);
            float acc[8];
#pragma unroll
            for (int c = 0; c < 8; ++c) acc[c] = 0.f;
#pragma unroll
            for (int i = 0; i < 16; i += 2) { const unsigned wp = cvtpk(wq[i >> 2][i & 3], wq[(i + 1) >> 2][(i + 1) & 3]);
#pragma unroll
                for (int c = 0; c < 4; ++c) { const unsigned lo = __builtin_amdgcn_perm(vv[i + 1][c], vv[i][c], 0x05040100u), hi_ = __builtin_amdgcn_perm(vv[i + 1][c], vv[i][c], 0x07060302u);
                    acc[2 * c] = dot2bf(lo, wp, acc[2 * c]); acc[2 * c + 1] = dot2bf(hi_, wp, acc[2 * c + 1]); } }
#pragma unroll
            for (int c = 0; c < 8; ++c) { float a = acc[c]; a += __shfl_xor(a, 8); a += __shfl_xor(a, 16); a += __shfl_xor(a, 32); acc[c] = a; }
            if (g == 0) { float* xr = X + t * DM + dc * 64 + sub * 8; f32x4 x0 = *(const f32x4*)xr, x1 = *(const f32x4*)(xr + 4);
                x0[0] += acc[0]; x0[1] += acc[1]; x0[2] += acc[2]; x0[3] += acc[3]; x1[0] += acc[4]; x1[1] += acc[5]; x1[2] += acc[6]; x1[3] += acc[7];
                *(f32x4*)xr = x0; *(f32x4*)(xr + 4) = x1;
                if (layer == 0) { u32x4 w; w.x = pk2(x0[0], x0[1]); w.y = pk2(x0[2], x0[3]); w.z = pk2(x1[0], x1[1]); w.w = pk2(x1[2], x1[3]); *(u32x4*)(XB + t * DM + dc * 64 + sub * 8) = w; }
                LAS float* sp = (LAS float*)(lds + GSS + (tl * 8 + sub) * 4);
                *sp += x0[0] * x0[0] + x0[1] * x0[1] + x0[2] * x0[2] + x0[3] * x0[3] + x1[0] * x1[0] + x1[1] * x1[1] + x1[2] * x1[2] + x1[3] * x1[3]; }
        }
    }
    LDS_WAIT(); VM_WAIT();
    for (int tt = 0; tt < 16; ++tt) { const int tl = tw0 + tt; const size_t t = (size_t)(t0 + tl);
        float ss = (lane < 8) ? *(LAS float*)(lds + GSS + (tl * 8 + lane) * 4) : 0.f; ss = wave_sum(ss);
        const float rn = 1.f / sqrtf(ss * (1.f / DM) + EPS);
        if (layer == 0) { if (lane == 0) rstd[t] = rn; }
        else {
#pragma unroll
            for (int j = 0; j < 8; ++j) { float* xr = X + t * DM + j * 256 + lane * 4; const f32x4 gq = *(const f32x4*)(fg + j * 256 + lane * 4);
                f32x4 xv = __builtin_nontemporal_load((const f32x4*)xr); xv[0] *= rn * gq[0]; xv[1] *= rn * gq[1]; xv[2] *= rn * gq[2]; xv[3] *= rn * gq[3]; *(f32x4*)xr = xv; } }
    }
}

#ifndef PH_MASK
#define PH_MASK 0xFFFFFu
#endif
#define IN(k) (lo <= (k) && (k) < hi)
#define SITE(b) (((PH_MASK) >> (b)) & 1u)
#define SEAM(k) do { if (IN(k) && IN((k) + 1)) xcd_barrier(bar, wave); } while (0)
#define PH_LOCALS const __attribute__((address_space(4))) Args* A_ = (const __attribute__((address_space(4))) Args*)__builtin_amdgcn_kernarg_segment_ptr(); asm volatile("" : "+s"(A_)); \
    unsigned char* ws = A_->ws; float* X = A_->out; float* rstd = (float*)(ws + WS_RSTD); float* cs = (float*)(ws + WS_CS); bf16_t* XB = (bf16_t*)(ws + WS_XB); const float* x_in = (const float*)A_->in[IN_X]; \
    const int lane = lane_id_v(), tid = wave * 64 + lane, gw = bx * NWAVES + wave, NGW = G * NWAVES, gtid = bx * NTHR + tid, gthreads = G * NTHR; \
    (void)X; (void)rstd; (void)cs; (void)XB; (void)x_in; (void)lane; (void)tid; (void)gw; (void)NGW; (void)gtid; (void)gthreads
#define AIN(k) (A_->in[k])

template <int layer>
__device__ __forceinline__ void peer_phases(LAS unsigned char* lds, const int lo, const int hi, const XcdBarrier& bar, const int wave, const int G, const int bx) {
    constexpr int pb = layer ? 15 : 4;
        if (SITE(4) && IN(pb)) { PH_LOCALS; const float* pg = (const float*)AIN(IN_PG) + (size_t)layer * DM;
            for (int m = gw; m < T; m += NGW) row_to_bf16_rstd(X + (size_t)m * DM, XB + (size_t)m * DM, rstd + m, lane);
            if (layer == 1) convert_tables((const float*)AIN(IN_PU) + (size_t)NEXP * DM, (const float*)AIN(IN_PV) + (size_t)NEXP * DM, pg, (bf16_t*)(ws + WS_TU), (bf16_t*)(ws + WS_TV), gtid, gthreads);
        }
        SEAM(pb);
        if (SITE(5) && IN(pb + 1)) { PH_LOCALS;
            pg8::Gemm g{XB, (const bf16_t*)(ws + WS_WPQ) + (size_t)layer * DM * DM, T, DM, DM, DM, 0}; pg8::StaticOrder S; S.init(T, DM, G, bx);
            pg8::EpiB16 E{(bf16_t*)(ws + WS_QP), DM, rstd};
            pg8::gemm_phase<pg8::EpiB16>(lds, g, S, E, wave, lane);
        }
        SEAM(pb + 1);
        if (SITE(6) && IN(pb + 2)) { PH_LOCALS;
            pg8::Gemm g{(const bf16_t*)(ws + WS_QP), (const bf16_t*)(ws + WS_KBD) + (size_t)layer * 2048 * 256, T, DM, 256, DM, 256}; pg8::StaticOrder S; S.init(T, DM, G, bx);
            pg8::EpiF32 E{(float*)(ws + WS_SC), DM, nullptr};
            pg8::gemm_phase<pg8::EpiF32>(lds, g, S, E, wave, lane);
        }
        SEAM(pb + 2);
        if (SITE(7) && IN(pb + 3)) { PH_LOCALS;
            const float* SC = (const float*)(ws + WS_SC); int* IDS = (int*)(ws + WS_IDS); float* GT = (float*)(ws + WS_GATE);
            for (int item = gw; item < T * PH; item += NGW) {
                const int t = item >> 3, hh = item & 7; const float* s = SC + (size_t)t * DM + hh * 256;
                unsigned ka[2], kb[2];
#pragma unroll
                for (int j = 0; j < 2; ++j) { const int idx = lane + 64 * j; unsigned ua = __float_as_uint(s[idx]), ub = __float_as_uint(s[128 + idx]);
                    ua ^= (ua >> 31) ? 0xffffffffu : 0x80000000u; ub ^= (ub >> 31) ? 0xffffffffu : 0x80000000u;
                    ka[j] = (ua & ~127u) | (unsigned)(127 - idx); kb[j] = (ub & ~127u) | (unsigned)(127 - idx); }
                unsigned my1 = 0u, my2 = 0u;
                for (int itx = 0; itx < TOPK; ++itx) {
                    unsigned m1 = wave_max_u32(ka[0] > ka[1] ? ka[0] : ka[1]); if (lane == itx) my1 = m1; if (ka[0] == m1) ka[0] = 0u; if (ka[1] == m1) ka[1] = 0u;
                    unsigned m2 = wave_max_u32(kb[0] > kb[1] ? kb[0] : kb[1]); if (lane == itx) my2 = m2; if (kb[0] == m2) kb[0] = 0u; if (kb[1] == m2) kb[1] = 0u;
                }
                auto dec = [](unsigned k) { unsigned u = k & ~127u; u ^= (u >> 31) ? 0x80000000u : 0xffffffffu; return __uint_as_float(u); };
                const float v1 = dec(my1), v2 = dec(my2);
                const float a1 = __shfl(v1, lane >> 2);
                unsigned kc[4];
#pragma unroll
                for (int jj = 0; jj < 4; ++jj) { const int j = (lane & 3) * 4 + jj; const float sum = a1 + __shfl(v2, j); unsigned us = __float_as_uint(sum); us ^= (us >> 31) ? 0xffffffffu : 0x80000000u;
                    kc[jj] = (us & ~255u) | (unsigned)(255 - (lane * 4 + jj)); }
                unsigned mysel = 0u;
                for (int itx = 0; itx < TOPK; ++itx) {
                    unsigned m = kc[0] > kc[1] ? kc[0] : kc[1]; unsigned m_ = kc[2] > kc[3] ? kc[2] : kc[3]; m = m > m_ ? m : m_;
                    m = wave_max_u32(m); if (lane == itx) mysel = m;
#pragma unroll
                    for (int jj = 0; jj < 4; ++jj) if (kc[jj] == m) kc[jj] = 0u;
                }
                const int cidx = 255 - (int)(mysel & 255u), ci = (cidx >> 4) & 15, cj = cidx & 15;
                const unsigned k1 = (unsigned)__shfl((int)my1, ci), k2 = (unsigned)__shfl((int)my2, cj);
                const int i1 = 127 - (int)(k1 & 127u), i2 = 127 - (int)(k2 & 127u);
                const float sc = dec(k1) + dec(k2);
                const float smax = __shfl(sc, 0);
                float e = (lane < TOPK) ? __expf(sc - smax) : 0.f;
                const float den = wave_sum(e);
                if (lane < TOPK) { IDS[(size_t)t * NSEL + hh * TOPK + lane] = i1 * NKEYS + i2; GT[(size_t)t * NSEL + hh * TOPK + lane] = e / den; }
            }
        }
        SEAM(pb + 3);
        if (SITE(8) && IN(pb + 4)) { PH_LOCALS;
            if (bx < 256) peer_gather<layer>(lds, ws, X, XB, rstd, (const float*)AIN(IN_FG), wave, lane, bx);
        }
}

__global__ void __launch_bounds__(NTHR, 2) fwd(Args args) {
    extern __shared__ __attribute__((aligned(16))) unsigned char lds_raw[];
    LAS unsigned char* lds = (LAS unsigned char*)lds_raw;
    volatile LAS unsigned* MISC = (volatile LAS unsigned*)(lds + MISC_OFF);
    const int wave = __builtin_amdgcn_readfirstlane(threadIdx.x >> 6);
    const int G = gridDim.x, bx = blockIdx.x;
    unsigned* ctl = (unsigned*)(args.ws + WS_CTL);
    for (int u = threadIdx.x; u < (LDS_BYTES - RING_BYTES) / 4; u += NTHR) ((LAS unsigned*)(lds + RING_BYTES))[u] = 0u;
    __syncthreads();
    XcdBarrier bar; bar.bar = ctl + CW_BAR; bar.x = 0; bar.st = nullptr;
    const int lo = args.ph_lo, hi = args.ph_hi;
    const bool multi = (hi - lo) > 1;
    if (multi) bar = xcd_barrier_post(ctl + CW_BAR, MISC + 8);

    if (SITE(0) && IN(0)) { PH_LOCALS;
        LAS float* scr = (LAS float*)(lds + wave * 16384);
        const float* sbg = (const float*)AIN(IN_SBG); const float* kvg = (const float*)AIN(IN_KVG); const float* mlag = (const float*)AIN(IN_MLAG);
        const float* kvlg = (const float*)AIN(IN_KVLG); const float* qlg = (const float*)AIN(IN_QLG); const float* pg = (const float*)AIN(IN_PG);
        constexpr int I_QKV = 32 * 192, I_WO = 32 * 64, I_DKV = 32 * 18, I_DQ = 32 * 16, I_UKV = 8 * 128, I_UQ = 8 * 96, I_MO = 32 * 64, I_PQ = 32 * 64;
        constexpr int NITEMS = I_QKV + I_WO + I_DKV + I_DQ + I_UKV + I_UQ + I_MO + 2 * I_PQ;
        for (int it = gw; it < NITEMS; it += NGW) {
            int r = it;
            if (r < I_QKV) { transpose_item((const float*)AIN(IN_WQKV), 6144, 2048, 192, sbg, (bf16_t*)(ws + WS_WQKV), 0, scr, r, lane); continue; } r -= I_QKV;
            if (r < I_WO) { transpose_item((const float*)AIN(IN_WO), 2048, 2048, 64, nullptr, (bf16_t*)(ws + WS_WO), 0, scr, r, lane); continue; } r -= I_WO;
            if (r < I_DKV) { transpose_item((const float*)AIN(IN_WDKV), 576, 2048, 18, kvg, (bf16_t*)(ws + WS_WDKQ), 0, scr, r, lane); continue; } r -= I_DKV;
            if (r < I_DQ) { transpose_item((const float*)AIN(IN_WDQ), 512, 2048, 16, mlag, (bf16_t*)(ws + WS_WDKQ), 576, scr, r, lane); continue; } r -= I_DQ;
            if (r < I_UKV) { transpose_item((const float*)AIN(IN_WUKV), 4096, 512, 128, kvlg, (bf16_t*)(ws + WS_WUKV), 0, scr, r, lane); continue; } r -= I_UKV;
            if (r < I_UQ) { transpose_item((const float*)AIN(IN_WUQ), 3072, 512, 96, qlg, (bf16_t*)(ws + WS_WUQ), 0, scr, r, lane); continue; } r -= I_UQ;
            if (r < I_MO) { transpose_item((const float*)AIN(IN_WMO), 2048, 2048, 64, nullptr, (bf16_t*)(ws + WS_WMO), 0, scr, r, lane); continue; } r -= I_MO;
            if (r < I_PQ) { transpose_item((const float*)AIN(IN_PWQ), 2048, 2048, 64, pg, (bf16_t*)(ws + WS_WPQ), 0, scr, r, lane); continue; } r -= I_PQ;
            transpose_item((const float*)AIN(IN_PWQ) + (size_t)DM * DM, 2048, 2048, 64, pg + DM, (bf16_t*)(ws + WS_WPQ) + (size_t)DM * DM, 0, scr, r, lane);
        }
        { u32x4 z = {0u, 0u, 0u, 0u}; bf16_t* p = (bf16_t*)(ws + WS_WDKQ) + (size_t)1088 * DM; for (int i = gtid; i < 192 * DM / 8; i += gthreads) *(u32x4*)(p + (size_t)i * 8) = z; }
        { const float* k1 = (const float*)AIN(IN_PK1); const float* k2 = (const float*)AIN(IN_PK2); bf16_t* kbd = (bf16_t*)(ws + WS_KBD);
          for (int i = gtid; i < 2 * 2048 * 256; i += gthreads) { const int kk = i & 255, n = (i >> 8) & 255, hh = (i >> 16) & 7, l = i >> 19; float v = 0.f;
              if (n < 128) { if (kk < 128) v = k1[(((size_t)l * PH + hh) * NKEYS + n) * 128 + kk]; } else { if (kk >= 128) v = k2[(((size_t)l * PH + hh) * NKEYS + (n - 128)) * 128 + (kk - 128)]; }
              kbd[i] = (bf16_t)f2bf(v); } }
        convert_tables((const float*)AIN(IN_PU), (const float*)AIN(IN_PV), pg, (bf16_t*)(ws + WS_TU), (bf16_t*)(ws + WS_TV), gtid, gthreads);
        for (int m = gw; m < T; m += NGW) row_to_bf16_rstd(x_in + (size_t)m * DM, XB + (size_t)m * DM, rstd + m, lane);
        { const int* pos = (const int*)AIN(IN_POS);
          for (int i = gtid; i < T * 32; i += gthreads) { const int t = i >> 5, j = i & 31; const float inv = powf(10000.f, -(float)(2 * j) / 64.f); const float ang = (float)pos[t] * inv;
              cs[2 * i] = cosf(ang); cs[2 * i + 1] = sinf(ang); } }
    }
    SEAM(0);

    {
        {
            if (SITE(1) && IN(1)) { PH_LOCALS;
                pg8::Gemm g{XB, (const bf16_t*)(ws + WS_WQKV), T, 3 * DM, DM, DM, 0}; pg8::StaticOrder S; S.init(T, 3 * DM, G, bx);
                pg8::EpiQKV E{(bf16_t*)(ws + WS_Q), (size_t)(WS_K - WS_Q) / 2, rstd, 0.08838834764831845f * LOG2E};
                pg8::gemm_phase<pg8::EpiQKV>(lds, g, S, E, wave, lane);
            }
            SEAM(1);
            if (SITE(2) && IN(2)) { PH_LOCALS;
                const int bh = bx >> 1, half = bx & 1, b = bh >> 4, h = bh & 15;
                if (bx < 256) {
                    const bf16_t* Qp = (const bf16_t*)(ws + WS_Q) + (size_t)b * SEQ * DM + h * HD; const bf16_t* Kp = (const bf16_t*)(ws + WS_K) + (size_t)b * SEQ * DM + h * HD;
                    const bf16_t* Vp = (const bf16_t*)(ws + WS_V) + (size_t)b * SEQ * DM + h * HD; bf16_t* Op = XB + (size_t)b * SEQ * DM + h * HD;
                    for (int i = 0; i < 8; ++i) { const int qb = 15 - (2 * i + ((i & 1) ^ half));
                        att::attn_unit<0>(lds, Qp, DM, Kp, Vp, DM, nullptr, nullptr, Op, DM, qb * 256, wave, lane); }
                }
            }
            SEAM(2);
            if (SITE(3) && IN(3)) { PH_LOCALS;
                pg8::Gemm g{XB, (const bf16_t*)(ws + WS_WO), T, DM, DM, DM, 0}; pg8::StaticOrder S; S.init(T, DM, G, bx);
                pg8::EpiRes E{X, x_in, DM};
                pg8::gemm_phase<pg8::EpiRes>(lds, g, S, E, wave, lane);
            }
            SEAM(3);
        }
        peer_phases<0>(lds, lo, hi, bar, wave, G, bx);
        SEAM(8);
        {
            if (SITE(9) && IN(9)) { PH_LOCALS;
                pg8::Gemm g{XB, (const bf16_t*)(ws + WS_WDKQ), T, NDKQ, DM, DM, 0}; pg8::StaticOrder S; S.init(T, NDKQ, G, bx);
                pg8::EpiF32 E{(float*)(ws + WS_DKQ), NDKQ, rstd};
                pg8::gemm_phase<pg8::EpiF32>(lds, g, S, E, wave, lane);
            }
            SEAM(9);
            if (SITE(10) && IN(10)) { PH_LOCALS;
                const float* dkq = (const float*)(ws + WS_DKQ); bf16_t* CB = (bf16_t*)(ws + WS_CB); bf16_t* CQB = (bf16_t*)(ws + WS_CQB); bf16_t* KR = (bf16_t*)(ws + WS_KR);
                for (int m = gw; m < T; m += NGW) { const float* r = dkq + (size_t)m * NDKQ;
                    const f32x4 a0 = *(const f32x4*)(r + lane * 8), a1 = *(const f32x4*)(r + lane * 8 + 4);
                    const f32x4 q0 = *(const f32x4*)(r + 576 + lane * 8), q1 = *(const f32x4*)(r + 576 + lane * 8 + 4);
                    float sa = a0[0] * a0[0] + a0[1] * a0[1] + a0[2] * a0[2] + a0[3] * a0[3] + a1[0] * a1[0] + a1[1] * a1[1] + a1[2] * a1[2] + a1[3] * a1[3];
                    float sq = q0[0] * q0[0] + q0[1] * q0[1] + q0[2] * q0[2] + q0[3] * q0[3] + q1[0] * q1[0] + q1[1] * q1[1] + q1[2] * q1[2] + q1[3] * q1[3];
                    sa = wave_sum(sa); sq = wave_sum(sq);
                    const float ra = 1.f / sqrtf(sa * (1.f / KVL) + EPS), rq = 1.f / sqrtf(sq * (1.f / QL) + EPS);
                    u32x4 w; w.x = pk2(a0[0] * ra, a0[1] * ra); w.y = pk2(a0[2] * ra, a0[3] * ra); w.z = pk2(a1[0] * ra, a1[1] * ra); w.w = pk2(a1[2] * ra, a1[3] * ra);
                    *(u32x4*)(CB + (size_t)m * KVL + lane * 8) = w;
                    u32x4 y; y.x = pk2(q0[0] * rq, q0[1] * rq); y.y = pk2(q0[2] * rq, q0[3] * rq); y.z = pk2(q1[0] * rq, q1[1] * rq); y.w = pk2(q1[2] * rq, q1[3] * rq);
                    *(u32x4*)(CQB + (size_t)m * QL + lane * 8) = y;
                    if (lane < 32) { const float x1 = r[512 + lane], x2 = r[512 + 32 + lane], co = cs[((size_t)m * 32 + lane) * 2], si = cs[((size_t)m * 32 + lane) * 2 + 1];
                        KR[(size_t)m * 64 + lane] = (bf16_t)f2bf(x1 * co - x2 * si); KR[(size_t)m * 64 + 32 + lane] = (bf16_t)f2bf(x2 * co + x1 * si); } }
            }
            SEAM(10);
            if (SITE(11) && IN(11)) { PH_LOCALS;
                pg8::Gemm g{(const bf16_t*)(ws + WS_CB), (const bf16_t*)(ws + WS_WUKV), T, 4096, KVL, KVL, 0}; pg8::StaticOrder S; S.init(T, 4096, G, bx);
                pg8::EpiUKV E{(bf16_t*)(ws + WS_KN), (bf16_t*)(ws + WS_VM), nullptr};
                pg8::gemm_phase<pg8::EpiUKV>(lds, g, S, E, wave, lane);
            }
            SEAM(11);
            if (SITE(12) && IN(12)) { PH_LOCALS;
                pg8::Gemm g{(const bf16_t*)(ws + WS_CQB), (const bf16_t*)(ws + WS_WUQ), T, 3072, QL, QL, 0}; pg8::StaticOrder S; S.init(T, 3072, G, bx);
                pg8::EpiB16 E{(bf16_t*)(ws + WS_QM), 3072, nullptr};
                pg8::gemm_phase<pg8::EpiB16>(lds, g, S, E, wave, lane);
            }
            SEAM(12);
            if (SITE(13) && IN(13)) { PH_LOCALS;
                const int bh = bx >> 1, half = bx & 1, b = bh >> 4, h = bh & 15;
                if (bx < 256) {
                    const bf16_t* Qp = (const bf16_t*)(ws + WS_QM) + (size_t)b * SEQ * 3072 + h * 192; const bf16_t* Kp = (const bf16_t*)(ws + WS_KN) + (size_t)b * SEQ * DM + h * HD;
                    const bf16_t* Vp = (const bf16_t*)(ws + WS_VM) + (size_t)b * SEQ * DM + h * HD; const bf16_t* Rp = (const bf16_t*)(ws + WS_KR) + (size_t)b * SEQ * 64;
                    bf16_t* Op = XB + (size_t)b * SEQ * DM + h * HD;
                    for (int i = 0; i < 8; ++i) { const int qb = 15 - (2 * i + ((i & 1) ^ half));
                        att::attn_unit<1>(lds, Qp, 3072, Kp, Vp, DM, Rp, cs + (size_t)b * SEQ * 64, Op, DM, qb * 256, wave, lane); }
                }
            }
            SEAM(13);
            if (SITE(14) && IN(14)) { PH_LOCALS;
                pg8::Gemm g{XB, (const bf16_t*)(ws + WS_WMO), T, DM, DM, DM, 0}; pg8::StaticOrder S; S.init(T, DM, G, bx);
                pg8::EpiRes E{X, X, DM};
                pg8::gemm_phase<pg8::EpiRes>(lds, g, S, E, wave, lane);
            }
            SEAM(14);
        }
        peer_phases<1>(lds, lo, hi, bar, wave, G, bx);
    }
#undef IN
#undef SEAM
}

extern "C" void kernel_launch(void* const* d_in, const int* in_sizes, int n_in, void* d_out, int out_size, void* d_ws, size_t ws_size, hipStream_t stream) {
    static int grid = 0;
    if (grid == 0) {
        if (n_in != 21 || out_size != T * DM || ws_size < WS_END) { fprintf(stderr, "kernel_launch: unexpected shapes (n_in %d out %d ws %zu need %zu)\n", n_in, out_size, ws_size, (size_t)WS_END); grid = -1; return; }
        int dev = 0, cus = 0, per_cu = 0;
        if (hipGetDevice(&dev) != hipSuccess || hipDeviceGetAttribute(&cus, hipDeviceAttributeMultiprocessorCount, dev) != hipSuccess) { grid = -1; return; }
        if (hipFuncSetAttribute((const void*)fwd, hipFuncAttributeMaxDynamicSharedMemorySize, LDS_BYTES) != hipSuccess) { fprintf(stderr, "kernel_launch: hipFuncSetAttribute failed\n"); grid = -1; return; }
        if (hipOccupancyMaxActiveBlocksPerMultiprocessor(&per_cu, (const void*)fwd, NTHR, LDS_BYTES) != hipSuccess || per_cu < 1) fprintf(stderr, "kernel_launch: occupancy query reports %d\n", per_cu);
        (void)hipGetLastError();
        grid = cus < 256 ? cus : 256;
    }
    if (grid < 0) return;
    (void)hipMemsetAsync((char*)d_ws + WS_CTL, 0, CTL_ZERO_BYTES, stream);
    Args a{};
    for (int i = 0; i < 21; ++i) a.in[i] = d_in[i];
    a.out = (float*)d_out; a.ws = (unsigned char*)d_ws;
#if MK_ONE_LAUNCH
    a.ph_lo = 0; a.ph_hi = 20;
    hipLaunchKernelGGL(fwd, dim3(grid), dim3(NTHR), LDS_BYTES, stream, a);
#else
    for (int ph = 0; ph < 20; ++ph) { a.ph_lo = ph; a.ph_hi = ph + 1; hipLaunchKernelGGL(fwd, dim3(grid), dim3(NTHR), LDS_BYTES, stream, a); }
#endif
}
```

```cpp
#include <hip/hip_runtime.h>
#include <cstdio>
#include <cstdint>

#ifndef MK_ONE_LAUNCH
#define MK_ONE_LAUNCH 1
#endif

#define LAS __attribute__((address_space(3)))
#define GAS __attribute__((address_space(1)))
typedef unsigned short bf16_t;
typedef short bf16x8 __attribute__((ext_vector_type(8)));
typedef short s16x4 __attribute__((ext_vector_type(4)));
typedef float f32x2 __attribute__((ext_vector_type(2)));
typedef float f32x4 __attribute__((ext_vector_type(4)));
typedef float f32x16 __attribute__((ext_vector_type(16)));
typedef unsigned u32x2 __attribute__((ext_vector_type(2)));
typedef unsigned u32x4 __attribute__((ext_vector_type(4)));
typedef __bf16 bf16v2 __attribute__((ext_vector_type(2)));
__device__ __forceinline__ float dot2bf(unsigned a, unsigned b, float c) { return __builtin_amdgcn_fdot2_f32_bf16(__builtin_bit_cast(bf16v2, a), __builtin_bit_cast(bf16v2, b), c, false); }

constexpr int NB = 8, SEQ = 4096, DM = 2048, T = NB * SEQ, NH = 16, HD = 128;
constexpr int KVL = 512, QKR = 64, QL = 512, NEXP = 16384, PH = 8, NKEYS = 128, TOPK = 16, NSEL = PH * TOPK;
constexpr int NDKQ = 1280;
constexpr float EPS = 1e-6f;
constexpr float LOG2E = 1.4426950408889634f;
constexpr int NWAVES = 8, NTHR = 512;

constexpr size_t MiB = 1u << 20;
constexpr size_t WS_CTL = 0, CTL_ZERO_BYTES = 1 * MiB;
constexpr size_t WS_RSTD = 1 * MiB;
constexpr size_t WS_CS = 2 * MiB;
constexpr size_t WS_WQKV = 16 * MiB;
constexpr size_t WS_WO = 40 * MiB;
constexpr size_t WS_WDKQ = 48 * MiB;
constexpr size_t WS_WUKV = 54 * MiB;
constexpr size_t WS_WUQ = 58 * MiB;
constexpr size_t WS_WMO = 62 * MiB;
constexpr size_t WS_WPQ = 70 * MiB;
constexpr size_t WS_KBD = 86 * MiB;
constexpr size_t WS_TU = 96 * MiB;
constexpr size_t WS_TV = 160 * MiB;
constexpr size_t WS_CB = 96 * MiB;
constexpr size_t WS_CQB = 128 * MiB;
constexpr size_t WS_XB = 224 * MiB;
constexpr size_t WS_R0 = 352 * MiB;
constexpr size_t WS_Q = WS_R0, WS_K = WS_R0 + 128 * MiB, WS_V = WS_R0 + 256 * MiB;
constexpr size_t WS_KN = WS_R0, WS_VM = WS_R0 + 128 * MiB, WS_QM = WS_R0 + 256 * MiB;
constexpr size_t WS_KR = WS_R0 + 448 * MiB;
constexpr size_t WS_QP = WS_R0, WS_SC = WS_R0 + 128 * MiB, WS_IDS = WS_R0 + 384 * MiB, WS_GATE = WS_R0 + 400 * MiB;
constexpr size_t WS_DKQ = WS_R0 + 256 * MiB;
constexpr size_t WS_END = WS_R0 + 452 * MiB;

constexpr int CW_TMO = 0, CW_CHK = 2, CW_BAR = 4096;

__device__ __forceinline__ unsigned f2bf(float f) { unsigned u = __builtin_bit_cast(unsigned, f); return (u + 0x7fffu + ((u >> 16) & 1u)) >> 16; }
__device__ __forceinline__ unsigned pk2(float lo, float hi) { return f2bf(lo) | (f2bf(hi) << 16); }
__device__ __forceinline__ float bflo(unsigned w) { return __builtin_bit_cast(float, w << 16); }
__device__ __forceinline__ float bfhi(unsigned w) { return __builtin_bit_cast(float, w & 0xffff0000u); }
__device__ __forceinline__ float bf2f(bf16_t h) { return __builtin_bit_cast(float, (unsigned)h << 16); }
__device__ __forceinline__ unsigned cvtpk(float lo, float hi) { unsigned r; asm volatile("v_cvt_pk_bf16_f32 %0, %1, %2" : "=v"(r) : "v"(lo), "v"(hi)); return r; }
__device__ __forceinline__ float wave_sum(float v) {
#pragma unroll
    for (int o = 1; o < 64; o <<= 1) v += __shfl_xor(v, o);
    return v;
}
__device__ __forceinline__ unsigned wave_max_u32(unsigned v) {
#pragma unroll
    for (int o = 1; o < 64; o <<= 1) { unsigned w = (unsigned)__shfl_xor((int)v, o); v = v > w ? v : w; }
    return v;
}
__device__ __forceinline__ int lane_id_v() { int l; asm volatile("v_mbcnt_lo_u32_b32 %0, -1, 0\n\tv_mbcnt_hi_u32_b32 %0, -1, %0" : "=v"(l)); return l; }
#define LDS_WAIT() asm volatile("s_waitcnt lgkmcnt(0)" ::: "memory")
#define VM_WAIT() asm volatile("s_waitcnt vmcnt(0)" ::: "memory")
#define SBAR() __builtin_amdgcn_sched_barrier(0)

namespace pg8 {
constexpr int BM = 256, BK = 64, HALF = 128, HTB = HALF * BK * 2, STAGE_BYTES = 8 * HTB, NXCD = 8, WGM = 8;
__host__ __device__ __forceinline__ int lds_byte(int r, int c) { const int st = (r >> 4) * 2 + (c >> 5), rr = r & 15, cc = c & 31, ob = rr * 64 + cc * 2; return st * 1024 + (ob ^ (((ob >> 9) & 1) << 5)); }
__host__ __device__ __forceinline__ void stage_rc(int b, int& R, int& C) { const int st = b / 1024, sb = b % 1024, swz = sb ^ (((sb >> 9) & 1) << 5); R = (st >> 1) * 16 + swz / 64; C = (st & 1) * 32 + (swz % 64) / 2; }
__host__ __device__ __forceinline__ int perm32(int rho) { const int n = rho >> 4, i = rho & 15; return 8 * (i >> 2) + 4 * n + (i & 3); }
struct Unit { int pm, pn; };
struct Gemm { const bf16_t* A; const bf16_t* Bt; int M, N, K, lda, a_pn; };
struct StaticOrder {
    int nM, nN, nwg, G, c;
    __device__ void init(int M, int N, int G_, int c_) { nM = M / BM; nN = N / BM; nwg = nM * nN; G = G_; c = c_; }
    __device__ bool next(int i, Unit& u) const {
        const long L = (long)i * G + c; if (L >= nwg) return false;
        int wgid = (int)L; { const int q = nwg / NXCD, r = nwg % NXCD, xcd = wgid % NXCD, off = wgid / NXCD; wgid = (xcd < r ? xcd * (q + 1) : r * (q + 1) + (xcd - r) * q) + off; }
        const int nig = WGM * nN, gid = wgid / nig, fm = gid * WGM, gsz = (nM - fm) < WGM ? (nM - fm) : WGM;
        u.pm = fm + ((wgid % nig) % gsz); u.pn = (wgid % nig) / gsz; return true;
    }
};
struct EpiQKV {
    static constexpr bool PERM = true;
    bf16_t* Q; size_t split_stride; const float* rstd; float qscale;
    __device__ __forceinline__ void operator()(const f32x4 (&acc)[2][2][4][2], const Unit& u, int wr, int wc, int fr, int fq) const {
        const int row0 = u.pm * BM + wr * 64 + fr; int colt = u.pn * BM; const int t = colt / DM; bf16_t* base = Q + (size_t)t * split_stride; colt -= t * DM;
        const float sc = t == 0 ? qscale : 1.f; const int col0 = colt + wc * 32 + 8 * fq;
#pragma unroll
        for (int ai = 0; ai < 2; ++ai)
#pragma unroll
            for (int m = 0; m < 4; ++m) { const int row = row0 + ai * HALF + m * 16; const float rs = rstd[row] * sc; bf16_t* rowp = base + (size_t)row * DM + col0;
#pragma unroll
                for (int bj = 0; bj < 2; ++bj) { const f32x4 v0 = acc[ai][bj][m][0] * rs, v1 = acc[ai][bj][m][1] * rs;
                    u32x4 w; w.x = cvtpk(v0[0], v0[1]); w.y = cvtpk(v0[2], v0[3]); w.z = cvtpk(v1[0], v1[1]); w.w = cvtpk(v1[2], v1[3]);
                    *(u32x4*)(rowp + bj * HALF) = w; } }
    }
};
struct EpiB16 {
    static constexpr bool PERM = true;
    bf16_t* O; int ldc; const float* rstd;
    __device__ __forceinline__ void operator()(const f32x4 (&acc)[2][2][4][2], const Unit& u, int wr, int wc, int fr, int fq) const {
        const int row0 = u.pm * BM + wr * 64 + fr, col0 = u.pn * BM + wc * 32 + 8 * fq;
#pragma unroll
        for (int ai = 0; ai < 2; ++ai)
#pragma unroll
            for (int m = 0; m < 4; ++m) { const int row = row0 + ai * HALF + m * 16; const float rs = rstd ? rstd[row] : 1.f; bf16_t* rowp = O + (size_t)row * ldc + col0;
#pragma unroll
                for (int bj = 0; bj < 2; ++bj) { const f32x4 v0 = acc[ai][bj][m][0] * rs, v1 = acc[ai][bj][m][1] * rs;
                    u32x4 w; w.x = cvtpk(v0[0], v0[1]); w.y = cvtpk(v0[2], v0[3]); w.z = cvtpk(v1[0], v1[1]); w.w = cvtpk(v1[2], v1[3]);
                    *(u32x4*)(rowp + bj * HALF) = w; } }
    }
};
struct EpiUKV {
    static constexpr bool PERM = true;
    bf16_t* KN; bf16_t* VM; const float* rstd;
    __device__ __forceinline__ void operator()(const f32x4 (&acc)[2][2][4][2], const Unit& u, int wr, int wc, int fr, int fq) const {
        const int row0 = u.pm * BM + wr * 64 + fr, col0 = u.pn * HD + wc * 32 + 8 * fq;
#pragma unroll
        for (int ai = 0; ai < 2; ++ai)
#pragma unroll
            for (int m = 0; m < 4; ++m) { const int row = row0 + ai * HALF + m * 16; const float rs = rstd ? rstd[row] : 1.f;
#pragma unroll
                for (int bj = 0; bj < 2; ++bj) { const f32x4 v0 = acc[ai][bj][m][0] * rs, v1 = acc[ai][bj][m][1] * rs;
                    u32x4 w; w.x = cvtpk(v0[0], v0[1]); w.y = cvtpk(v0[2], v0[3]); w.z = cvtpk(v1[0], v1[1]); w.w = cvtpk(v1[2], v1[3]);
                    *(u32x4*)((bj ? VM : KN) + (size_t)row * DM + col0) = w; } }
    }
};
struct EpiF32 {
    static constexpr bool PERM = false;
    float* C; int ldc; const float* rstd;
    __device__ __forceinline__ void operator()(const f32x4 (&acc)[2][2][4][2], const Unit& u, int wr, int wc, int fr, int fq) const {
        const int row0 = u.pm * BM + wr * 64 + fr, col0 = u.pn * BM + wc * 32 + 4 * fq;
#pragma unroll
        for (int ai = 0; ai < 2; ++ai)
#pragma unroll
            for (int m = 0; m < 4; ++m) { const int row = row0 + ai * HALF + m * 16; const float rs = rstd ? rstd[row] : 1.f; float* rowp = C + (size_t)row * ldc + col0;
#pragma unroll
                for (int bj = 0; bj < 2; ++bj)
#pragma unroll
                    for (int n = 0; n < 2; ++n) *(f32x4*)(rowp + bj * HALF + n * 16) = acc[ai][bj][m][n] * rs; }
    }
};
struct EpiRes {
    static constexpr bool PERM = false;
    float* C; const float* base; int ldc;
    __device__ __forceinline__ void operator()(const f32x4 (&acc)[2][2][4][2], const Unit& u, int wr, int wc, int fr, int fq) const {
        const int row0 = u.pm * BM + wr * 64 + fr, col0 = u.pn * BM + wc * 32 + 4 * fq;
#pragma unroll
        for (int ai = 0; ai < 2; ++ai)
#pragma unroll
            for (int m = 0; m < 4; ++m) { const size_t ro = (size_t)(row0 + ai * HALF + m * 16) * ldc + col0;
#pragma unroll
                for (int bj = 0; bj < 2; ++bj)
#pragma unroll
                    for (int n = 0; n < 2; ++n) { const f32x4 b = *(const f32x4*)(base + ro + bj * HALF + n * 16); *(f32x4*)(C + ro + bj * HALF + n * 16) = acc[ai][bj][m][n] + b; } }
    }
};

template <class Epi>
__device__ __forceinline__ void gemm_phase(LAS unsigned char* lds, const Gemm g, const StaticOrder& S, const Epi& E, const int wid, const int lane) {
    const int tid = wid * 64 + lane, wr = wid >> 2, wc = wid & 3, fr = lane & 15, fq = lane >> 4;
    const int K = g.K, nt = K / BK, lda = g.lda;
    unsigned voffA[2], voffB[2];
#pragma unroll
    for (int i = 0; i < 2; ++i) { int R, C; stage_rc(tid * 16 + i * 8192, R, C); const int Rb = Epi::PERM ? ((R & ~31) + perm32(R & 31)) : R;
        voffA[i] = (unsigned)(R * lda + C) * 2u; voffB[i] = (unsigned)(Rb * K + C) * 2u; }
    const size_t kstep = (size_t)(BK * 2);
    const size_t hstepA = (size_t)HALF * lda * 2, hstepB = (size_t)HALF * K * 2;
    const size_t tstepA = 2 * hstepA, tstepB = 2 * hstepB;
    const unsigned ldsw = (unsigned)wid * 1024u;
    const int aoff = lds_byte(wr * 64 + fr, fq * 8), boff = lds_byte(wc * 32 + fr, fq * 8);
#define PG8_SA(b, h) (((b) * 2 + (h)) * HTB)
#define PG8_SB(b, h) ((4 + (b) * 2 + (h)) * HTB)
#define PG8_STAGE(bufoff, gbase, voff) do { _Pragma("unroll") for (int _i = 0; _i < 2; ++_i) \
        __builtin_amdgcn_global_load_lds((const unsigned*)((const char*)(gbase) + (voff)[_i]), (LAS unsigned*)(lds + (bufoff) + ldsw + _i * 8192), 16, 0, 0); } while (0)
#define PG8_LDA(dst, b, h) do { _Pragma("unroll") for (int m = 0; m < 4; ++m) _Pragma("unroll") for (int k = 0; k < 2; ++k) dst[m][k] = *(const LAS bf16x8*)(lds + PG8_SA(b, h) + aoff + m * 2048 + k * 1024); } while (0)
#define PG8_LDB(dst, b, h) do { _Pragma("unroll") for (int n = 0; n < 2; ++n) _Pragma("unroll") for (int k = 0; k < 2; ++k) dst[n][k] = *(const LAS bf16x8*)(lds + PG8_SB(b, h) + boff + n * 2048 + k * 1024); } while (0)
#define PG8_MMA(ai, bj, At, Bt) do { __builtin_amdgcn_s_setprio(1); _Pragma("unroll") for (int m = 0; m < 4; ++m) _Pragma("unroll") for (int n = 0; n < 2; ++n) _Pragma("unroll") for (int k = 0; k < 2; ++k) \
        acc[ai][bj][m][n] = __builtin_amdgcn_mfma_f32_16x16x32_bf16(Bt[n][k], At[m][k], acc[ai][bj][m][n], 0, 0, 0); __builtin_amdgcn_s_setprio(0); } while (0)
#define PG8_WAIT_V(n) asm volatile("s_waitcnt vmcnt(" #n ")" ::: "memory")
#define PG8_WAIT_L(n) asm volatile("s_waitcnt lgkmcnt(" #n ")" ::: "memory")
#define PG8_BAR __builtin_amdgcn_s_barrier()
#define PG8_SCHED __builtin_amdgcn_sched_barrier(0)
    Unit cur, nxt; int ui = 0;
    if (!S.next(0, cur)) return;
    f32x4 acc[2][2][4][2];
#pragma unroll
    for (int a = 0; a < 2; ++a)
#pragma unroll
        for (int b = 0; b < 2; ++b)
#pragma unroll
            for (int m = 0; m < 4; ++m)
#pragma unroll
                for (int n = 0; n < 2; ++n) acc[a][b][m][n] = (f32x4){0.f, 0.f, 0.f, 0.f};
    bf16x8 At[4][2], B0[2][2], B1[2][2];
    const char* cA = (const char*)g.A + (size_t)cur.pm * tstepA + (size_t)cur.pn * g.a_pn * 2; const char* cB = (const char*)g.Bt + (size_t)cur.pn * tstepB;
    PG8_STAGE(PG8_SB(0, 0), cB, voffB); PG8_STAGE(PG8_SB(0, 1), cB + hstepB, voffB); PG8_STAGE(PG8_SA(0, 0), cA, voffA); PG8_STAGE(PG8_SA(0, 1), cA + hstepA, voffA);
    if (wr == 1) PG8_BAR;
    PG8_WAIT_V(2); PG8_BAR;
    PG8_STAGE(PG8_SB(1, 0), cB + kstep, voffB); PG8_STAGE(PG8_SA(1, 0), cA + kstep, voffA); PG8_STAGE(PG8_SB(1, 1), cB + hstepB + kstep, voffB);
    PG8_WAIT_V(6); PG8_BAR;
#pragma unroll 1
    for (;;) {
        const bool has_next = S.next(ui + 1, nxt);
        const char* nA = has_next ? (const char*)g.A + (size_t)nxt.pm * tstepA + (size_t)nxt.pn * g.a_pn * 2 : cA; const char* nB = has_next ? (const char*)g.Bt + (size_t)nxt.pn * tstepB : cB;
#pragma unroll 1
        for (int t = 0; t < nt; t += 2) {
            const bool last = (t == nt - 2);
            const char* a1 = cA + (size_t)(t + 1) * kstep;
            const char* a2 = last ? nA : cA + (size_t)(t + 2) * kstep; const char* b2 = last ? nB : cB + (size_t)(t + 2) * kstep;
            const char* a3 = a2 + kstep; const char* b3 = b2 + kstep;
            PG8_LDB(B0, 0, 0); PG8_LDB(B1, 0, 1); PG8_SCHED; PG8_LDA(At, 0, 0); PG8_STAGE(PG8_SA(1, 1), a1 + hstepA, voffA);
            PG8_WAIT_V(8); PG8_WAIT_L(0); PG8_BAR; PG8_MMA(0, 0, At, B0); PG8_MMA(0, 1, At, B1); PG8_BAR; PG8_SCHED;
            PG8_LDA(At, 0, 1); PG8_STAGE(PG8_SB(0, 0), b2, voffB); PG8_STAGE(PG8_SB(0, 1), b2 + hstepB, voffB); PG8_STAGE(PG8_SA(0, 0), a2, voffA);
            PG8_WAIT_V(8); PG8_WAIT_L(0); PG8_BAR; PG8_MMA(1, 0, At, B0); PG8_MMA(1, 1, At, B1); PG8_BAR; PG8_SCHED;
            PG8_LDB(B0, 1, 0); PG8_LDB(B1, 1, 1); PG8_SCHED; PG8_LDA(At, 1, 0); PG8_STAGE(PG8_SA(0, 1), a2 + hstepA, voffA);
            PG8_WAIT_V(8); PG8_WAIT_L(0); PG8_BAR; PG8_MMA(0, 0, At, B0); PG8_MMA(0, 1, At, B1); PG8_BAR; PG8_SCHED;
            PG8_LDA(At, 1, 1); PG8_STAGE(PG8_SB(1, 0), b3, voffB); PG8_STAGE(PG8_SB(1, 1), b3 + hstepB, voffB); PG8_STAGE(PG8_SA(1, 0), a3, voffA);
            PG8_WAIT_V(8); PG8_WAIT_L(0); PG8_BAR; PG8_MMA(1, 0, At, B0); PG8_MMA(1, 1, At, B1); PG8_BAR; PG8_SCHED;
        }
        if (wr == 0) PG8_BAR;
        E(acc, cur, wr, wc, fr, fq);
        if (!has_next) break;
#pragma unroll
        for (int a = 0; a < 2; ++a)
#pragma unroll
            for (int b = 0; b < 2; ++b)
#pragma unroll
                for (int m = 0; m < 4; ++m)
#pragma unroll
                    for (int n = 0; n < 2; ++n) acc[a][b][m][n] = (f32x4){0.f, 0.f, 0.f, 0.f};
        cur = nxt; cA = nA; cB = nB; ++ui;
        if (wr == 1) PG8_BAR;
    }
    PG8_WAIT_V(0);
    PG8_BAR;
#undef PG8_SA
#undef PG8_SB
#undef PG8_STAGE
#undef PG8_LDA
#undef PG8_LDB
#undef PG8_MMA
#undef PG8_WAIT_V
#undef PG8_WAIT_L
#undef PG8_BAR
#undef PG8_SCHED
}
}

namespace att {
constexpr int SHM_V = 16384, SHM_K = 16384, SHM_R = 8192;
constexpr int OFF_V = 0, OFF_K = 2 * SHM_V, OFF_R = OFF_K + 2 * SHM_K, OFF_WS = OFF_R + 2 * SHM_R, LDS_BYTES = OFF_WS + NWAVES * 64 * 4;
#define KSWZ(row, colB) ((row) * 256 + ((colB) ^ (((row) & 7) << 4)))
#define RSWZ(row, colB) ((row) * 128 + ((colB) ^ (((row) & 7) << 4)))
__device__ __forceinline__ int v_st(int k, int c) { const int kk = (k & ~0xC) | ((k & 4) << 1) | ((k & 8) >> 1); return ((kk >> 3) * 4 + (c >> 5)) * 512 + ((kk & 7) * 32 + (c & 31)) * 2; }
__device__ __forceinline__ int v_rd_base(int lane) { return ((lane & 3) << 3) | (((lane >> 2) & 3) << 6) | (((lane >> 4) & 1) << 5) | (((lane >> 5) & 1) << 8); }
__device__ __forceinline__ int crow(int r, int hi) { return (r & 3) + 8 * (r >> 2) + 4 * hi; }
__device__ __forceinline__ float pl_sum(float x) { auto rr = __builtin_amdgcn_permlane32_swap(__float_as_uint(x), __float_as_uint(x), false, false); return __uint_as_float(rr[0]) + __uint_as_float(rr[1]); }
__device__ __forceinline__ float pl_max(float x) { auto rr = __builtin_amdgcn_permlane32_swap(__float_as_uint(x), __float_as_uint(x), false, false); return fmaxf(__uint_as_float(rr[0]), __uint_as_float(rr[1])); }

#define PK4(P, B_, OUT) do { unsigned a0 = cvtpk(P[B_+0], P[B_+1]), a1 = cvtpk(P[B_+2], P[B_+3]);                          \
        unsigned b0 = cvtpk(P[B_+4], P[B_+5]), b1 = cvtpk(P[B_+6], P[B_+7]);                                             \
        auto r0 = __builtin_amdgcn_permlane32_swap(a0, b0, false, false); auto r1 = __builtin_amdgcn_permlane32_swap(a1, b1, false, false); \
        u32x4 w = {r0[0], r1[0], r0[1], r1[1]}; OUT = __builtin_bit_cast(bf16x8, w); } while (0)

__device__ __forceinline__ void pv_tile(f32x16* o, unsigned vb, bf16x8 pa0, bf16x8 pa1, bf16x8 pa2, bf16x8 pa3) {
#define TRRD(dst, off) asm volatile("ds_read_b64_tr_b16 %0, %1 offset:%2" : "=&v"(dst) : "v"(vb), "i"(off) : "memory")
#define PV_D0(d0) do { s16x4 l0, l1, l2, l3, h0, h1, h2, h3; constexpr int b_ = (d0) * 512;   \
        TRRD(l0, b_); TRRD(h0, b_ + 2048); TRRD(l1, b_ + 4096); TRRD(h1, b_ + 6144); TRRD(l2, b_ + 8192); TRRD(h2, b_ + 10240); TRRD(l3, b_ + 12288); TRRD(h3, b_ + 14336); \
        asm volatile("s_waitcnt lgkmcnt(0)" ::: "memory"); SBAR();   \
        o[d0] = __builtin_amdgcn_mfma_f32_32x32x16_bf16(pa0, (bf16x8){l0[0], l0[1], l0[2], l0[3], h0[0], h0[1], h0[2], h0[3]}, o[d0], 0, 0, 0);   \
        o[d0] = __builtin_amdgcn_mfma_f32_32x32x16_bf16(pa1, (bf16x8){l1[0], l1[1], l1[2], l1[3], h1[0], h1[1], h1[2], h1[3]}, o[d0], 0, 0, 0);   \
        o[d0] = __builtin_amdgcn_mfma_f32_32x32x16_bf16(pa2, (bf16x8){l2[0], l2[1], l2[2], l2[3], h2[0], h2[1], h2[2], h2[3]}, o[d0], 0, 0, 0);   \
        o[d0] = __builtin_amdgcn_mfma_f32_32x32x16_bf16(pa3, (bf16x8){l3[0], l3[1], l3[2], l3[3], h3[0], h3[1], h3[2], h3[3]}, o[d0], 0, 0, 0); } while (0)
    PV_D0(0); PV_D0(1); PV_D0(2); PV_D0(3);
#undef PV_D0
#undef TRRD
}

__device__ __forceinline__ void sb_tile(f32x16& p0, f32x16& p1, float& R, int dq, int hi) {
    const float NEG = -__builtin_inff();
    asm volatile("" : "+v"(dq));
    float g[8];
#define SB_GRP(P, half, i) do { float Lv[4], zv[4];                                                                              \
        _Pragma("unroll") for (int jj = 0; jj < 4; ++jj) { const int c = jj + 8 * (i) + 32 * (half); const bool ok = dq >= c;  \
            const float z = fminf(P[4 * (i) + jj], 80.f); const float e = __builtin_amdgcn_exp2f(z);                               \
            const float sp = __builtin_amdgcn_logf(1.f + e); Lv[jj] = ok ? -sp : 0.f; zv[jj] = ok ? z : NEG; }                      \
        const float s3 = Lv[3], s2 = Lv[2] + s3, s1 = Lv[1] + s2, s0 = Lv[0] + s1;                                                \
        P[4 * (i) + 0] = zv[0] + s0; P[4 * (i) + 1] = zv[1] + s1; P[4 * (i) + 2] = zv[2] + s2; P[4 * (i) + 3] = zv[3] + s3;      \
        g[(half) * 4 + (i)] = s0; } while (0)
    SB_GRP(p0, 0, 0); SB_GRP(p0, 0, 1); SB_GRP(p0, 0, 2); SB_GRP(p0, 0, 3);
    SB_GRP(p1, 1, 0); SB_GRP(p1, 1, 1); SB_GRP(p1, 1, 2); SB_GRP(p1, 1, 3);
#undef SB_GRP
    float c[8], Tk[8];
#pragma unroll
    for (int k = 0; k < 8; ++k) c[k] = pl_sum(g[k]);
    Tk[7] = 0.f;
#pragma unroll
    for (int k = 6; k >= 0; --k) Tk[k] = Tk[k + 1] + c[k + 1];
    const float tot = Tk[0] + c[0];
#pragma unroll
    for (int k = 0; k < 8; ++k) { const float add = R + Tk[k] + (hi == 0 ? (c[k] - g[k]) : 0.f);
#pragma unroll
        for (int jj = 0; jj < 4; ++jj) { if (k < 4) p0[4 * k + jj] = __builtin_amdgcn_exp2f(p0[4 * k + jj] + add); else p1[4 * (k - 4) + jj] = __builtin_amdgcn_exp2f(p1[4 * (k - 4) + jj] + add); } }
    R += tot;
}

template <int MODE>
__device__ __forceinline__ void attn_unit(LAS unsigned char* lds, const bf16_t* Qp, int qpitch, const bf16_t* Kp, const bf16_t* Vp, int kvpitch,
                                          const bf16_t* Rp, const float* cs, bf16_t* Op, int opitch, int q0, const int wid, const int lane) {
    constexpr int NQF = MODE ? 12 : 8;
    constexpr float SCALE = 0.07216878364870323f;
    constexpr float C2 = LOG2E * SCALE, THR = 8.f, SB_EXIT = 40.f;
    const int r32 = lane & 31, hi = lane >> 5;
    const int qrow = q0 + wid * 32 + r32;
    LAS unsigned char* V_lds = lds + OFF_V; LAS unsigned char* K_lds = lds + OFF_K; LAS unsigned char* R_lds = lds + OFF_R;
    LAS float* wsf = (LAS float*)(lds + OFF_WS) + wid * 64;
    bf16x8 qr[NQF];
#pragma unroll
    for (int d0 = 0; d0 < NQF; ++d0) qr[d0] = *(const bf16x8*)(Qp + (size_t)qrow * qpitch + d0 * 16 + hi * 8);
    if constexpr (MODE == 1) {
#pragma unroll
        for (int f = 0; f < 2; ++f) { const int ib = f * 16 + hi * 8; const float* csr = cs + (size_t)qrow * 64 + ib * 2;
            bf16x8 a = qr[8 + f], b = qr[10 + f];
#pragma unroll
            for (int j = 0; j < 8; ++j) { const float co = csr[2 * j], si = csr[2 * j + 1], x1 = bf2f((bf16_t)a[j]), x2 = bf2f((bf16_t)b[j]);
                a[j] = (short)f2bf(x1 * co - x2 * si); b[j] = (short)f2bf(x2 * co + x1 * si); }
            qr[8 + f] = a; qr[10 + f] = b; }
    }
    const int NT = q0 / 64 + 4;
    const unsigned vb0 = (unsigned)(size_t)(V_lds) + (unsigned)v_rd_base(lane);
    unsigned koff[2], voff[2], roff;
#pragma unroll
    for (int i = 0; i < 2; ++i) { const int p = (wid * 2 + i) * 64 + lane;
        { const int row = p >> 4, pc = p & 15; koff[i] = (unsigned)(row * kvpitch + ((pc ^ (row & 7)) * 8)); }
        { const int sub = p >> 5, w = p & 31, kk = (sub >> 2) * 8 + (w >> 2), c = (sub & 3) * 32 + (w & 3) * 8, k = (kk & ~0xC) | ((kk & 4) << 1) | ((kk & 8) >> 1); voff[i] = (unsigned)(k * kvpitch + c); } }
    { const int p = wid * 64 + lane, row = p >> 3, pc = p & 7; roff = (unsigned)(row * 64 + ((pc ^ (row & 7)) * 8)); }
#define TILE_OF(it) (MODE ? (it) : (NT - 1 - (it)))
#define STAGE(jt, bf) do { const size_t kb_ = (size_t)(jt) * 64 * kvpitch;                                                                                   \
        _Pragma("unroll") for (int i_ = 0; i_ < 2; ++i_) {                                                                                                   \
            __builtin_amdgcn_global_load_lds((const unsigned*)(Kp + kb_ + koff[i_]), (LAS unsigned*)(K_lds + (bf) * SHM_K + (wid * 2 + i_) * 1024), 16, 0, 0);   \
            __builtin_amdgcn_global_load_lds((const unsigned*)(Vp + kb_ + voff[i_]), (LAS unsigned*)(V_lds + (bf) * SHM_V + (wid * 2 + i_) * 1024), 16, 0, 0); } \
        if constexpr (MODE == 1) __builtin_amdgcn_global_load_lds((const unsigned*)(Rp + (size_t)(jt) * 64 * 64 + roff), (LAS unsigned*)(R_lds + (bf) * SHM_R + wid * 1024), 16, 0, 0); } while (0)
    float m_reg = -1e30f, l_reg = 0.f, Rrun = 0.f; f32x16 o[4];
#pragma unroll
    for (int d = 0; d < 4; ++d) o[d] = f32x16{};
    STAGE(TILE_OF(0), 0);
    __syncthreads();
    for (int it = 0; it < NT; ++it) {
        const int buf = it & 1, jt = TILE_OF(it), k0 = jt * 64;
        if (it + 1 < NT) STAGE(TILE_OF(it + 1), buf ^ 1);
        f32x16 p0 = f32x16{}, p1 = f32x16{};
        {
            LAS unsigned char* kb = K_lds + buf * SHM_K;
#pragma unroll
            for (int d0 = 0; d0 < 8; ++d0) { LAS unsigned char* a = kb + KSWZ(r32, ((d0 & 3) * 16 + hi * 8) * 2) + (d0 >> 2) * 128;
                const bf16x8 b0 = *(LAS bf16x8*)a, b1 = *(LAS bf16x8*)(a + 32 * 256);
                p0 = __builtin_amdgcn_mfma_f32_32x32x16_bf16(b0, qr[d0], p0, 0, 0, 0);
                p1 = __builtin_amdgcn_mfma_f32_32x32x16_bf16(b1, qr[d0], p1, 0, 0, 0); }
            if constexpr (MODE == 1) {
                LAS unsigned char* rb = R_lds + buf * SHM_R;
#pragma unroll
                for (int d0 = 0; d0 < 4; ++d0) { LAS unsigned char* a = rb + RSWZ(r32, (d0 * 16 + hi * 8) * 2);
                    const bf16x8 b0 = *(LAS bf16x8*)a, b1 = *(LAS bf16x8*)(a + 32 * 128);
                    p0 = __builtin_amdgcn_mfma_f32_32x32x16_bf16(b0, qr[8 + d0], p0, 0, 0, 0);
                    p1 = __builtin_amdgcn_mfma_f32_32x32x16_bf16(b1, qr[8 + d0], p1, 0, 0, 0); }
            }
        }
        bf16x8 pa0, pa1, pa2, pa3;
        if constexpr (MODE == 0) {
            sb_tile(p0, p1, Rrun, qrow - 1 - k0 - 4 * hi, hi);
        } else {
            const float NEG = -__builtin_inff();
            if (k0 + 63 > q0 + wid * 32) {
                int dq = qrow - k0 - 4 * hi; asm volatile("" : "+v"(dq));
#pragma unroll
                for (int r = 0; r < 16; ++r) { const int c = (r & 3) + 8 * (r >> 2); if (dq < c) p0[r] = NEG; if (dq < c + 32) p1[r] = NEG; }
            }
            float pmax = p0[0];
#pragma unroll
            for (int r = 1; r < 16; ++r) pmax = fmaxf(pmax, p0[r]);
#pragma unroll
            for (int r = 0; r < 16; ++r) pmax = fmaxf(pmax, p1[r]);
            pmax = pl_max(pmax);
            float mn, alpha;
            if (__all((pmax - m_reg) * SCALE <= THR)) { mn = m_reg; alpha = 1.f; }
            else { mn = fmaxf(m_reg, pmax); alpha = __builtin_amdgcn_exp2f((m_reg - mn) * C2); m_reg = mn; }
            const float mnL = -mn * C2;
#pragma unroll
            for (int r = 0; r < 16; ++r) { p0[r] = __builtin_amdgcn_exp2f(fmaf(p0[r], C2, mnL)); p1[r] = __builtin_amdgcn_exp2f(fmaf(p1[r], C2, mnL)); }
            float ps = 0.f;
#pragma unroll
            for (int r = 0; r < 16; ++r) ps += p0[r] + p1[r];
            ps = pl_sum(ps);
            l_reg = l_reg * alpha + ps;
            if (__any(alpha < 1.f)) { if (hi == 0) wsf[r32] = alpha; LDS_WAIT();
#pragma unroll
                for (int r = 0; r < 16; ++r) { const float al = wsf[crow(r, hi)];
#pragma unroll
                    for (int d = 0; d < 4; ++d) o[d][r] *= al; } }
        }
        PK4(p0, 0, pa0); PK4(p0, 8, pa1); PK4(p1, 0, pa2); PK4(p1, 8, pa3);
        SBAR();
        pv_tile(o, vb0 + buf * SHM_V, pa0, pa1, pa2, pa3);
        if constexpr (MODE == 0) {
            if (lane == 0) wsf[40 + (it & 1)] = __all(Rrun < -SB_EXIT) ? 1.f : 0.f;
            __syncthreads();
            LAS float* wsa = (LAS float*)(lds + OFF_WS) + 40 + (it & 1);
            const float allf = wsa[0] * wsa[64] * wsa[128] * wsa[192] * wsa[256] * wsa[320] * wsa[384] * wsa[448];
            if (allf != 0.f) break;
        } else {
            __syncthreads();
        }
    }
    if constexpr (MODE == 1) { if (hi == 0) wsf[r32] = l_reg; LDS_WAIT(); }
    GAS bf16_t* Ow = (GAS bf16_t*)(Op + (size_t)(q0 + wid * 32) * opitch); asm volatile("" : "+s"(Ow));
#pragma unroll
    for (int r = 0; r < 16; ++r) { const int orow = crow(r, hi); float inv = 1.f; if constexpr (MODE == 1) inv = __builtin_amdgcn_rcpf(wsf[orow]);
#pragma unroll
        for (int d0 = 0; d0 < 4; ++d0) { const float v = o[d0][r] * inv; const float vn = __shfl_xor(v, 1);
            if ((r32 & 1) == 0) *(GAS unsigned*)(Ow + (size_t)orow * opitch + d0 * 32 + r32) = pk2(v, vn); } }
    __syncthreads();
#undef TILE_OF
#undef STAGE
}
}

#define XB_TMO      128
#define XB_XCNT(j)  (256  + 64 * (j))
#define XB_XSUB(j)  (1280 + 64 * (j))
#define XB_XGEN(j)  (2304 + 64 * (j))
#define XB_TOP      3328
#define XB_TOPGEN   3392
#define XCD_BAR_WORDS 3456
#define XB_SPIN_CAP (1u << 22)
__device__ __forceinline__ unsigned xb_ld(unsigned* p)              { return __hip_atomic_load(p, __ATOMIC_RELAXED, __HIP_MEMORY_SCOPE_AGENT); }
__device__ __forceinline__ unsigned xb_add(unsigned* p, unsigned v) { return __hip_atomic_fetch_add(p, v, __ATOMIC_RELAXED, __HIP_MEMORY_SCOPE_AGENT); }
__device__ __forceinline__ unsigned xb_xcc_id() { return (unsigned)__builtin_amdgcn_s_getreg((3 << 11) | 20) & 0xFu; }
#define XB_SPIN(cond, bar) do { unsigned _sp = 0; while (cond) { __builtin_amdgcn_s_sleep(1); \
    if ((++_sp & 255u) == 0u) { if (xb_ld(&(bar)[XB_TMO])) break; if (_sp > XB_SPIN_CAP) { atomicAdd(&(bar)[XB_TMO], 1u); break; } } } } while (0)
struct XcdBarrier { unsigned* bar; unsigned x; volatile LAS unsigned* st; };
__device__ __forceinline__ XcdBarrier xcd_barrier_post(unsigned* bar, volatile LAS unsigned* st) {
    XcdBarrier b; b.bar = bar; b.x = xb_xcc_id(); b.st = st;
    if (threadIdx.x == 0) (void)xb_add(&bar[XB_XCNT(b.x)], 1u);
    return b;
}
__device__ __forceinline__ void xcd_barrier_complete(unsigned* bar, unsigned x, unsigned& nloc, unsigned& nx) {
    const unsigned G = gridDim.x * gridDim.y * gridDim.z;
    unsigned sum, cnt, mine, sp = 0u;
    for (;;) {
        sum = 0u; cnt = 0u; mine = 0u;
#pragma unroll
        for (unsigned j = 0; j < 16; ++j) { const unsigned c = xb_ld(&bar[XB_XCNT(j)]); sum += c; cnt += (c > 0u) ? 1u : 0u; mine = (j == x) ? c : mine; }
        if (sum == G) break;
        __builtin_amdgcn_s_sleep(1);
        if ((++sp & 255u) == 0u) { if (xb_ld(&bar[XB_TMO])) break; if (sp > XB_SPIN_CAP) { atomicAdd(&bar[XB_TMO], 1u); break; } }
    }
    nloc = mine > 0u ? mine : 1u; nx = cnt > 0u ? cnt : 1u;
}
__device__ __forceinline__ void xcd_barrier(const XcdBarrier& b, const int wave) {
    asm volatile("s_waitcnt vmcnt(0)" ::: "memory");
    __syncthreads();
    if (wave == 0 && lane_id_v() == 0) {
        unsigned* bar = b.bar;
        __builtin_amdgcn_s_waitcnt(0);
        unsigned nloc = b.st[0], nx = b.st[1];
        if (nloc == 0u) { xcd_barrier_complete(bar, b.x, nloc, nx); b.st[0] = nloc; b.st[1] = nx; }
        const unsigned old = xb_add(&bar[XB_XSUB(b.x)], 1u);
        const unsigned gen = old / nloc;
        if (old + 1u == (gen + 1u) * nloc) {
            __builtin_amdgcn_fence(__ATOMIC_RELEASE, "agent");
            asm volatile("s_waitcnt vmcnt(0)" ::: "memory");
            const unsigned og = xb_add(&bar[XB_TOP], 1u);
            const unsigned tg = og / nx;
            if (og + 1u == (tg + 1u) * nx) xb_add(&bar[XB_TOPGEN], 1u);
            else XB_SPIN(xb_ld(&bar[XB_TOPGEN]) == tg, bar);
            __builtin_amdgcn_fence(__ATOMIC_ACQUIRE, "agent");
            xb_add(&bar[XB_XGEN(b.x)], 1u);
            asm volatile("s_waitcnt vmcnt(0)" ::: "memory");
        } else {
            XB_SPIN(xb_ld(&bar[XB_XGEN(b.x)]) == gen, bar);
            __builtin_amdgcn_fence(__ATOMIC_ACQUIRE, "agent");
            asm volatile("s_waitcnt vmcnt(0)" ::: "memory");
        }
    }
    __syncthreads();
}

constexpr int RING_BYTES = 131072, MISC_OFF = RING_BYTES + 320, LDS_BYTES = 147456;
static_assert(att::LDS_BYTES <= RING_BYTES, "attention LDS");

struct Args { const void* in[21]; float* out; unsigned char* ws; int ph_lo, ph_hi; };
enum { IN_X = 0, IN_POS, IN_SBG, IN_WQKV, IN_WO, IN_KVG, IN_WDKV, IN_KVLG, IN_WUKV, IN_MLAG, IN_WDQ, IN_QLG, IN_WUQ, IN_WMO, IN_PG, IN_PWQ, IN_PK1, IN_PK2, IN_PU, IN_PV, IN_FG };

__device__ __forceinline__ void transpose_item(const float* W, int ldw, int K, int nblk, const float* gain, bf16_t* WT, int row_off, LAS float* scr, int item, int lane) {
    const int kb = item / nblk, nb = item % nblk, k0 = 64 * kb, n0 = 32 * nb;
#pragma unroll 8
    for (int i = 0; i < 32; ++i) { const int kk = 2 * i + (lane >> 5); const float gv = gain ? gain[k0 + kk] : 1.f; scr[kk * 33 + (lane & 31)] = W[(size_t)(k0 + kk) * ldw + n0 + (lane & 31)] * gv; }
    LDS_WAIT(); asm volatile("" ::: "memory");
    const int c = lane & 7;
#pragma unroll
    for (int j = 0; j < 4; ++j) { const int n = (lane >> 3) + 8 * j; const LAS float* s = scr + (8 * c) * 33 + n;
        u32x4 o; o.x = pk2(s[0 * 33], s[1 * 33]); o.y = pk2(s[2 * 33], s[3 * 33]); o.z = pk2(s[4 * 33], s[5 * 33]); o.w = pk2(s[6 * 33], s[7 * 33]);
        *(u32x4*)(WT + (size_t)(row_off + n0 + n) * K + k0 + 8 * c) = o; }
    LDS_WAIT(); asm volatile("" ::: "memory");
}
__device__ __forceinline__ void convert_tables(const float* u, const float* v, const float* g, bf16_t* TU, bf16_t* TV, int gtid, int gthreads) {
    const size_t n8 = (size_t)NEXP * DM / 8;
    for (size_t i = gtid; i < n8; i += gthreads) { const int d = (int)((i * 8) % DM); const size_t e = (i * 8) / DM;
        const size_t dst = ((size_t)(d >> 6) * NEXP + e) * 64 + (d & 63);
        const f32x4 a0 = *(const f32x4*)(u + i * 8), a1 = *(const f32x4*)(u + i * 8 + 4), g0 = *(const f32x4*)(g + d), g1 = *(const f32x4*)(g + d + 4);
        u32x4 w; w.x = pk2(a0[0] * g0[0], a0[1] * g0[1]); w.y = pk2(a0[2] * g0[2], a0[3] * g0[3]); w.z = pk2(a1[0] * g1[0], a1[1] * g1[1]); w.w = pk2(a1[2] * g1[2], a1[3] * g1[3]);
        *(u32x4*)(TU + dst) = w;
        const f32x4 b0 = *(const f32x4*)(v + i * 8), b1 = *(const f32x4*)(v + i * 8 + 4);
        u32x4 x; x.x = pk2(b0[0], b0[1]); x.y = pk2(b0[2], b0[3]); x.z = pk2(b1[0], b1[1]); x.w = pk2(b1[2], b1[3]);
        *(u32x4*)(TV + dst) = x; }
}
__device__ __forceinline__ void row_to_bf16_rstd(const float* xrow, bf16_t* orow, float* rstd_out, int lane) {
    f32x4 v[8]; float s = 0.f;
#pragma unroll
    for (int j = 0; j < 8; ++j) { v[j] = *(const f32x4*)(xrow + j * 256 + lane * 4); s += v[j][0] * v[j][0] + v[j][1] * v[j][1] + v[j][2] * v[j][2] + v[j][3] * v[j][3]; }
    s = wave_sum(s);
#pragma unroll
    for (int j = 0; j < 8; ++j) { u32x2 w; w.x = pk2(v[j][0], v[j][1]); w.y = pk2(v[j][2], v[j][3]); *(u32x2*)(orow + j * 256 + lane * 4) = w; }
    if (lane == 0) *rstd_out = 1.f / sqrtf(s * (1.f / DM) + EPS);
}

template <int layer>
__device__ __forceinline__ void peer_gather(LAS unsigned char* lds, unsigned char* ws, float* X, bf16_t* XB, float* rstd, const float* fg, const int wave, const int lane, const int bx) {
    constexpr int GOFF = 0, GPW = 65536, GSS = 131072 + 1024;
    const bf16_t* TU = (const bf16_t*)(ws + WS_TU); const bf16_t* TV = (const bf16_t*)(ws + WS_TV);
    const int* IDS = (const int*)(ws + WS_IDS); const float* GT = (const float*)(ws + WS_GATE);
    const int g = lane >> 3, sub = lane & 7;
    const int tw0 = wave * 16;
    const int t0 = bx * 128;
    for (int tt = 0; tt < 16; ++tt) { const int tl = tw0 + tt; const size_t t = (size_t)(t0 + tl);
#pragma unroll
        for (int k = 0; k < 2; ++k) { const int s_ = lane + 64 * k; const int id = IDS[t * NSEL + s_];
            const int pos = tl * 128 + (s_ & 7) * 16 + (s_ >> 3);
            *(LAS unsigned*)(lds + GOFF + pos * 4) = (unsigned)id * 128u; *(LAS float*)(lds + GPW + pos * 4) = 0.f; }
        if (lane < 8) *(LAS float*)(lds + GSS + (tl * 8 + lane) * 4) = 0.f; }
    LDS_WAIT();
#pragma unroll 1
    for (int kc = 0; kc < 32; ++kc) {
        const char* slab = (const char*)TU + (size_t)kc * ((size_t)NEXP * 128) + sub * 16;
#pragma unroll 1
        for (int tt = 0; tt < 16; ++tt) { const int tl = tw0 + tt;
            const u32x4 h4 = *(const u32x4*)(XB + (size_t)(t0 + tl) * DM + kc * 64 + sub * 8);
            u32x4 of[4];
#pragma unroll
            for (int q = 0; q < 4; ++q) of[q] = *(LAS u32x4*)(lds + GOFF + (tl * 128 + g * 16 + q * 4) * 4);
            u32x4 uv[16];
#pragma unroll
            for (int i = 0; i < 16; ++i) uv[i] = *(const u32x4*)(slab + of[i >> 2][i & 3]);
            float d[16];
#pragma unroll
            for (int i = 0; i < 16; ++i) { float a = 0.f;
                a = dot2bf(uv[i].x, h4.x, a); a = dot2bf(uv[i].y, h4.y, a); a = dot2bf(uv[i].z, h4.z, a); a = dot2bf(uv[i].w, h4.w, a);
                a += __shfl_xor(a, 1); a += __shfl_xor(a, 2); a += __shfl_xor(a, 4); d[i] = a; }
            if (sub == 0) {
#pragma unroll
                for (int q = 0; q < 4; ++q) { LAS f32x4* p = (LAS f32x4*)(lds + GPW + (tl * 128 + g * 16 + q * 4) * 4); f32x4 v = *p;
                    v[0] += d[q * 4 + 0]; v[1] += d[q * 4 + 1]; v[2] += d[q * 4 + 2]; v[3] += d[q * 4 + 3]; *p = v; } }
        }
    }
    LDS_WAIT();
    for (int tt = 0; tt < 16; ++tt) { const int tl = tw0 + tt; const size_t t = (size_t)(t0 + tl); const float rs = rstd[t];
#pragma unroll
        for (int k = 0; k < 2; ++k) { const int s_ = lane + 64 * k; const int pos = tl * 128 + (s_ & 7) * 16 + (s_ >> 3);
            LAS float* p = (LAS float*)(lds + GPW + pos * 4); const float dd = *p * rs;
            *p = GT[t * NSEL + s_] * 0.5f * dd * (1.f + erff(dd * 0.7071067811865476f)); } }
    LDS_WAIT();
#pragma unroll 1
    for (int dc = 0; dc < 32; ++dc) {
        const char* slab = (const char*)TV + (size_t)dc * ((size_t)NEXP * 128) + sub * 16;
#pragma unroll 1
        for (int tt = 0; tt < 16; ++tt) { const int tl = tw0 + tt; const size_t t = (size_t)(t0 + tl);
            u32x4 of[4]; f32x4 wq[4];
#pragma unroll
            for (int q = 0; q < 4; ++q) { of[q] = *(LAS u32x4*)(lds + GOFF + (tl * 128 + g * 16 + q * 4) * 4); wq[q] = *(LAS f32x4*)(lds + GPW + (tl * 128 + g * 16 + q * 4) * 4); }
            u32x4 vv[16];
#pragma unroll
            for (int i = 0; i < 16; ++i) vv[i] = *(const u32x4*)(slab + of[i >> 2][i & 3]);
            float acc[8];
#pragma unroll
            for (int c = 0; c < 8; ++c) acc[c] = 0.f;
#pragma unroll
            for (int i = 0; i < 16; i += 2) { const unsigned wp = cvtpk(wq[i >> 2][i & 3], wq[(i + 1) >> 2][(i + 1) & 3]);
#pragma unroll
                for (int c = 0; c < 4; ++c) { const unsigned lo = __builtin_amdgcn_perm(vv[i + 1][c], vv[i][c], 0x05040100u), hi_ = __builtin_amdgcn_perm(vv[i + 1][c], vv[i][c], 0x07060302u);
                    acc[2 * c] = dot2bf(lo, wp, acc[2 * c]); acc[2 * c + 1] = dot2bf(hi_, wp, acc[2 * c + 1]); } }
#pragma unroll
            for (int c = 0; c < 8; ++c) { float a = acc[c]; a += __shfl_xor(a, 8); a += __shfl_xor(a, 16); a += __shfl_xor(a, 32); acc[c] = a; }
            if (g == 0) { float* xr = X + t * DM + dc * 64 + sub * 8; f32x4 x0 = *(const f32x4*)xr, x1 = *(const f32x4*)(xr + 4);
                x0[0] += acc[0]; x0[1] += acc[1]; x0[2] += acc[2]; x0[3] += acc[3]; x1[0] += acc[4]; x1[1] += acc[5]; x1[2] += acc[6]; x1[3] += acc[7];
                *(f32x4*)xr = x0; *(f32x4*)(xr + 4) = x1;
                if (layer == 0) { u32x4 w; w.x = pk2(x0[0], x0[1]); w.y = pk2(x0[2], x0[3]); w.z = pk2(x1[0], x1[1]); w.w = pk2(x1[2], x1[3]); *(u32x4*)(XB + t * DM + dc * 64 + sub * 8) = w; }
                LAS float* sp = (LAS float*)(lds + GSS + (tl * 8 + sub) * 4);
                *sp += x0[0] * x0[0] + x0[1] * x0[1] + x0[2] * x0[2] + x0[3] * x0[3] + x1[0] * x1[0] + x1[1] * x1[1] + x1[2] * x1[2] + x1[3] * x1[3]; }
        }
    }
    LDS_WAIT(); VM_WAIT();
    for (int tt = 0; tt < 16; ++tt) { const int tl = tw0 + tt; const size_t t = (size_t)(t0 + tl);
        float ss = (lane < 8) ? *(LAS float*)(lds + GSS + (tl * 8 + lane) * 4) : 0.f; ss = wave_sum(ss);
        const float rn = 1.f / sqrtf(ss * (1.f / DM) + EPS);
        if (layer == 0) { if (lane == 0) rstd[t] = rn; }
        else {
#pragma unroll
            for (int j = 0; j < 8; ++j) { float* xr = X + t * DM + j * 256 + lane * 4; const f32x4 gq = *(const f32x4*)(fg + j * 256 + lane * 4);
                f32x4 xv = __builtin_nontemporal_load((const f32x4*)xr); xv[0] *= rn * gq[0]; xv[1] *= rn * gq[1]; xv[2] *= rn * gq[2]; xv[3] *= rn * gq[3]; *(f32x4*)xr = xv; } }
    }
}

template <int CTRL> __device__ __forceinline__ unsigned dpp_u32(unsigned x) { return (unsigned)__builtin_amdgcn_update_dpp(0, (int)x, CTRL, 0xF, 0xF, false); }
template <int CTRL> __device__ __forceinline__ float dpp_f32(float x) { return __int_as_float(__builtin_amdgcn_update_dpp(0, __float_as_int(x), CTRL, 0xF, 0xF, false)); }
__device__ __forceinline__ unsigned umax(unsigned a, unsigned b) { return a > b ? a : b; }
__device__ __forceinline__ unsigned umin(unsigned a, unsigned b) { return a < b ? a : b; }
__device__ __forceinline__ unsigned row_allmax(unsigned x) { x = umax(x, dpp_u32<0xB1>(x)); x = umax(x, dpp_u32<0x4E>(x)); x = umax(x, dpp_u32<0x124>(x)); x = umax(x, dpp_u32<0x128>(x)); return x; }
__device__ __forceinline__ float row_allsum(float x) { x += dpp_f32<0xB1>(x); x += dpp_f32<0x4E>(x); x += dpp_f32<0x124>(x); x += dpp_f32<0x128>(x); return x; }
__device__ __forceinline__ unsigned f2ord(float f) { unsigned u = __float_as_uint(f); return u ^ ((u >> 31) ? 0xffffffffu : 0x80000000u); }
__device__ __forceinline__ float ord2f(unsigned u) { return __uint_as_float(u ^ ((u >> 31) ? 0x80000000u : 0xffffffffu)); }
__device__ __forceinline__ void peer_topk(const float* SC, int* IDS, float* GT, const int lane, const int gw, const int NGW) {
    const int l16 = lane & 15, row = (lane >> 4) & 1, L = lane & 31, base32 = lane & 32;
    int ci[2], cj[2]; bool cv[2];
#pragma unroll
    for (int sl = 0; sl < 2; ++sl) { const int n = L + 32 * sl; int i_, j_; bool v = true;
        if (n < 16) { i_ = 0; j_ = n; } else if (n < 24) { i_ = 1; j_ = n - 16; } else if (n < 29) { i_ = 2; j_ = n - 24; } else if (n < 33) { i_ = 3; j_ = n - 29; }
        else if (n < 36) { i_ = 4; j_ = n - 33; } else if (n < 42) { i_ = 5 + ((n - 36) >> 1); j_ = (n - 36) & 1; } else if (n < 50) { i_ = 8 + (n - 42); j_ = 0; } else { i_ = 15; j_ = 15; v = false; }
        ci[sl] = i_; cj[sl] = j_; cv[sl] = v; }
    for (int pair = gw; pair < T * PH / 2; pair += NGW) {
        const int item = pair * 2 + (lane >> 5), t = item >> 3, hh = item & 7;
        const float* s = SC + (size_t)t * DM + hh * 256 + row * 128 + l16 * 8;
        const f32x4 a0 = *(const f32x4*)s, a1 = *(const f32x4*)(s + 4);
        unsigned k[8];
#pragma unroll
        for (int e = 0; e < 8; ++e) { const float v = e < 4 ? a0[e & 3] : a1[e & 3]; k[e] = (f2ord(v) & ~127u) | (unsigned)(127 - (l16 * 8 + e)); }
#define CE(a, b) do { const unsigned hi_ = umax(k[a], k[b]), lo_ = umin(k[a], k[b]); k[a] = hi_; k[b] = lo_; } while (0)
        CE(0, 1); CE(2, 3); CE(4, 5); CE(6, 7); CE(0, 2); CE(1, 3); CE(4, 6); CE(5, 7); CE(1, 2); CE(5, 6);
        CE(0, 4); CE(1, 5); CE(2, 6); CE(3, 7); CE(2, 4); CE(3, 5); CE(1, 2); CE(3, 4); CE(5, 6);
#undef CE
        unsigned mine = 0u;
#pragma unroll 4
        for (int it = 0; it < TOPK; ++it) { const unsigned m = row_allmax(k[0]); if (l16 == it) mine = m;
            if (k[0] == m) { k[0] = k[1]; k[1] = k[2]; k[2] = k[3]; k[3] = k[4]; k[4] = k[5]; k[5] = k[6]; k[6] = k[7]; k[7] = 0u; } }
        unsigned kc[2];
#pragma unroll
        for (int sl = 0; sl < 2; ++sl) { const unsigned k1 = (unsigned)__shfl((int)mine, base32 + ci[sl]), k2 = (unsigned)__shfl((int)mine, base32 + 16 + cj[sl]);
            const float sum = ord2f(k1 & ~127u) + ord2f(k2 & ~127u);
            kc[sl] = cv[sl] ? ((f2ord(sum) & ~255u) | (unsigned)(255 - (ci[sl] * 16 + cj[sl]))) : 0u; }
        unsigned mysel = 0u;
#pragma unroll 4
        for (int it = 0; it < TOPK; ++it) { unsigned m = row_allmax(umax(kc[0], kc[1]));
            { auto rr = __builtin_amdgcn_permlane16_swap(m, m, false, false); m = umax(rr[0], rr[1]); }
            if (L == it) mysel = m; if (kc[0] == m) kc[0] = 0u; if (kc[1] == m) kc[1] = 0u; }
        const int cidx = 255 - (int)(mysel & 255u), si = (cidx >> 4) & 15, sj = cidx & 15;
        const unsigned k1 = (unsigned)__shfl((int)mine, base32 + si), k2 = (unsigned)__shfl((int)mine, base32 + 16 + sj);
        const int i1 = 127 - (int)(k1 & 127u), i2 = 127 - (int)(k2 & 127u);
        const float* sb = SC + (size_t)t * DM + hh * 256;
        float sc = 0.f; if (L < TOPK) sc = sb[i1] + sb[128 + i2];
        const float smax = __shfl(sc, base32);
        const float e = (L < TOPK) ? __expf(sc - smax) : 0.f;
        const float den = row_allsum(e);
        if (L < TOPK) { IDS[(size_t)t * NSEL + hh * TOPK + L] = i1 * NKEYS + i2; GT[(size_t)t * NSEL + hh * TOPK + L] = e / den; }
    }
}

#ifndef PH_MASK
#define PH_MASK 0xFFFFFu
#endif
#define IN(k) (lo <= (k) && (k) < hi)
#define SITE(b) (((PH_MASK) >> (b)) & 1u)
#ifndef REP_MASK
#define REP_MASK 0u
#endif
#define REPS(b) for (int rep_ = 0; rep_ < ((((REP_MASK) >> (b)) & 1u) ? 3 : 1); ++rep_)
#define SEAM(k) do { if (IN(k) && IN((k) + 1)) xcd_barrier(bar, wave); } while (0)
#define PH_LOCALS const __attribute__((address_space(4))) Args* A_ = (const __attribute__((address_space(4))) Args*)__builtin_amdgcn_kernarg_segment_ptr(); asm volatile("" : "+s"(A_)); \
    unsigned char* ws = A_->ws; float* X = A_->out; float* rstd = (float*)(ws + WS_RSTD); float* cs = (float*)(ws + WS_CS); bf16_t* XB = (bf16_t*)(ws + WS_XB); const float* x_in = (const float*)A_->in[IN_X]; \
    const int lane = lane_id_v(), tid = wave * 64 + lane, gw = bx * NWAVES + wave, NGW = G * NWAVES, gtid = bx * NTHR + tid, gthreads = G * NTHR; \
    (void)X; (void)rstd; (void)cs; (void)XB; (void)x_in; (void)lane; (void)tid; (void)gw; (void)NGW; (void)gtid; (void)gthreads
#define AIN(k) (A_->in[k])

template <int layer>
__device__ __forceinline__ void peer_phases(LAS unsigned char* lds, const int lo, const int hi, const XcdBarrier& bar, const int wave, const int G, const int bx) {
    constexpr int pb = layer ? 15 : 4;
        if (SITE(4) && IN(pb)) REPS(4) { PH_LOCALS; const float* pg = (const float*)AIN(IN_PG) + (size_t)layer * DM;
            for (int m = gw; m < T; m += NGW) row_to_bf16_rstd(X + (size_t)m * DM, XB + (size_t)m * DM, rstd + m, lane);
            if (layer == 1) convert_tables((const float*)AIN(IN_PU) + (size_t)NEXP * DM, (const float*)AIN(IN_PV) + (size_t)NEXP * DM, pg, (bf16_t*)(ws + WS_TU), (bf16_t*)(ws + WS_TV), gtid, gthreads);
        }
        SEAM(pb);
        if (SITE(5) && IN(pb + 1)) REPS(5) { PH_LOCALS;
            pg8::Gemm g{XB, (const bf16_t*)(ws + WS_WPQ) + (size_t)layer * DM * DM, T, DM, DM, DM, 0}; pg8::StaticOrder S; S.init(T, DM, G, bx);
            pg8::EpiB16 E{(bf16_t*)(ws + WS_QP), DM, rstd};
            pg8::gemm_phase<pg8::EpiB16>(lds, g, S, E, wave, lane);
        }
        SEAM(pb + 1);
        if (SITE(6) && IN(pb + 2)) REPS(6) { PH_LOCALS;
            pg8::Gemm g{(const bf16_t*)(ws + WS_QP), (const bf16_t*)(ws + WS_KBD) + (size_t)layer * 2048 * 256, T, DM, 256, DM, 256}; pg8::StaticOrder S; S.init(T, DM, G, bx);
            pg8::EpiF32 E{(float*)(ws + WS_SC), DM, nullptr};
            pg8::gemm_phase<pg8::EpiF32>(lds, g, S, E, wave, lane);
        }
        SEAM(pb + 2);
        if (SITE(7) && IN(pb + 3)) REPS(7) { PH_LOCALS;
            peer_topk((const float*)(ws + WS_SC), (int*)(ws + WS_IDS), (float*)(ws + WS_GATE), lane, gw, NGW);
        }
        SEAM(pb + 3);
        if (SITE(8) && IN(pb + 4)) REPS(8) { PH_LOCALS;
            if (bx < 256) peer_gather<layer>(lds, ws, X, XB, rstd, (const float*)AIN(IN_FG), wave, lane, bx);
        }
}

__global__ void __launch_bounds__(NTHR, 2) fwd(Args args) {
    extern __shared__ __attribute__((aligned(16))) unsigned char lds_raw[];
    LAS unsigned char* lds = (LAS unsigned char*)lds_raw;
    volatile LAS unsigned* MISC = (volatile LAS unsigned*)(lds + MISC_OFF);
    const int wave = __builtin_amdgcn_readfirstlane(threadIdx.x >> 6);
    const int G = gridDim.x, bx = blockIdx.x;
    unsigned* ctl = (unsigned*)(args.ws + WS_CTL);
    for (int u = threadIdx.x; u < (LDS_BYTES - RING_BYTES) / 4; u += NTHR) ((LAS unsigned*)(lds + RING_BYTES))[u] = 0u;
    __syncthreads();
    XcdBarrier bar; bar.bar = ctl + CW_BAR; bar.x = 0; bar.st = nullptr;
    const int lo = args.ph_lo, hi = args.ph_hi;
    const bool multi = (hi - lo) > 1;
    if (multi) bar = xcd_barrier_post(ctl + CW_BAR, MISC + 8);

    if (SITE(0) && IN(0)) REPS(0) { PH_LOCALS;
        LAS float* scr = (LAS float*)(lds + wave * 16384);
        const float* sbg = (const float*)AIN(IN_SBG); const float* kvg = (const float*)AIN(IN_KVG); const float* mlag = (const float*)AIN(IN_MLAG);
        const float* kvlg = (const float*)AIN(IN_KVLG); const float* qlg = (const float*)AIN(IN_QLG); const float* pg = (const float*)AIN(IN_PG);
        constexpr int I_QKV = 32 * 192, I_WO = 32 * 64, I_DKV = 32 * 18, I_DQ = 32 * 16, I_UKV = 8 * 128, I_UQ = 8 * 96, I_MO = 32 * 64, I_PQ = 32 * 64;
        constexpr int NITEMS = I_QKV + I_WO + I_DKV + I_DQ + I_UKV + I_UQ + I_MO + 2 * I_PQ;
        for (int it = gw; it < NITEMS; it += NGW) {
            int r = it;
            if (r < I_QKV) { transpose_item((const float*)AIN(IN_WQKV), 6144, 2048, 192, sbg, (bf16_t*)(ws + WS_WQKV), 0, scr, r, lane); continue; } r -= I_QKV;
            if (r < I_WO) { transpose_item((const float*)AIN(IN_WO), 2048, 2048, 64, nullptr, (bf16_t*)(ws + WS_WO), 0, scr, r, lane); continue; } r -= I_WO;
            if (r < I_DKV) { transpose_item((const float*)AIN(IN_WDKV), 576, 2048, 18, kvg, (bf16_t*)(ws + WS_WDKQ), 0, scr, r, lane); continue; } r -= I_DKV;
            if (r < I_DQ) { transpose_item((const float*)AIN(IN_WDQ), 512, 2048, 16, mlag, (bf16_t*)(ws + WS_WDKQ), 576, scr, r, lane); continue; } r -= I_DQ;
            if (r < I_UKV) { transpose_item((const float*)AIN(IN_WUKV), 4096, 512, 128, kvlg, (bf16_t*)(ws + WS_WUKV), 0, scr, r, lane); continue; } r -= I_UKV;
            if (r < I_UQ) { transpose_item((const float*)AIN(IN_WUQ), 3072, 512, 96, qlg, (bf16_t*)(ws + WS_WUQ), 0, scr, r, lane); continue; } r -= I_UQ;
            if (r < I_MO) { transpose_item((const float*)AIN(IN_WMO), 2048, 2048, 64, nullptr, (bf16_t*)(ws + WS_WMO), 0, scr, r, lane); continue; } r -= I_MO;
            if (r < I_PQ) { transpose_item((const float*)AIN(IN_PWQ), 2048, 2048, 64, pg, (bf16_t*)(ws + WS_WPQ), 0, scr, r, lane); continue; } r -= I_PQ;
            transpose_item((const float*)AIN(IN_PWQ) + (size_t)DM * DM, 2048, 2048, 64, pg + DM, (bf16_t*)(ws + WS_WPQ) + (size_t)DM * DM, 0, scr, r, lane);
        }
        { u32x4 z = {0u, 0u, 0u, 0u}; bf16_t* p = (bf16_t*)(ws + WS_WDKQ) + (size_t)1088 * DM; for (int i = gtid; i < 192 * DM / 8; i += gthreads) *(u32x4*)(p + (size_t)i * 8) = z; }
        { const float* k1 = (const float*)AIN(IN_PK1); const float* k2 = (const float*)AIN(IN_PK2); bf16_t* kbd = (bf16_t*)(ws + WS_KBD);
          for (int i = gtid; i < 2 * 2048 * 256; i += gthreads) { const int kk = i & 255, n = (i >> 8) & 255, hh = (i >> 16) & 7, l = i >> 19; float v = 0.f;
              if (n < 128) { if (kk < 128) v = k1[(((size_t)l * PH + hh) * NKEYS + n) * 128 + kk]; } else { if (kk >= 128) v = k2[(((size_t)l * PH + hh) * NKEYS + (n - 128)) * 128 + (kk - 128)]; }
              kbd[i] = (bf16_t)f2bf(v); } }
        convert_tables((const float*)AIN(IN_PU), (const float*)AIN(IN_PV), pg, (bf16_t*)(ws + WS_TU), (bf16_t*)(ws + WS_TV), gtid, gthreads);
        for (int m = gw; m < T; m += NGW) row_to_bf16_rstd(x_in + (size_t)m * DM, XB + (size_t)m * DM, rstd + m, lane);
        { const int* pos = (const int*)AIN(IN_POS);
          for (int i = gtid; i < T * 32; i += gthreads) { const int t = i >> 5, j = i & 31; const float inv = powf(10000.f, -(float)(2 * j) / 64.f); const float ang = (float)pos[t] * inv;
              cs[2 * i] = cosf(ang); cs[2 * i + 1] = sinf(ang); } }
    }
    SEAM(0);

    {
        {
            if (SITE(1) && IN(1)) REPS(1) { PH_LOCALS;
                pg8::Gemm g{XB, (const bf16_t*)(ws + WS_WQKV), T, 3 * DM, DM, DM, 0}; pg8::StaticOrder S; S.init(T, 3 * DM, G, bx);
                pg8::EpiQKV E{(bf16_t*)(ws + WS_Q), (size_t)(WS_K - WS_Q) / 2, rstd, 0.08838834764831845f * LOG2E};
                pg8::gemm_phase<pg8::EpiQKV>(lds, g, S, E, wave, lane);
            }
            SEAM(1);
            if (SITE(2) && IN(2)) REPS(2) { PH_LOCALS;
                const int bh = bx >> 1, half = bx & 1, b = bh >> 4, h = bh & 15;
                if (bx < 256) {
                    const bf16_t* Qp = (const bf16_t*)(ws + WS_Q) + (size_t)b * SEQ * DM + h * HD; const bf16_t* Kp = (const bf16_t*)(ws + WS_K) + (size_t)b * SEQ * DM + h * HD;
                    const bf16_t* Vp = (const bf16_t*)(ws + WS_V) + (size_t)b * SEQ * DM + h * HD; bf16_t* Op = XB + (size_t)b * SEQ * DM + h * HD;
                    for (int i = 0; i < 8; ++i) { const int qb = 15 - (2 * i + ((i & 1) ^ half));
                        att::attn_unit<0>(lds, Qp, DM, Kp, Vp, DM, nullptr, nullptr, Op, DM, qb * 256, wave, lane); }
                }
            }
            SEAM(2);
            if (SITE(3) && IN(3)) REPS(3) { PH_LOCALS;
                pg8::Gemm g{XB, (const bf16_t*)(ws + WS_WO), T, DM, DM, DM, 0}; pg8::StaticOrder S; S.init(T, DM, G, bx);
                pg8::EpiRes E{X, x_in, DM};
                pg8::gemm_phase<pg8::EpiRes>(lds, g, S, E, wave, lane);
            }
            SEAM(3);
        }
        peer_phases<0>(lds, lo, hi, bar, wave, G, bx);
        SEAM(8);
        {
            if (SITE(9) && IN(9)) REPS(9) { PH_LOCALS;
                pg8::Gemm g{XB, (const bf16_t*)(ws + WS_WDKQ), T, NDKQ, DM, DM, 0}; pg8::StaticOrder S; S.init(T, NDKQ, G, bx);
                pg8::EpiF32 E{(float*)(ws + WS_DKQ), NDKQ, rstd};
                pg8::gemm_phase<pg8::EpiF32>(lds, g, S, E, wave, lane);
            }
            SEAM(9);
            if (SITE(10) && IN(10)) REPS(10) { PH_LOCALS;
                const float* dkq = (const float*)(ws + WS_DKQ); bf16_t* CB = (bf16_t*)(ws + WS_CB); bf16_t* CQB = (bf16_t*)(ws + WS_CQB); bf16_t* KR = (bf16_t*)(ws + WS_KR);
                for (int m = gw; m < T; m += NGW) { const float* r = dkq + (size_t)m * NDKQ;
                    const f32x4 a0 = *(const f32x4*)(r + lane * 8), a1 = *(const f32x4*)(r + lane * 8 + 4);
                    const f32x4 q0 = *(const f32x4*)(r + 576 + lane * 8), q1 = *(const f32x4*)(r + 576 + lane * 8 + 4);
                    float sa = a0[0] * a0[0] + a0[1] * a0[1] + a0[2] * a0[2] + a0[3] * a0[3] + a1[0] * a1[0] + a1[1] * a1[1] + a1[2] * a1[2] + a1[3] * a1[3];
                    float sq = q0[0] * q0[0] + q0[1] * q0[1] + q0[2] * q0[2] + q0[3] * q0[3] + q1[0] * q1[0] + q1[1] * q1[1] + q1[2] * q1[2] + q1[3] * q1[3];
                    sa = wave_sum(sa); sq = wave_sum(sq);
                    const float ra = 1.f / sqrtf(sa * (1.f / KVL) + EPS), rq = 1.f / sqrtf(sq * (1.f / QL) + EPS);
                    u32x4 w; w.x = pk2(a0[0] * ra, a0[1] * ra); w.y = pk2(a0[2] * ra, a0[3] * ra); w.z = pk2(a1[0] * ra, a1[1] * ra); w.w = pk2(a1[2] * ra, a1[3] * ra);
                    *(u32x4*)(CB + (size_t)m * KVL + lane * 8) = w;
                    u32x4 y; y.x = pk2(q0[0] * rq, q0[1] * rq); y.y = pk2(q0[2] * rq, q0[3] * rq); y.z = pk2(q1[0] * rq, q1[1] * rq); y.w = pk2(q1[2] * rq, q1[3] * rq);
                    *(u32x4*)(CQB + (size_t)m * QL + lane * 8) = y;
                    if (lane < 32) { const float x1 = r[512 + lane], x2 = r[512 + 32 + lane], co = cs[((size_t)m * 32 + lane) * 2], si = cs[((size_t)m * 32 + lane) * 2 + 1];
                        KR[(size_t)m * 64 + lane] = (bf16_t)f2bf(x1 * co - x2 * si); KR[(size_t)m * 64 + 32 + lane] = (bf16_t)f2bf(x2 * co + x1 * si); } }
            }
            SEAM(10);
            if (SITE(11) && IN(11)) REPS(11) { PH_LOCALS;
                pg8::Gemm g{(const bf16_t*)(ws + WS_CB), (const bf16_t*)(ws + WS_WUKV), T, 4096, KVL, KVL, 0}; pg8::StaticOrder S; S.init(T, 4096, G, bx);
                pg8::EpiUKV E{(bf16_t*)(ws + WS_KN), (bf16_t*)(ws + WS_VM), nullptr};
                pg8::gemm_phase<pg8::EpiUKV>(lds, g, S, E, wave, lane);
            }
            SEAM(11);
            if (SITE(12) && IN(12)) REPS(12) { PH_LOCALS;
                pg8::Gemm g{(const bf16_t*)(ws + WS_CQB), (const bf16_t*)(ws + WS_WUQ), T, 3072, QL, QL, 0}; pg8::StaticOrder S; S.init(T, 3072, G, bx);
                pg8::EpiB16 E{(bf16_t*)(ws + WS_QM), 3072, nullptr};
                pg8::gemm_phase<pg8::EpiB16>(lds, g, S, E, wave, lane);
            }
            SEAM(12);
            if (SITE(13) && IN(13)) REPS(13) { PH_LOCALS;
                const int bh = bx >> 1, half = bx & 1, b = bh >> 4, h = bh & 15;
                if (bx < 256) {
                    const bf16_t* Qp = (const bf16_t*)(ws + WS_QM) + (size_t)b * SEQ * 3072 + h * 192; const bf16_t* Kp = (const bf16_t*)(ws + WS_KN) + (size_t)b * SEQ * DM + h * HD;
                    const bf16_t* Vp = (const bf16_t*)(ws + WS_VM) + (size_t)b * SEQ * DM + h * HD; const bf16_t* Rp = (const bf16_t*)(ws + WS_KR) + (size_t)b * SEQ * 64;
                    bf16_t* Op = XB + (size_t)b * SEQ * DM + h * HD;
                    for (int i = 0; i < 8; ++i) { const int qb = 15 - (2 * i + ((i & 1) ^ half));
                        att::attn_unit<1>(lds, Qp, 3072, Kp, Vp, DM, Rp, cs + (size_t)b * SEQ * 64, Op, DM, qb * 256, wave, lane); }
                }
            }
            SEAM(13);
            if (SITE(14) && IN(14)) REPS(14) { PH_LOCALS;
                pg8::Gemm g{XB, (const bf16_t*)(ws + WS_WMO), T, DM, DM, DM, 0}; pg8::StaticOrder S; S.init(T, DM, G, bx);
                pg8::EpiRes E{X, X, DM};
                pg8::gemm_phase<pg8::EpiRes>(lds, g, S, E, wave, lane);
            }
            SEAM(14);
        }
        peer_phases<1>(lds, lo, hi, bar, wave, G, bx);
    }
#undef IN
#undef SEAM
}

extern "C" void kernel_launch(void* const* d_in, const int* in_sizes, int n_in, void* d_out, int out_size, void* d_ws, size_t ws_size, hipStream_t stream) {
    static int grid = 0;
    if (grid == 0) {
        if (n_in != 21 || out_size != T * DM || ws_size < WS_END) { fprintf(stderr, "kernel_launch: unexpected shapes (n_in %d out %d ws %zu need %zu)\n", n_in, out_size, ws_size, (size_t)WS_END); grid = -1; return; }
        int dev = 0, cus = 0, per_cu = 0;
        if (hipGetDevice(&dev) != hipSuccess || hipDeviceGetAttribute(&cus, hipDeviceAttributeMultiprocessorCount, dev) != hipSuccess) { grid = -1; return; }
        if (hipFuncSetAttribute((const void*)fwd, hipFuncAttributeMaxDynamicSharedMemorySize, LDS_BYTES) != hipSuccess) { fprintf(stderr, "kernel_launch: hipFuncSetAttribute failed\n"); grid = -1; return; }
        if (hipOccupancyMaxActiveBlocksPerMultiprocessor(&per_cu, (const void*)fwd, NTHR, LDS_BYTES) != hipSuccess || per_cu < 1) fprintf(stderr, "kernel_launch: occupancy query reports %d\n", per_cu);
        (void)hipGetLastError();
        grid = cus < 256 ? cus : 256;
    }
    if (grid < 0) return;
    (void)hipMemsetAsync((char*)d_ws + WS_CTL, 0, CTL_ZERO_BYTES, stream);
    Args a{};
    for (int i = 0; i < 21; ++i) a.in[i] = d_in[i];
    a.out = (float*)d_out; a.ws = (unsigned char*)d_ws;
#if MK_ONE_LAUNCH
    a.ph_lo = 0; a.ph_hi = 20;
    hipLaunchKernelGGL(fwd, dim3(grid), dim3(NTHR), LDS_BYTES, stream, a);
#else
    for (int ph = 0; ph < 20; ++ph) { a.ph_lo = ph; a.ph_hi = ph + 1; hipLaunchKernelGGL(fwd, dim3(grid), dim3(NTHR), LDS_BYTES, stream, a); }
#endif
}
```

```cpp
#include <hip/hip_runtime.h>
#include <cstdio>
#include <cstdint>

#define PROBE_LO -1
#define PROBE_SUB 0
#define PROBE_WG 0
#define PROBE_ARG 0
#define PROBE_HI -1
#ifndef MK_ONE_LAUNCH
#define MK_ONE_LAUNCH 1
#endif

#define LAS __attribute__((address_space(3)))
#define GAS __attribute__((address_space(1)))
typedef unsigned short bf16_t;
typedef short bf16x8 __attribute__((ext_vector_type(8)));
typedef short s16x4 __attribute__((ext_vector_type(4)));
typedef float f32x2 __attribute__((ext_vector_type(2)));
typedef float f32x4 __attribute__((ext_vector_type(4)));
typedef float f32x16 __attribute__((ext_vector_type(16)));
typedef unsigned u32x2 __attribute__((ext_vector_type(2)));
typedef int i32x2v __attribute__((ext_vector_type(2)));
typedef unsigned u32x4 __attribute__((ext_vector_type(4)));
typedef __bf16 bf16v2 __attribute__((ext_vector_type(2)));
typedef _Float16 h16x2 __attribute__((ext_vector_type(2)));
__device__ __forceinline__ float dot2bf(unsigned a, unsigned b, float c) { return __builtin_amdgcn_fdot2_f32_bf16(__builtin_bit_cast(bf16v2, a), __builtin_bit_cast(bf16v2, b), c, false); }

constexpr int NB = 8, SEQ = 4096, DM = 2048, T = NB * SEQ, NH = 16, HD = 128;
constexpr int KVL = 512, QKR = 64, QL = 512, NEXP = 16384, PH = 8, NKEYS = 128, TOPK = 16, NSEL = PH * TOPK;
constexpr int NDKQ = 1280;
constexpr float EPS = 1e-6f;
constexpr float LOG2E = 1.4426950408889634f;
constexpr int NWAVES = 8, NTHR = 512;

constexpr size_t MiB = 1u << 20;
constexpr size_t WS_CTL = 0, CTL_ZERO_BYTES = 1 * MiB;
constexpr size_t WS_RSTD = 1 * MiB;
constexpr size_t WS_XSUM = 1 * MiB + 512 * 1024;
constexpr size_t WS_CS = 2 * MiB;
constexpr size_t WS_WQKV = 16 * MiB;
constexpr size_t WS_WO = 40 * MiB;
constexpr size_t WS_WDKQ = 48 * MiB;
constexpr size_t WS_WUKV = 54 * MiB;
constexpr size_t WS_WUQ = 58 * MiB;
constexpr size_t WS_WMO = 62 * MiB;
constexpr size_t WS_WPQ = 70 * MiB;
constexpr size_t WS_KBD = 86 * MiB;
constexpr size_t WS_TU8 = 96 * MiB;
constexpr size_t WS_TV8 = 128 * MiB;
constexpr float SU8 = 512.f, SV4 = 4.f, SX8 = 8.f, SU4 = 136.f, UOFF = 7.5f, SVQ = 8.5f, SW8 = 64.f;
constexpr size_t WS_CB = 96 * MiB;
constexpr size_t WS_CQB = 128 * MiB;
constexpr size_t WS_XB = 224 * MiB;
constexpr size_t WS_R0 = 352 * MiB;
constexpr size_t WS_Q = WS_R0, WS_K = WS_R0 + 128 * MiB, WS_V = WS_R0 + 256 * MiB;
constexpr size_t WS_KN = WS_R0, WS_VM = WS_R0 + 128 * MiB, WS_QM = WS_R0 + 256 * MiB;
constexpr size_t WS_KR = WS_R0 + 448 * MiB;
constexpr size_t WS_QP = WS_R0, WS_SC = WS_R0 + 128 * MiB, WS_IDS = WS_R0 + 384 * MiB, WS_GATE = WS_R0 + 400 * MiB;
constexpr size_t WS_DKQ = WS_R0 + 256 * MiB;
constexpr size_t WS_X8 = WS_R0 + 416 * MiB;
constexpr size_t WS_XS = WS_R0 + 480 * MiB;
constexpr size_t WS_WST = WS_R0 + 608 * MiB;
constexpr size_t WS_END = WS_R0 + 624 * MiB;

constexpr int CW_TMO = 0, CW_CHK = 2, CW_BAR = 4096;

__device__ __forceinline__ unsigned f2bf(float f) { unsigned u = __builtin_bit_cast(unsigned, f); return (u + 0x7fffu + ((u >> 16) & 1u)) >> 16; }
__device__ __forceinline__ unsigned pk2(float lo, float hi) { return f2bf(lo) | (f2bf(hi) << 16); }
__device__ __forceinline__ unsigned pk4_fp8(float a, float b, float c, float d) { int w = __builtin_amdgcn_cvt_pk_fp8_f32(a, b, 0, false); w = __builtin_amdgcn_cvt_pk_fp8_f32(c, d, w, true); return (unsigned)w; }
constexpr float SA8 = 16.f, SWT8 = 512.f;
constexpr float SQ8 = 16.f, SK8 = 16.f, SV8 = 16.f;
constexpr float SO8 = 32.f;
template <int CTRL> __device__ __forceinline__ float quad_f32(float x) { return __int_as_float(__builtin_amdgcn_update_dpp(0, __float_as_int(x), CTRL, 0xF, 0xF, false)); }
__device__ __forceinline__ float bflo(unsigned w) { return __builtin_bit_cast(float, w << 16); }
__device__ __forceinline__ float bfhi(unsigned w) { return __builtin_bit_cast(float, w & 0xffff0000u); }
__device__ __forceinline__ float bf2f(bf16_t h) { return __builtin_bit_cast(float, (unsigned)h << 16); }
__device__ __forceinline__ unsigned cvtpk(float lo, float hi) { unsigned r; asm volatile("v_cvt_pk_bf16_f32 %0, %1, %2" : "=v"(r) : "v"(lo), "v"(hi)); return r; }
__device__ __forceinline__ float wave_sum(float v) {
#pragma unroll
    for (int o = 1; o < 64; o <<= 1) v += __shfl_xor(v, o);
    return v;
}
__device__ __forceinline__ unsigned wave_max_u32(unsigned v) {
#pragma unroll
    for (int o = 1; o < 64; o <<= 1) { unsigned w = (unsigned)__shfl_xor((int)v, o); v = v > w ? v : w; }
    return v;
}
__device__ __forceinline__ int lane_id_v() { int l; asm volatile("v_mbcnt_lo_u32_b32 %0, -1, 0\n\tv_mbcnt_hi_u32_b32 %0, -1, %0" : "=v"(l)); return l; }
#define LDS_WAIT() asm volatile("s_waitcnt lgkmcnt(0)" ::: "memory")
#define VM_WAIT() asm volatile("s_waitcnt vmcnt(0)" ::: "memory")
#define SBAR() __builtin_amdgcn_sched_barrier(0)

namespace pg8 {
constexpr int BM = 256, BK = 64, HALF = 128, HTB = HALF * BK * 2, STAGE_BYTES = 8 * HTB, NXCD = 8, WGM = 8;
__host__ __device__ __forceinline__ int lds_byte(int r, int c) { const int st = (r >> 4) * 2 + (c >> 5), rr = r & 15, cc = c & 31, ob = rr * 64 + cc * 2; return st * 1024 + (ob ^ (((ob >> 9) & 1) << 5)); }
__host__ __device__ __forceinline__ void stage_rc(int b, int& R, int& C) { const int st = b / 1024, sb = b % 1024, swz = sb ^ (((sb >> 9) & 1) << 5); R = (st >> 1) * 16 + swz / 64; C = (st & 1) * 32 + (swz % 64) / 2; }
__host__ __device__ __forceinline__ int perm32(int rho) { const int n = rho >> 4, i = rho & 15; return 8 * (i >> 2) + 4 * n + (i & 3); }
struct Unit { int pm, pn; };
struct Gemm { const bf16_t* A; const bf16_t* Bt; int M, N, K, lda, a_pn, ldb = 0, b_pm = 0; };
struct StaticOrder {
    int nM, nN, nwg, G, c;
    __device__ void init(int M, int N, int G_, int c_) { nM = M / BM; nN = N / BM; nwg = nM * nN; G = G_; c = c_; }
    __device__ bool next(int i, Unit& u) const {
        const long L = (long)i * G + c; if (L >= nwg) return false;
        int wgid = (int)L; { const int q = nwg / NXCD, r = nwg % NXCD, xcd = wgid % NXCD, off = wgid / NXCD; wgid = (xcd < r ? xcd * (q + 1) : r * (q + 1) + (xcd - r) * q) + off; }
        const int nig = WGM * nN, gid = wgid / nig, fm = gid * WGM, gsz = (nM - fm) < WGM ? (nM - fm) : WGM;
        u.pm = fm + ((wgid % nig) % gsz); u.pn = (wgid % nig) / gsz; return true;
    }
};
struct EpiQKV {
    static constexpr bool PERM = true;
    bf16_t* Q; size_t split_stride; const float* rstd; float qscale;
    __device__ __forceinline__ void operator()(const f32x4 (&acc)[2][2][4][2], const Unit& u, int wr, int wc, int fr, int fq) const {
        const int row0 = u.pm * BM + wr * 64 + fr; int colt = u.pn * BM; const int t = colt / DM; bf16_t* base = Q + (size_t)t * split_stride; colt -= t * DM;
        const float sc = t == 0 ? qscale : 1.f; const int col0 = colt + wc * 32 + 8 * fq;
#pragma unroll
        for (int ai = 0; ai < 2; ++ai)
#pragma unroll
            for (int m = 0; m < 4; ++m) { const int row = row0 + ai * HALF + m * 16; const float rs = rstd[row] * sc; bf16_t* rowp = base + (size_t)row * DM + col0;
#pragma unroll
                for (int bj = 0; bj < 2; ++bj) { const f32x4 v0 = acc[ai][bj][m][0] * rs, v1 = acc[ai][bj][m][1] * rs;
                    u32x4 w; w.x = cvtpk(v0[0], v0[1]); w.y = cvtpk(v0[2], v0[3]); w.z = cvtpk(v1[0], v1[1]); w.w = cvtpk(v1[2], v1[3]);
                    *(u32x4*)(rowp + bj * HALF) = w; } }
    }
};
struct EpiB16 {
    static constexpr bool PERM = true;
    bf16_t* O; int ldc; const float* rstd; float scale = 1.f;
    __device__ __forceinline__ void operator()(const f32x4 (&acc)[2][2][4][2], const Unit& u, int wr, int wc, int fr, int fq) const {
        const int row0 = u.pm * BM + wr * 64 + fr, col0 = u.pn * BM + wc * 32 + 8 * fq;
#pragma unroll
        for (int ai = 0; ai < 2; ++ai)
#pragma unroll
            for (int m = 0; m < 4; ++m) { const int row = row0 + ai * HALF + m * 16; const float rs = (rstd ? rstd[row] : 1.f) * scale; bf16_t* rowp = O + (size_t)row * ldc + col0;
#pragma unroll
                for (int bj = 0; bj < 2; ++bj) { const f32x4 v0 = acc[ai][bj][m][0] * rs, v1 = acc[ai][bj][m][1] * rs;
                    u32x4 w; w.x = cvtpk(v0[0], v0[1]); w.y = cvtpk(v0[2], v0[3]); w.z = cvtpk(v1[0], v1[1]); w.w = cvtpk(v1[2], v1[3]);
                    *(u32x4*)(rowp + bj * HALF) = w; } }
    }
};
struct EpiUKV {
    static constexpr bool PERM = true;
    bf16_t* KN; bf16_t* VM; const float* rstd; float scale = 1.f;
    __device__ __forceinline__ void operator()(const f32x4 (&acc)[2][2][4][2], const Unit& u, int wr, int wc, int fr, int fq) const {
        const int row0 = u.pm * BM + wr * 64 + fr, col0 = u.pn * HD + wc * 32 + 8 * fq;
#pragma unroll
        for (int ai = 0; ai < 2; ++ai)
#pragma unroll
            for (int m = 0; m < 4; ++m) { const int row = row0 + ai * HALF + m * 16; const float rs = (rstd ? rstd[row] : 1.f) * scale;
                { const f32x4 v0 = acc[ai][0][m][0] * (rs * SK8), v1 = acc[ai][0][m][1] * (rs * SK8);
                    u32x2 w; w.x = pk4_fp8(v0[0], v0[1], v0[2], v0[3]); w.y = pk4_fp8(v1[0], v1[1], v1[2], v1[3]); *(u32x2*)((unsigned char*)KN + (size_t)row * DM + col0) = w; }
                { const f32x4 v0 = acc[ai][1][m][0] * (rs * SV8), v1 = acc[ai][1][m][1] * (rs * SV8);
                    u32x2 w; w.x = pk4_fp8(v0[0], v0[1], v0[2], v0[3]); w.y = pk4_fp8(v1[0], v1[1], v1[2], v1[3]); *(u32x2*)((unsigned char*)VM + (size_t)row * DM + col0) = w; } }
    }
};
struct EpiF8 {
    static constexpr bool PERM = true;
    unsigned char* O; int ldc; float scale;
    __device__ __forceinline__ void operator()(const f32x4 (&acc)[2][2][4][2], const Unit& u, int wr, int wc, int fr, int fq) const {
        const int row0 = u.pm * BM + wr * 64 + fr, col0 = u.pn * BM + wc * 32 + 8 * fq;
#pragma unroll
        for (int ai = 0; ai < 2; ++ai)
#pragma unroll
            for (int m = 0; m < 4; ++m) { const int row = row0 + ai * HALF + m * 16; unsigned char* rowp = O + (size_t)row * ldc + col0;
#pragma unroll
                for (int bj = 0; bj < 2; ++bj) { const f32x4 v0 = acc[ai][bj][m][0] * scale, v1 = acc[ai][bj][m][1] * scale;
                    u32x2 w; w.x = pk4_fp8(v0[0], v0[1], v0[2], v0[3]); w.y = pk4_fp8(v1[0], v1[1], v1[2], v1[3]); *(u32x2*)(rowp + bj * HALF) = w; } }
    }
};
struct EpiF16 {
    static constexpr bool PERM = true;
    _Float16* O; int ldc; const float* rstd; float scale = 1.f;
    __device__ __forceinline__ void operator()(const f32x4 (&acc)[2][2][4][2], const Unit& u, int wr, int wc, int fr, int fq) const {
        typedef _Float16 h8 __attribute__((ext_vector_type(8)));
        const int row0 = u.pm * BM + wr * 64 + fr, col0 = u.pn * BM + wc * 32 + 8 * fq;
#pragma unroll
        for (int ai = 0; ai < 2; ++ai)
#pragma unroll
            for (int m = 0; m < 4; ++m) { const int row = row0 + ai * HALF + m * 16; const float rs = rstd[row] * scale; _Float16* rowp = O + (size_t)row * ldc + col0;
#pragma unroll
                for (int bj = 0; bj < 2; ++bj) { const f32x4 v0 = acc[ai][bj][m][0] * rs, v1 = acc[ai][bj][m][1] * rs;
                    const h8 w = {(_Float16)v0[0], (_Float16)v0[1], (_Float16)v0[2], (_Float16)v0[3], (_Float16)v1[0], (_Float16)v1[1], (_Float16)v1[2], (_Float16)v1[3]};
                    *(h8*)(rowp + bj * HALF) = w; } }
    }
};
struct EpiF32 {
    static constexpr bool PERM = false;
    float* C; int ldc; const float* rstd;
    __device__ __forceinline__ void operator()(const f32x4 (&acc)[2][2][4][2], const Unit& u, int wr, int wc, int fr, int fq) const {
        const int row0 = u.pm * BM + wr * 64 + fr, col0 = u.pn * BM + wc * 32 + 4 * fq;
#pragma unroll
        for (int ai = 0; ai < 2; ++ai)
#pragma unroll
            for (int m = 0; m < 4; ++m) { const int row = row0 + ai * HALF + m * 16; const float rs = rstd ? rstd[row] : 1.f; float* rowp = C + (size_t)row * ldc + col0;
#pragma unroll
                for (int bj = 0; bj < 2; ++bj)
#pragma unroll
                    for (int n = 0; n < 2; ++n) *(f32x4*)(rowp + bj * HALF + n * 16) = acc[ai][bj][m][n] * rs; }
    }
};
template <bool BASE_F32> struct EpiResB {
    static constexpr bool PERM = true;
    bf16_t* XS; const float* basef; float scale = 1.f;
    __device__ __forceinline__ void operator()(const f32x4 (&acc)[2][2][4][2], const Unit& u, int wr, int wc, int fr, int fq) const {
        const int row0 = u.pm * BM + wr * 64 + fr, col0 = u.pn * BM + wc * 32 + 8 * fq;
#pragma unroll
        for (int ai = 0; ai < 2; ++ai)
#pragma unroll
            for (int m = 0; m < 4; ++m) { const size_t ro = (size_t)(row0 + ai * HALF + m * 16) * DM + col0;
#pragma unroll
                for (int bj = 0; bj < 2; ++bj) { f32x4 b0, b1;
                    if constexpr (BASE_F32) { b0 = *(const f32x4*)(basef + ro + bj * HALF); b1 = *(const f32x4*)(basef + ro + bj * HALF + 4); }
                    else { const u32x4 bw = *(const u32x4*)(XS + ro + bj * HALF); b0 = (f32x4){bflo(bw.x), bfhi(bw.x), bflo(bw.y), bfhi(bw.y)}; b1 = (f32x4){bflo(bw.z), bfhi(bw.z), bflo(bw.w), bfhi(bw.w)}; }
                    const f32x4 v0 = acc[ai][bj][m][0] * scale + b0, v1 = acc[ai][bj][m][1] * scale + b1;
                    u32x4 w; w.x = cvtpk(v0[0], v0[1]); w.y = cvtpk(v0[2], v0[3]); w.z = cvtpk(v1[0], v1[1]); w.w = cvtpk(v1[2], v1[3]);
                    *(u32x4*)(XS + ro + bj * HALF) = w; } }
    }
};
struct EpiRes {
    static constexpr bool PERM = false;
    float* C; const float* base; int ldc;
    __device__ __forceinline__ void operator()(const f32x4 (&acc)[2][2][4][2], const Unit& u, int wr, int wc, int fr, int fq) const {
        const int row0 = u.pm * BM + wr * 64 + fr, col0 = u.pn * BM + wc * 32 + 4 * fq;
#pragma unroll
        for (int ai = 0; ai < 2; ++ai)
#pragma unroll
            for (int m = 0; m < 4; ++m) { const size_t ro = (size_t)(row0 + ai * HALF + m * 16) * ldc + col0;
#pragma unroll
                for (int bj = 0; bj < 2; ++bj)
#pragma unroll
                    for (int n = 0; n < 2; ++n) { const f32x4 b = *(const f32x4*)(base + ro + bj * HALF + n * 16); *(f32x4*)(C + ro + bj * HALF + n * 16) = acc[ai][bj][m][n] + b; } }
    }
};

typedef int i32x4v __attribute__((ext_vector_type(4)));
typedef int i32x8v __attribute__((ext_vector_type(8)));
template <class Epi, bool FP8 = false>
__device__ __forceinline__ void gemm_phase(LAS unsigned char* lds, const Gemm g, const StaticOrder& S, const Epi& E, const int wid, const int lane) {
    const int tid = wid * 64 + lane, wr = wid >> 2, wc = wid & 3, fr = lane & 15, fq = lane >> 4;
    const int K = g.K, nt = K / BK, lda = g.lda, ldb = g.ldb ? g.ldb : K;
    unsigned voffA[2], voffB[2];
#pragma unroll
    for (int i = 0; i < 2; ++i) { int R, C; stage_rc(tid * 16 + i * 8192, R, C); const int Rb = Epi::PERM ? ((R & ~31) + perm32(R & 31)) : R;
        voffA[i] = (unsigned)(R * lda + C) * 2u; voffB[i] = (unsigned)(Rb * ldb + C) * 2u; }
    const size_t kstep = (size_t)(BK * 2);
    const size_t hstepA = (size_t)HALF * lda * 2, hstepB = (size_t)HALF * ldb * 2;
    const size_t tstepA = 2 * hstepA, tstepB = 2 * hstepB;
    const unsigned ldsw = (unsigned)wid * 1024u;
    const int aoff = lds_byte(wr * 64 + fr, fq * 8); int boff = lds_byte(wc * 32 + fr, fq * 8) + 4 * HTB; asm volatile("" : "+v"(boff));
#define PG8_SA(b, h) (((b) * 2 + (h)) * HTB)
#define PG8_SB(b, h) ((4 + (b) * 2 + (h)) * HTB)
#define PG8_SBR(b, h) (((b) * 2 + (h)) * HTB)
#define PG8_STAGE(bufoff, gbase, voff) do { _Pragma("unroll") for (int _i = 0; _i < 2; ++_i) { unsigned vo_ = (voff)[_i]; asm volatile("" : "+v"(vo_));     \
        __builtin_amdgcn_global_load_lds((const unsigned*)((const char*)(gbase) + vo_), (LAS unsigned*)(lds + (bufoff) + ldsw + _i * 8192), 16, 0, 0); } } while (0)
#define PG8_LD4(addr_) (*(const LAS i32x4v*)(lds + (addr_)))
#define PG8_LDA(dst, b, h) do { if constexpr (FP8) { _Pragma("unroll") for (int m = 0; m < 4; ++m) dst##8[m] = __builtin_shufflevector(PG8_LD4(PG8_SA(b, h) + aoff + m * 2048), PG8_LD4(PG8_SA(b, h) + aoff + m * 2048 + 1024), 0, 1, 2, 3, 4, 5, 6, 7); } \
        else { _Pragma("unroll") for (int m = 0; m < 4; ++m) _Pragma("unroll") for (int k = 0; k < 2; ++k) dst[m][k] = *(const LAS bf16x8*)(lds + PG8_SA(b, h) + aoff + m * 2048 + k * 1024); } } while (0)
#define PG8_LDB(dst, b, h) do { if constexpr (FP8) { _Pragma("unroll") for (int n = 0; n < 2; ++n) dst##8[n] = __builtin_shufflevector(PG8_LD4(PG8_SBR(b, h) + boff + n * 2048), PG8_LD4(PG8_SBR(b, h) + boff + n * 2048 + 1024), 0, 1, 2, 3, 4, 5, 6, 7); } \
        else { _Pragma("unroll") for (int n = 0; n < 2; ++n) _Pragma("unroll") for (int k = 0; k < 2; ++k) dst[n][k] = *(const LAS bf16x8*)(lds + PG8_SBR(b, h) + boff + n * 2048 + k * 1024); } } while (0)
#define PG8_MMA(ai, bj, At, Bt) do { __builtin_amdgcn_s_setprio(1);                                                                                                         \
        if constexpr (FP8) { _Pragma("unroll") for (int m = 0; m < 4; ++m) _Pragma("unroll") for (int n = 0; n < 2; ++n)                                                          \
            acc[ai][bj][m][n] = __builtin_amdgcn_mfma_scale_f32_16x16x128_f8f6f4(Bt##8[n], At##8[m], acc[ai][bj][m][n], 0, 0, 0, 0, 0, 0); }                     \
        else { _Pragma("unroll") for (int m = 0; m < 4; ++m) _Pragma("unroll") for (int n = 0; n < 2; ++n) _Pragma("unroll") for (int k = 0; k < 2; ++k)                           \
            acc[ai][bj][m][n] = __builtin_amdgcn_mfma_f32_16x16x32_bf16(Bt[n][k], At[m][k], acc[ai][bj][m][n], 0, 0, 0); }                                                          \
        __builtin_amdgcn_s_setprio(0); } while (0)
#define PG8_WAIT_V(n) asm volatile("s_waitcnt vmcnt(" #n ")" ::: "memory")
#define PG8_WAIT_L(n) asm volatile("s_waitcnt lgkmcnt(" #n ")" ::: "memory")
#define PG8_BAR __builtin_amdgcn_s_barrier()
#define PG8_SCHED __builtin_amdgcn_sched_barrier(0)
    Unit cur, nxt; int ui = 0;
    if (!S.next(0, cur)) return;
    f32x4 acc[2][2][4][2];
#pragma unroll
    for (int a = 0; a < 2; ++a)
#pragma unroll
        for (int b = 0; b < 2; ++b)
#pragma unroll
            for (int m = 0; m < 4; ++m)
#pragma unroll
                for (int n = 0; n < 2; ++n) acc[a][b][m][n] = (f32x4){0.f, 0.f, 0.f, 0.f};
    bf16x8 At[4][2], B0[2][2], B1[2][2];
    i32x8v At8[4], B08[2], B18[2]; (void)At8; (void)B08; (void)B18; (void)At; (void)B0; (void)B1;
    const char* cA = (const char*)g.A + (size_t)cur.pm * tstepA + (size_t)cur.pn * g.a_pn * 2; const char* cB = (const char*)g.Bt + (size_t)cur.pn * tstepB + (size_t)cur.pm * g.b_pm * 2;
    PG8_STAGE(PG8_SB(0, 0), cB, voffB); PG8_STAGE(PG8_SB(0, 1), cB + hstepB, voffB); PG8_STAGE(PG8_SA(0, 0), cA, voffA); PG8_STAGE(PG8_SA(0, 1), cA + hstepA, voffA);
    if (wr == 1) PG8_BAR;
    PG8_WAIT_V(2); PG8_BAR;
    PG8_STAGE(PG8_SB(1, 0), cB + kstep, voffB); PG8_STAGE(PG8_SA(1, 0), cA + kstep, voffA); PG8_STAGE(PG8_SB(1, 1), cB + hstepB + kstep, voffB);
    PG8_WAIT_V(6); PG8_BAR;
#pragma unroll 1
    for (;;) {
        const bool has_next = S.next(ui + 1, nxt);
        const char* nA = has_next ? (const char*)g.A + (size_t)nxt.pm * tstepA + (size_t)nxt.pn * g.a_pn * 2 : cA; const char* nB = has_next ? (const char*)g.Bt + (size_t)nxt.pn * tstepB + (size_t)nxt.pm * g.b_pm * 2 : cB;
#pragma unroll 1
        for (int t = 0; t < nt; t += 2) {
            const bool last = (t == nt - 2);
            const char* a1 = cA + (size_t)(t + 1) * kstep;
            const char* a2 = last ? nA : cA + (size_t)(t + 2) * kstep; const char* b2 = last ? nB : cB + (size_t)(t + 2) * kstep;
            const char* a3 = a2 + kstep; const char* b3 = b2 + kstep;
            PG8_LDB(B0, 0, 0); PG8_LDB(B1, 0, 1); PG8_SCHED; PG8_LDA(At, 0, 0); PG8_STAGE(PG8_SA(1, 1), a1 + hstepA, voffA);
            PG8_WAIT_V(8); PG8_WAIT_L(0); PG8_BAR; PG8_MMA(0, 0, At, B0); PG8_MMA(0, 1, At, B1); PG8_BAR; PG8_SCHED;
            PG8_LDA(At, 0, 1); PG8_STAGE(PG8_SB(0, 0), b2, voffB); PG8_STAGE(PG8_SB(0, 1), b2 + hstepB, voffB); PG8_STAGE(PG8_SA(0, 0), a2, voffA);
            PG8_WAIT_V(8); PG8_WAIT_L(0); PG8_BAR; PG8_MMA(1, 0, At, B0); PG8_MMA(1, 1, At, B1); PG8_BAR; PG8_SCHED;
            PG8_LDB(B0, 1, 0); PG8_LDB(B1, 1, 1); PG8_SCHED; PG8_LDA(At, 1, 0); PG8_STAGE(PG8_SA(0, 1), a2 + hstepA, voffA);
            PG8_WAIT_V(8); PG8_WAIT_L(0); PG8_BAR; PG8_MMA(0, 0, At, B0); PG8_MMA(0, 1, At, B1); PG8_BAR; PG8_SCHED;
            PG8_LDA(At, 1, 1); PG8_STAGE(PG8_SB(1, 0), b3, voffB); PG8_STAGE(PG8_SB(1, 1), b3 + hstepB, voffB); PG8_STAGE(PG8_SA(1, 0), a3, voffA);
            PG8_WAIT_V(8); PG8_WAIT_L(0); PG8_BAR; PG8_MMA(1, 0, At, B0); PG8_MMA(1, 1, At, B1); PG8_BAR; PG8_SCHED;
        }
        if (wr == 0) PG8_BAR;
        E(acc, cur, wr, wc, fr, fq);
        if (!has_next) break;
#pragma unroll
        for (int a = 0; a < 2; ++a)
#pragma unroll
            for (int b = 0; b < 2; ++b)
#pragma unroll
                for (int m = 0; m < 4; ++m)
#pragma unroll
                    for (int n = 0; n < 2; ++n) acc[a][b][m][n] = (f32x4){0.f, 0.f, 0.f, 0.f};
        cur = nxt; cA = nA; cB = nB; ++ui;
        if (wr == 1) PG8_BAR;
    }
    PG8_WAIT_V(0);
    PG8_BAR;
#undef PG8_SA
#undef PG8_SB
#undef PG8_SBR
#undef PG8_STAGE
#undef PG8_LDA
#undef PG8_LD4
#undef PG8_LDB
#undef PG8_MMA
#undef PG8_WAIT_V
#undef PG8_WAIT_L
#undef PG8_BAR
#undef PG8_SCHED
}
}

namespace att {
typedef int i32x8q __attribute__((ext_vector_type(8)));
typedef int i32x4q __attribute__((ext_vector_type(4)));
constexpr int SHM_V = 16384, SHM_K = 16384, SHM_R = 8192;
constexpr int OFF_V = 0, OFF_K = 2 * SHM_V, OFF_R = OFF_K + 2 * SHM_K, OFF_WS = OFF_R + 2 * SHM_R, LDS_BYTES = OFF_WS + NWAVES * 64 * 4;
#define KSWZ(row, colB) ((row) * 256 + ((colB) ^ (((row) & 7) << 4)))
#define RSWZ(row, colB) ((row) * 128 + ((colB) ^ (((row) & 7) << 4)))
__device__ __forceinline__ int v_st(int k, int c) { const int kk = (k & ~0xC) | ((k & 4) << 1) | ((k & 8) >> 1); return ((kk >> 3) * 4 + (c >> 5)) * 512 + ((kk & 7) * 32 + (c & 31)) * 2; }
__device__ __forceinline__ int v_rd_base(int lane) { return ((lane & 3) << 3) | (((lane >> 2) & 3) << 6) | (((lane >> 4) & 1) << 5) | (((lane >> 5) & 1) << 8); }
__device__ __forceinline__ int crow(int r, int hi) { return (r & 3) + 8 * (r >> 2) + 4 * hi; }
__device__ __forceinline__ float pl_sum(float x) { auto rr = __builtin_amdgcn_permlane32_swap(__float_as_uint(x), __float_as_uint(x), false, false); return __uint_as_float(rr[0]) + __uint_as_float(rr[1]); }
__device__ __forceinline__ float pl_max(float x) { auto rr = __builtin_amdgcn_permlane32_swap(__float_as_uint(x), __float_as_uint(x), false, false); return fmaxf(__uint_as_float(rr[0]), __uint_as_float(rr[1])); }

#define PK4(P, B_, OUT) do { unsigned a0 = cvtpk(P[B_+0], P[B_+1]), a1 = cvtpk(P[B_+2], P[B_+3]);                          \
        unsigned b0 = cvtpk(P[B_+4], P[B_+5]), b1 = cvtpk(P[B_+6], P[B_+7]);                                             \
        auto r0 = __builtin_amdgcn_permlane32_swap(a0, b0, false, false); auto r1 = __builtin_amdgcn_permlane32_swap(a1, b1, false, false); \
        u32x4 w = {r0[0], r1[0], r0[1], r1[1]}; OUT = __builtin_bit_cast(bf16x8, w); } while (0)

__device__ __forceinline__ void pv_tile(f32x16* o, unsigned vb, bf16x8 pa0, bf16x8 pa1, bf16x8 pa2, bf16x8 pa3) {
#define TRRD(dst, off) asm volatile("ds_read_b64_tr_b16 %0, %1 offset:%2" : "=&v"(dst) : "v"(vb), "i"(off) : "memory")
#define PV_RD(S, d0) do { constexpr int b_ = (d0) * 512; TRRD(S##l0, b_); TRRD(S##h0, b_ + 2048); TRRD(S##l1, b_ + 4096); TRRD(S##h1, b_ + 6144); TRRD(S##l2, b_ + 8192); TRRD(S##h2, b_ + 10240); TRRD(S##l3, b_ + 12288); TRRD(S##h3, b_ + 14336); } while (0)
#define PV_MM(S, d0) do {   \
        o[d0] = __builtin_amdgcn_mfma_f32_32x32x16_bf16(pa0, (bf16x8){S##l0[0], S##l0[1], S##l0[2], S##l0[3], S##h0[0], S##h0[1], S##h0[2], S##h0[3]}, o[d0], 0, 0, 0);   \
        o[d0] = __builtin_amdgcn_mfma_f32_32x32x16_bf16(pa1, (bf16x8){S##l1[0], S##l1[1], S##l1[2], S##l1[3], S##h1[0], S##h1[1], S##h1[2], S##h1[3]}, o[d0], 0, 0, 0);   \
        o[d0] = __builtin_amdgcn_mfma_f32_32x32x16_bf16(pa2, (bf16x8){S##l2[0], S##l2[1], S##l2[2], S##l2[3], S##h2[0], S##h2[1], S##h2[2], S##h2[3]}, o[d0], 0, 0, 0);   \
        o[d0] = __builtin_amdgcn_mfma_f32_32x32x16_bf16(pa3, (bf16x8){S##l3[0], S##l3[1], S##l3[2], S##l3[3], S##h3[0], S##h3[1], S##h3[2], S##h3[3]}, o[d0], 0, 0, 0); } while (0)
#define PV_WAIT(n) do { asm volatile("s_waitcnt lgkmcnt(" #n ")" ::: "memory"); SBAR(); } while (0)
    s16x4 Al0, Al1, Al2, Al3, Ah0, Ah1, Ah2, Ah3, Bl0, Bl1, Bl2, Bl3, Bh0, Bh1, Bh2, Bh3;
    PV_RD(A, 0); PV_RD(B, 1); PV_WAIT(8); PV_MM(A, 0); SBAR();
    PV_RD(A, 2); PV_WAIT(8); PV_MM(B, 1); SBAR();
    PV_RD(B, 3); PV_WAIT(8); PV_MM(A, 2); SBAR();
    PV_WAIT(0); PV_MM(B, 3);
#undef PV_RD
#undef PV_MM
#undef PV_WAIT
#undef TRRD
}

__device__ __forceinline__ void pv_tile8(f32x16* o, LAS unsigned char* vt, const int (&va)[4], const i32x8q pa) {
#pragma unroll
    for (int d0 = 0; d0 < 4; ++d0) {
        const auto b0 = __builtin_amdgcn_ds_read_tr8_b64_v2i32((LAS i32x2v*)(vt + va[d0])), b1 = __builtin_amdgcn_ds_read_tr8_b64_v2i32((LAS i32x2v*)(vt + va[d0] + 2048));
        const auto b2 = __builtin_amdgcn_ds_read_tr8_b64_v2i32((LAS i32x2v*)(vt + va[d0] + 4096)), b3 = __builtin_amdgcn_ds_read_tr8_b64_v2i32((LAS i32x2v*)(vt + va[d0] + 6144));
        const i32x8q bb = {b0[0], b0[1], b1[0], b1[1], b2[0], b2[1], b3[0], b3[1]};
        o[d0] = __builtin_amdgcn_mfma_scale_f32_32x32x64_f8f6f4(pa, bb, o[d0], 0, 0, 0, 0, 0, 0); }
}
__device__ __forceinline__ void sb_tile(f32x16& p0, f32x16& p1, float& R, int dq, int hi) {
    const float NEG = -__builtin_inff();
    asm volatile("" : "+v"(dq));
    float g[8];
#define SB_GRP(P, half, i) do { float Lv[4], zv[4];                                                                              \
        _Pragma("unroll") for (int jj = 0; jj < 4; ++jj) { const int c = jj + 8 * (i) + 32 * (half); const bool ok = dq >= c;  \
            const float z = fminf(P[4 * (i) + jj], 80.f); const float e = __builtin_amdgcn_exp2f(z);                               \
            const float sp = __builtin_amdgcn_logf(1.f + e); Lv[jj] = ok ? -sp : 0.f; zv[jj] = ok ? z : NEG; }                      \
        const float s3 = Lv[3], s2 = Lv[2] + s3, s1 = Lv[1] + s2, s0 = Lv[0] + s1;                                                \
        P[4 * (i) + 0] = zv[0] + s0; P[4 * (i) + 1] = zv[1] + s1; P[4 * (i) + 2] = zv[2] + s2; P[4 * (i) + 3] = zv[3] + s3;      \
        g[(half) * 4 + (i)] = s0; } while (0)
    SB_GRP(p0, 0, 0); SB_GRP(p0, 0, 1); SB_GRP(p0, 0, 2); SB_GRP(p0, 0, 3);
    SB_GRP(p1, 1, 0); SB_GRP(p1, 1, 1); SB_GRP(p1, 1, 2); SB_GRP(p1, 1, 3);
#undef SB_GRP
    float c[8], Tk[8];
#pragma unroll
    for (int k = 0; k < 8; ++k) c[k] = pl_sum(g[k]);
    Tk[7] = 0.f;
#pragma unroll
    for (int k = 6; k >= 0; --k) Tk[k] = Tk[k + 1] + c[k + 1];
    const float tot = Tk[0] + c[0];
#pragma unroll
    for (int k = 0; k < 8; ++k) { const float add = R + Tk[k] + (hi == 0 ? (c[k] - g[k]) : 0.f);
#pragma unroll
        for (int jj = 0; jj < 4; ++jj) { if (k < 4) p0[4 * k + jj] = __builtin_amdgcn_exp2f(p0[4 * k + jj] + add); else p1[4 * (k - 4) + jj] = __builtin_amdgcn_exp2f(p1[4 * (k - 4) + jj] + add); } }
    R += tot;
}

template <int MODE>
__device__ __forceinline__ void attn_unit(LAS unsigned char* lds, const bf16_t* Qp, int qpitch, const bf16_t* Kp, const bf16_t* Vp, int kvpitch,
                                          const bf16_t* Rp, const float* cs, bf16_t* Op, int opitch, int q0, const int wid, const int lane) {
    constexpr float SCALE = 0.07216878364870323f / (SQ8 * SK8);
    constexpr float C2 = LOG2E * SCALE, THR = MODE ? 5.f : 8.f, SB_EXIT = 40.f;
    const int r32 = lane & 31, hi = lane >> 5;
    const int qrow = q0 + wid * 32 + r32;
    LAS unsigned char* V_lds = lds + OFF_V; LAS unsigned char* K_lds = lds + OFF_K; LAS unsigned char* R_lds = lds + OFF_R;
    LAS float* wsf = (LAS float*)(lds + OFF_WS) + wid * 64;
    bf16x8 qr[MODE ? 1 : 8]; i32x8q qf[MODE ? 3 : 1]; (void)qr; (void)qf;
    if constexpr (MODE == 0) {
#pragma unroll
        for (int d0 = 0; d0 < 8; ++d0) qr[d0] = *(const bf16x8*)(Qp + (size_t)qrow * qpitch + d0 * 16 + hi * 8);
    } else {
#pragma unroll
        for (int j = 0; j < 3; ++j) { u32x4 w[4];
#pragma unroll
            for (int c = 0; c < 4; ++c) w[c] = *(const u32x4*)(Qp + (size_t)qrow * qpitch + j * 64 + hi * 32 + c * 8);
            float f[32];
#pragma unroll
            for (int c = 0; c < 4; ++c) { f[8 * c + 0] = bflo(w[c].x); f[8 * c + 1] = bfhi(w[c].x); f[8 * c + 2] = bflo(w[c].y); f[8 * c + 3] = bfhi(w[c].y); f[8 * c + 4] = bflo(w[c].z); f[8 * c + 5] = bfhi(w[c].z); f[8 * c + 6] = bflo(w[c].w); f[8 * c + 7] = bfhi(w[c].w); }
            if (j == 2) { const float* csr = cs + (size_t)qrow * 64;
#pragma unroll
                for (int e = 0; e < 32; ++e) { const float own = f[e]; auto rr = __builtin_amdgcn_permlane32_swap(__float_as_uint(own), __float_as_uint(own), false, false);
                    const float oth = __uint_as_float(hi ? rr[0] : rr[1]); const float co = csr[2 * e], si = csr[2 * e + 1];
                    f[e] = hi ? (own * co + oth * si) : (own * co - oth * si); } }
            i32x8q q8;
#pragma unroll
            for (int c = 0; c < 8; ++c) q8[c] = (int)pk4_fp8(f[4 * c] * SQ8, f[4 * c + 1] * SQ8, f[4 * c + 2] * SQ8, f[4 * c + 3] * SQ8);
            qf[j] = q8; }
    }
    const int NT = q0 / 64 + 4;
    const unsigned vb0 = (unsigned)(size_t)(V_lds) + (unsigned)v_rd_base(lane);
    unsigned koff[2], voff[2], roff;
#pragma unroll
    for (int i = 0; i < 2; ++i) { const int p = (wid * 2 + i) * 64 + lane;
        { const int row = p >> 4, pc = p & 15; koff[i] = (unsigned)(row * kvpitch + ((pc ^ (row & 7)) * 8)); }
        { const int sub = p >> 5, w = p & 31, kk = (sub >> 2) * 8 + (w >> 2), c = (sub & 3) * 32 + (w & 3) * 8, k = (kk & ~0xC) | ((kk & 4) << 1) | ((kk & 8) >> 1); voff[i] = (unsigned)(k * kvpitch + c); } }
    { const int p = wid * 64 + lane, row = p >> 3, pc = p & 7; roff = (unsigned)(row * 64 + ((pc ^ (row & 7)) * 8)); }
    if constexpr (MODE == 1) { const int p = wid * 64 + lane, row = p >> 3, pc = p & 7, sg = pc ^ (row & 7);
        koff[0] = (unsigned)(row * kvpitch + sg * 16);
        roff = (unsigned)(((2 * (row & 31) + (sg >> 2)) * 64) + (sg & 3) * 16); }
    int va8[4]; (void)va8;
    if constexpr (MODE == 1) { const int p = wid * 64 + lane, row = p >> 3, pc = p & 7, sw = (row & 3) | (((row >> 3) & 1) << 2);
        voff[0] = (unsigned)(row * kvpitch + ((pc ^ sw) * 16));
        const int r = (lane & 15) >> 1, pp = lane & 1, gq = (lane >> 4) & 1, row0 = (r & 3) + 8 * (r >> 2) + 4 * hi;
#pragma unroll
        for (int d0 = 0; d0 < 4; ++d0) va8[d0] = row0 * 128 + (((2 * d0 + gq) ^ r) << 4) + 8 * pp; }
#define TILE_OF(it) (MODE ? (it) : (NT - 1 - (it)))
#define STAGE(jt, bf) do { const size_t kb_ = (size_t)(jt) * 64 * kvpitch;                                                                                   \
        if constexpr (MODE == 1) {                                                                                                                           \
            __builtin_amdgcn_global_load_lds((const unsigned*)((const unsigned char*)Kp + kb_ + koff[0]), (LAS unsigned*)(K_lds + (bf) * SHM_K + wid * 1024), 16, 0, 0);   \
            if (wid < 4) __builtin_amdgcn_global_load_lds((const unsigned*)((const unsigned char*)Rp + (size_t)(jt) * 64 * 64 + roff), (LAS unsigned*)(R_lds + (bf) * SHM_R + wid * 1024), 16, 0, 0); \
            __builtin_amdgcn_global_load_lds((const unsigned*)((const unsigned char*)Vp + kb_ + voff[0]), (LAS unsigned*)(V_lds + (bf) * SHM_V + wid * 1024), 16, 0, 0); \
        } else {                                                                                                                                             \
        _Pragma("unroll") for (int i_ = 0; i_ < 2; ++i_) {                                                                                                   \
            __builtin_amdgcn_global_load_lds((const unsigned*)(Kp + kb_ + koff[i_]), (LAS unsigned*)(K_lds + (bf) * SHM_K + (wid * 2 + i_) * 1024), 16, 0, 0);   \
            __builtin_amdgcn_global_load_lds((const unsigned*)(Vp + kb_ + voff[i_]), (LAS unsigned*)(V_lds + (bf) * SHM_V + (wid * 2 + i_) * 1024), 16, 0, 0); } } } while (0)
    float m_reg = -1e30f, l_reg = 0.f, Rrun = 0.f; f32x16 o[4];
#pragma unroll
    for (int d = 0; d < 4; ++d) o[d] = f32x16{};
    STAGE(TILE_OF(0), 0);
    __syncthreads();
    for (int it = 0; it < NT; ++it) {
        const int buf = it & 1, jt = TILE_OF(it), k0 = jt * 64;
        if (it + 1 < NT) STAGE(TILE_OF(it + 1), buf ^ 1);
        if (MODE ? (k0 <= q0 + wid * 32 + 31) : (k0 < q0 + wid * 32 + 31)) {
        f32x16 p0 = f32x16{}, p1 = f32x16{};
        if constexpr (MODE == 1) {
            LAS unsigned char* kb = K_lds + buf * SHM_K; LAS unsigned char* rb = R_lds + buf * SHM_R;
#define KF8(base_, row_, colB_) __builtin_shufflevector(*(const LAS i32x4q*)((base_) + RSWZ(row_, colB_)), *(const LAS i32x4q*)((base_) + RSWZ(row_, (colB_) + 16)), 0, 1, 2, 3, 4, 5, 6, 7)
#pragma unroll
            for (int j = 0; j < 2; ++j) { const i32x8q a0 = KF8(kb, r32, 64 * j + 32 * hi), a1 = KF8(kb, r32 + 32, 64 * j + 32 * hi);
                p0 = __builtin_amdgcn_mfma_scale_f32_32x32x64_f8f6f4(a0, qf[j], p0, 0, 0, 0, 0, 0, 0);
                p1 = __builtin_amdgcn_mfma_scale_f32_32x32x64_f8f6f4(a1, qf[j], p1, 0, 0, 0, 0, 0, 0); }
            { const i32x8q a0 = KF8(rb, r32 >> 1, (r32 & 1) * 64 + 32 * hi), a1 = KF8(rb, (r32 >> 1) + 16, (r32 & 1) * 64 + 32 * hi);
                p0 = __builtin_amdgcn_mfma_scale_f32_32x32x64_f8f6f4(a0, qf[2], p0, 0, 0, 0, 0, 0, 0);
                p1 = __builtin_amdgcn_mfma_scale_f32_32x32x64_f8f6f4(a1, qf[2], p1, 0, 0, 0, 0, 0, 0); }
#undef KF8
        } else {
            LAS unsigned char* kb = K_lds + buf * SHM_K;
#pragma unroll
            for (int d0 = 0; d0 < 8; ++d0) { LAS unsigned char* a = kb + KSWZ(r32, ((d0 & 3) * 16 + hi * 8) * 2) + (d0 >> 2) * 128;
                const bf16x8 b0 = *(LAS bf16x8*)a, b1 = *(LAS bf16x8*)(a + 32 * 256);
                p0 = __builtin_amdgcn_mfma_f32_32x32x16_bf16(b0, qr[d0], p0, 0, 0, 0);
                p1 = __builtin_amdgcn_mfma_f32_32x32x16_bf16(b1, qr[d0], p1, 0, 0, 0); }
        }
        bf16x8 pa0, pa1, pa2, pa3;
        if constexpr (MODE == 0) {
            sb_tile(p0, p1, Rrun, qrow - 1 - k0 - 4 * hi, hi);
        } else {
            const float NEG = -__builtin_inff();
            if (k0 + 63 > q0 + wid * 32) {
                int dq = qrow - k0 - 4 * hi; asm volatile("" : "+v"(dq));
#pragma unroll
                for (int r = 0; r < 16; ++r) { const int c = (r & 3) + 8 * (r >> 2); if (dq < c) p0[r] = NEG; if (dq < c + 32) p1[r] = NEG; }
            }
            float pmax = p0[0];
#pragma unroll
            for (int r = 1; r < 16; ++r) pmax = fmaxf(pmax, p0[r]);
#pragma unroll
            for (int r = 0; r < 16; ++r) pmax = fmaxf(pmax, p1[r]);
            pmax = pl_max(pmax);
            float mn, alpha;
            if (__all((pmax - m_reg) * SCALE <= THR)) { mn = m_reg; alpha = 1.f; }
            else { mn = fmaxf(m_reg, pmax); alpha = __builtin_amdgcn_exp2f((m_reg - mn) * C2); m_reg = mn; }
            const float mnL = -mn * C2;
#pragma unroll
            for (int r = 0; r < 16; ++r) { p0[r] = __builtin_amdgcn_exp2f(fmaf(p0[r], C2, mnL)); p1[r] = __builtin_amdgcn_exp2f(fmaf(p1[r], C2, mnL)); }
            float ps = 0.f;
#pragma unroll
            for (int r = 0; r < 16; ++r) ps += p0[r] + p1[r];
            ps = pl_sum(ps);
            l_reg = l_reg * alpha + ps;
            if (__any(alpha < 1.f)) { if (hi == 0) wsf[r32] = alpha; LDS_WAIT();
#pragma unroll
                for (int r = 0; r < 16; ++r) { const float al = wsf[crow(r, hi)];
#pragma unroll
                    for (int d = 0; d < 4; ++d) o[d][r] *= al; } }
        }
        if constexpr (MODE == 1) { i32x8q pa;
#pragma unroll
            for (int c = 0; c < 4; ++c) { pa[c] = (int)pk4_fp8(p0[4 * c], p0[4 * c + 1], p0[4 * c + 2], p0[4 * c + 3]); pa[4 + c] = (int)pk4_fp8(p1[4 * c], p1[4 * c + 1], p1[4 * c + 2], p1[4 * c + 3]); }
            pv_tile8(o, V_lds + buf * SHM_V, va8, pa);
        } else {
        PK4(p0, 0, pa0); PK4(p0, 8, pa1); PK4(p1, 0, pa2); PK4(p1, 8, pa3);
        SBAR();
        pv_tile(o, vb0 + buf * SHM_V, pa0, pa1, pa2, pa3); }
        }
        if constexpr (MODE == 0) {
            if (lane == 0) wsf[40 + (it & 1)] = __all(Rrun < -SB_EXIT) ? 1.f : 0.f;
            __syncthreads();
            LAS float* wsa = (LAS float*)(lds + OFF_WS) + 40 + (it & 1);
            const float allf = wsa[0] * wsa[64] * wsa[128] * wsa[192] * wsa[256] * wsa[320] * wsa[384] * wsa[448];
            if (allf != 0.f) break;
        } else {
            __syncthreads();
        }
    }
    if constexpr (MODE == 1) { if (hi == 0) wsf[r32] = l_reg; LDS_WAIT(); }
    if constexpr (MODE == 1) {
        GAS unsigned char* Ow = (GAS unsigned char*)Op + (size_t)(q0 + wid * 32) * opitch; asm volatile("" : "+s"(Ow));
        int hio = hi; asm volatile("" : "+v"(hio));
#pragma unroll
        for (int r = 0; r < 16; ++r) { const int orow = crow(r, hio); const float inv = __builtin_amdgcn_rcpf(wsf[orow]) * (SO8 / SV8);
#pragma unroll
            for (int d0 = 0; d0 < 4; ++d0) { const float v = o[d0][r] * inv; const float v1 = quad_f32<0xB1>(v), v2 = quad_f32<0x4E>(v), v3 = quad_f32<0x1B>(v);
                if ((r32 & 3) == 0) *(GAS unsigned*)(Ow + (size_t)orow * opitch + d0 * 32 + r32) = pk4_fp8(v, v1, v2, v3); } }
    } else {
    GAS bf16_t* Ow = (GAS bf16_t*)(Op + (size_t)(q0 + wid * 32) * opitch); asm volatile("" : "+s"(Ow));
#pragma unroll
    for (int r = 0; r < 16; ++r) { const int orow = crow(r, hi);
#pragma unroll
        for (int d0 = 0; d0 < 4; ++d0) { const float v = o[d0][r]; const float vn = __shfl_xor(v, 1);
            if ((r32 & 1) == 0) *(GAS unsigned*)(Ow + (size_t)orow * opitch + d0 * 32 + r32) = pk2(v, vn); } }
    }
    __syncthreads();
#undef TILE_OF
#undef STAGE
}
}

#define XB_TMO      128
#define XB_XCNT(j)  (256  + 64 * (j))
#define XB_XSUB(j)  (1280 + 64 * (j))
#define XB_XGEN(j)  (2304 + 64 * (j))
#define XB_TOP      3328
#define XB_TOPGEN   3392
#define XCD_BAR_WORDS 3456
#define XB_SPIN_CAP (1u << 22)
__device__ __forceinline__ unsigned xb_ld(unsigned* p)              { return __hip_atomic_load(p, __ATOMIC_RELAXED, __HIP_MEMORY_SCOPE_AGENT); }
__device__ __forceinline__ unsigned xb_add(unsigned* p, unsigned v) { return __hip_atomic_fetch_add(p, v, __ATOMIC_RELAXED, __HIP_MEMORY_SCOPE_AGENT); }
__device__ __forceinline__ unsigned xb_xcc_id() { return (unsigned)__builtin_amdgcn_s_getreg((3 << 11) | 20) & 0xFu; }
#define XB_SPIN(cond, bar) do { unsigned _sp = 0; while (cond) { __builtin_amdgcn_s_sleep(1); \
    if ((++_sp & 255u) == 0u) { if (xb_ld(&(bar)[XB_TMO])) break; if (_sp > XB_SPIN_CAP) { atomicAdd(&(bar)[XB_TMO], 1u); break; } } } } while (0)
struct XcdBarrier { unsigned* bar; unsigned x; volatile LAS unsigned* st; };
__device__ __forceinline__ XcdBarrier xcd_barrier_post(unsigned* bar, volatile LAS unsigned* st) {
    XcdBarrier b; b.bar = bar; b.x = xb_xcc_id(); b.st = st;
    if (threadIdx.x == 0) (void)xb_add(&bar[XB_XCNT(b.x)], 1u);
    return b;
}
__device__ __forceinline__ void xcd_barrier_complete(unsigned* bar, unsigned x, unsigned& nloc, unsigned& nx) {
    const unsigned G = gridDim.x * gridDim.y * gridDim.z;
    unsigned sum, cnt, mine, sp = 0u;
    for (;;) {
        sum = 0u; cnt = 0u; mine = 0u;
#pragma unroll
        for (unsigned j = 0; j < 16; ++j) { const unsigned c = xb_ld(&bar[XB_XCNT(j)]); sum += c; cnt += (c > 0u) ? 1u : 0u; mine = (j == x) ? c : mine; }
        if (sum == G) break;
        __builtin_amdgcn_s_sleep(1);
        if ((++sp & 255u) == 0u) { if (xb_ld(&bar[XB_TMO])) break; if (sp > XB_SPIN_CAP) { atomicAdd(&bar[XB_TMO], 1u); break; } }
    }
    nloc = mine > 0u ? mine : 1u; nx = cnt > 0u ? cnt : 1u;
}
__device__ __forceinline__ void xcd_barrier(const XcdBarrier& b, const int wave) {
    asm volatile("s_waitcnt vmcnt(0)" ::: "memory");
    __syncthreads();
    if (wave == 0 && lane_id_v() == 0) {
        unsigned* bar = b.bar;
        __builtin_amdgcn_s_waitcnt(0);
        unsigned nloc = b.st[0], nx = b.st[1];
        if (nloc == 0u) { xcd_barrier_complete(bar, b.x, nloc, nx); b.st[0] = nloc; b.st[1] = nx; }
        const unsigned old = xb_add(&bar[XB_XSUB(b.x)], 1u);
        const unsigned gen = old / nloc;
        if (old + 1u == (gen + 1u) * nloc) {
            __builtin_amdgcn_fence(__ATOMIC_RELEASE, "agent");
            asm volatile("s_waitcnt vmcnt(0)" ::: "memory");
            const unsigned og = xb_add(&bar[XB_TOP], 1u);
            const unsigned tg = og / nx;
            if (og + 1u == (tg + 1u) * nx) xb_add(&bar[XB_TOPGEN], 1u);
            else XB_SPIN(xb_ld(&bar[XB_TOPGEN]) == tg, bar);
            __builtin_amdgcn_fence(__ATOMIC_ACQUIRE, "agent");
            xb_add(&bar[XB_XGEN(b.x)], 1u);
            asm volatile("s_waitcnt vmcnt(0)" ::: "memory");
        } else {
            XB_SPIN(xb_ld(&bar[XB_XGEN(b.x)]) == gen, bar);
            __builtin_amdgcn_fence(__ATOMIC_ACQUIRE, "agent");
            asm volatile("s_waitcnt vmcnt(0)" ::: "memory");
        }
    }
    __syncthreads();
}

constexpr int RING_BYTES = 131072, MISC_OFF = RING_BYTES + 320, LDS_BYTES = 155648;
static_assert(att::LDS_BYTES <= RING_BYTES, "attention LDS");

struct Args { const void* in[21]; float* out; unsigned char* ws; int ph_lo, ph_hi; };
enum { IN_X = 0, IN_POS, IN_SBG, IN_WQKV, IN_WO, IN_KVG, IN_WDKV, IN_KVLG, IN_WUKV, IN_MLAG, IN_WDQ, IN_QLG, IN_WUQ, IN_WMO, IN_PG, IN_PWQ, IN_PK1, IN_PK2, IN_PU, IN_PV, IN_FG };

template <bool F8 = false>
__device__ __forceinline__ void transpose_item(const float* W, int ldw, int K, int nblk, const float* gain, bf16_t* WT, int row_off, LAS float* scr, int item, int lane) {
    const int kb = item / nblk, nb = item % nblk, k0 = 64 * kb, n0 = 32 * nb;
#pragma unroll 16
    for (int i = 0; i < 32; ++i) { const int kk = 2 * i + (lane >> 5); const float gv = gain ? gain[k0 + kk] : 1.f; scr[kk * 33 + (lane & 31)] = W[(size_t)(k0 + kk) * ldw + n0 + (lane & 31)] * gv; }
    LDS_WAIT(); asm volatile("" ::: "memory");
    const int c = lane & 7;
#pragma unroll
    for (int j = 0; j < 4; ++j) { const int n = (lane >> 3) + 8 * j; const LAS float* s = scr + (8 * c) * 33 + n;
        if constexpr (F8) { u32x2 o; o.x = pk4_fp8(s[0 * 33] * SWT8, s[1 * 33] * SWT8, s[2 * 33] * SWT8, s[3 * 33] * SWT8); o.y = pk4_fp8(s[4 * 33] * SWT8, s[5 * 33] * SWT8, s[6 * 33] * SWT8, s[7 * 33] * SWT8);
            *(u32x2*)((unsigned char*)WT + (size_t)(row_off + n0 + n) * K + k0 + 8 * c) = o; }
        else { u32x4 o; o.x = pk2(s[0 * 33], s[1 * 33]); o.y = pk2(s[2 * 33], s[3 * 33]); o.z = pk2(s[4 * 33], s[5 * 33]); o.w = pk2(s[6 * 33], s[7 * 33]);
            *(u32x4*)(WT + (size_t)(row_off + n0 + n) * K + k0 + 8 * c) = o; } }
    LDS_WAIT(); asm volatile("" ::: "memory");
}

__device__ __forceinline__ void convert_tables8(const float* u, const float* v, const float* g, unsigned char* TU, unsigned char* TV, int gtid, int gthreads) {
    const size_t n32 = (size_t)NEXP * DM / 32;
    for (size_t i = gtid; i < n32; i += gthreads) { const int d = (int)((i * 32) % DM); const size_t e = (i * 32) / DM;
        const size_t dst = ((size_t)(d >> 8) * NEXP + e) * 128 + ((d & 255) >> 1);
        u32x4 w;
#pragma unroll
        for (int k = 0; k < 4; ++k) { const int cb = (k & 1) * 4 + (k >> 1) * 16;
            const f32x4 lo = *(const f32x4*)(u + i * 32 + cb), hi = *(const f32x4*)(u + i * 32 + cb + 8), gl = *(const f32x4*)(g + d + cb), gh = *(const f32x4*)(g + d + cb + 8);
            unsigned wd = 0u;
#pragma unroll
            for (int b = 0; b < 4; ++b) { const unsigned cl = (unsigned)(int)rintf(fminf(fmaxf(lo[b] * gl[b] * SU4 + UOFF, 0.f), 15.f)), ch = (unsigned)(int)rintf(fminf(fmaxf(hi[b] * gh[b] * SU4 + UOFF, 0.f), 15.f));
                wd |= (cl | (ch << 4)) << (8 * b); }
            w[k] = wd; }
        *(u32x4*)(TU + dst) = w;
        u32x4 x;
#pragma unroll
        for (int q = 0; q < 4; ++q) { const f32x4 b0 = *(const f32x4*)(v + i * 32 + q * 8), b1 = *(const f32x4*)(v + i * 32 + q * 8 + 4); unsigned wd = 0u;
#pragma unroll
            for (int b = 0; b < 4; ++b) { const unsigned cc = (unsigned)(int)rintf(fminf(fmaxf(b0[b] * SVQ + UOFF, 0.f), 15.f)), cd = (unsigned)(int)rintf(fminf(fmaxf(b1[b] * SVQ + UOFF, 0.f), 15.f));
                wd |= (cc << (4 * b)) | (cd << (16 + 4 * b)); }
            x[q] = wd; }
        *(u32x4*)(TV + dst) = x; }
}
__device__ __forceinline__ void row_to_bf16_rstd(const float* xrow, bf16_t* orow, float* rstd_out, int lane, unsigned char* x8row = nullptr) {
    f32x4 v[8]; float s = 0.f;
#pragma unroll
    for (int j = 0; j < 8; ++j) { v[j] = *(const f32x4*)(xrow + j * 256 + lane * 4); s += v[j][0] * v[j][0] + v[j][1] * v[j][1] + v[j][2] * v[j][2] + v[j][3] * v[j][3]; }
    s = wave_sum(s);
#pragma unroll
    for (int j = 0; j < 8; ++j) { u32x2 w; w.x = pk2(v[j][0], v[j][1]); w.y = pk2(v[j][2], v[j][3]); *(u32x2*)(orow + j * 256 + lane * 4) = w;
        if (x8row) *(unsigned*)(x8row + j * 256 + lane * 4) = pk4_fp8(v[j][0] * SX8, v[j][1] * SX8, v[j][2] * SX8, v[j][3] * SX8); }
    if (lane == 0) *rstd_out = 1.f / sqrtf(s * (1.f / DM) + EPS);
}

template <int CTRL> __device__ __forceinline__ unsigned dpp_u32(unsigned x) { return (unsigned)__builtin_amdgcn_update_dpp(0, (int)x, CTRL, 0xF, 0xF, false); }
template <int CTRL> __device__ __forceinline__ float dpp_f32(float x) { return __int_as_float(__builtin_amdgcn_update_dpp(0, __float_as_int(x), CTRL, 0xF, 0xF, false)); }
__device__ __forceinline__ unsigned umax(unsigned a, unsigned b) { return a > b ? a : b; }
__device__ __forceinline__ unsigned umin(unsigned a, unsigned b) { return a < b ? a : b; }
__device__ __forceinline__ unsigned row_allmax(unsigned x) { x = umax(x, dpp_u32<0xB1>(x)); x = umax(x, dpp_u32<0x4E>(x)); x = umax(x, dpp_u32<0x124>(x)); x = umax(x, dpp_u32<0x128>(x)); return x; }
__device__ __forceinline__ float row_allsum(float x) { x += dpp_f32<0xB1>(x); x += dpp_f32<0x4E>(x); x += dpp_f32<0x124>(x); x += dpp_f32<0x128>(x); return x; }


__device__ __forceinline__ void row_bf16_to_rstd_x8(const bf16_t* xrow, float* rstd_out, int lane, unsigned char* x8row, float* xsum_out) {
    float s = 0.f, sx = 0.f;
#pragma unroll
    for (int j = 0; j < 4; ++j) { const u32x4 w = *(const u32x4*)(xrow + j * 512 + lane * 8);
        const float v0 = bflo(w.x), v1 = bfhi(w.x), v2 = bflo(w.y), v3 = bfhi(w.y), v4 = bflo(w.z), v5 = bfhi(w.z), v6 = bflo(w.w), v7 = bfhi(w.w);
        s += v0 * v0 + v1 * v1 + v2 * v2 + v3 * v3 + v4 * v4 + v5 * v5 + v6 * v6 + v7 * v7;
        u32x2 o; o.x = pk4_fp8(v0 * SX8, v1 * SX8, v2 * SX8, v3 * SX8); o.y = pk4_fp8(v4 * SX8, v5 * SX8, v6 * SX8, v7 * SX8); *(u32x2*)(x8row + j * 512 + lane * 8) = o;
        const auto d0 = __builtin_amdgcn_cvt_pk_f32_fp8((int)o.x, false), d1 = __builtin_amdgcn_cvt_pk_f32_fp8((int)o.x, true), d2 = __builtin_amdgcn_cvt_pk_f32_fp8((int)o.y, false), d3 = __builtin_amdgcn_cvt_pk_f32_fp8((int)o.y, true);
        sx += ((d0[0] + d0[1]) + (d1[0] + d1[1])) + ((d2[0] + d2[1]) + (d3[0] + d3[1])); }
    s = wave_sum(s); sx = wave_sum(sx);
    if (lane == 0) { *rstd_out = 1.f / sqrtf(s * (1.f / DM) + EPS); *xsum_out = sx; }
}
template <int layer>
__device__ __forceinline__ void peer_gather(LAS unsigned char* lds, unsigned char* ws, float* X, bf16_t* XS, float* rstd, const float* fg, const int wave, const int lane, const int bx, unsigned long long& tp0, unsigned long long& tp1) {
    constexpr int GOFF = 0, GPW = 65536, GSS = 131072 + 1024;
    const unsigned char* TU = ws + WS_TU8 + (size_t)layer * 64 * MiB; const unsigned char* TV = ws + WS_TV8 + (size_t)layer * 64 * MiB; const unsigned char* X8 = ws + WS_X8;
    const int* IDS = (const int*)(ws + WS_IDS); const float* GT = (const float*)(ws + WS_GATE);
    const int tw0 = wave * 16, t0 = bx * 128;
#pragma unroll
    for (int tt = 0; tt < 16; ++tt) { const int tl = tw0 + tt; const size_t t = (size_t)(t0 + tl);
#pragma unroll
        for (int k = 0; k < 2; ++k) { const int p = lane + 64 * k; const int id = IDS[t * NSEL + p];
            *(LAS unsigned*)(lds + GOFF + (tl * 128 + p) * 4) = (unsigned)id * 128u; *(LAS float*)(lds + GPW + (tl * 128 + p) * 4) = 0.f; }
        if (lane < 8) *(LAS float*)(lds + GSS + (tl * 8 + lane) * 4) = 0.f; }
    LDS_WAIT();
    if (PROBE_SUB == 1 && layer == 1) tp0 = __builtin_amdgcn_s_memrealtime();
    constexpr size_t SLAB = (size_t)NEXP * 128;
    struct USet { u32x4 ua[16], h0, h1; };
    {
        const int r = lane & 15, q = lane >> 4;
#define U_ISSUE(S_, n_) do { const int kc_ = (n_) >> 4, tl_ = tw0 + ((n_) & 15); const unsigned char* slab_ = TU + (size_t)kc_ * SLAB; const unsigned lo_ = (unsigned)((r & 1) * 64 + q * 16);               \
            { const unsigned char* xp_ = X8 + (size_t)(t0 + tl_) * DM + kc_ * 256 + (r >> 3) * 128 + q * 32; S_.h0 = *(const u32x4*)xp_; S_.h1 = *(const u32x4*)(xp_ + 16); }            \
            _Pragma("unroll") for (int G_ = 0; G_ < 16; ++G_) S_.ua[G_] = *(const u32x4*)(slab_ + (size_t)(*(LAS unsigned*)(lds + GOFF + (tl_ * 128 + G_ * 8 + (r >> 1)) * 4) + lo_)); } while (0)
#define U64(v_, a_, b_) ((long)(((unsigned long long)(v_).b_ << 32) | (v_).a_))
#define UPK(lo_, hi_) ((long)(((unsigned long long)(hi_) << 32) | (lo_)))
        constexpr unsigned NM = 0x0F0F0F0Fu;
#define U_COMPUTE(S_, n_) do { const int tl_ = tw0 + ((n_) & 15);                                                                                                                  \
            _Pragma("unroll") for (int hg = 0; hg < 2; ++hg) { f32x2 sel_ = {0.f, 0.f};                                                                                             \
                _Pragma("unroll") for (int g8 = 0; g8 < 8; ++g8) { f32x4 c = {0.f, 0.f, 0.f, 0.f};                                                                                  \
                    const u32x4 X_ = S_.ua[hg * 8 + g8];                                                                                                                           \
                    c = __builtin_amdgcn_mfma_f32_16x16x32_fp8_fp8(UPK(X_.x & NM, X_.y & NM), U64(S_.h0, x, y), c, 0, 0, 0); c = __builtin_amdgcn_mfma_f32_16x16x32_fp8_fp8(UPK((X_.x >> 4) & NM, (X_.y >> 4) & NM), U64(S_.h0, z, w), c, 0, 0, 0); \
                    c = __builtin_amdgcn_mfma_f32_16x16x32_fp8_fp8(UPK(X_.z & NM, X_.w & NM), U64(S_.h1, x, y), c, 0, 0, 0); c = __builtin_amdgcn_mfma_f32_16x16x32_fp8_fp8(UPK((X_.z >> 4) & NM, (X_.w >> 4) & NM), U64(S_.h1, z, w), c, 0, 0, 0); \
                    const float c0 = c[0] + dpp_f32<0x128>(c[1]), c1 = c[2] + dpp_f32<0x128>(c[3]); const bool pick = (r == g8); sel_[0] = pick ? c0 : sel_[0]; sel_[1] = pick ? c1 : sel_[1]; } \
                if (r < 8) { LAS f32x2* p = (LAS f32x2*)(lds + GPW + (tl_ * 128 + (hg * 8 + r) * 8 + 2 * q) * 4); f32x2 v0 = *p; v0 += sel_; *p = v0; } } } while (0)
        USet A, B;
        U_ISSUE(A, 0);
#pragma unroll 1
        for (int n = 0; n < 128; n += 2) {
            U_ISSUE(B, n + 1);
            U_COMPUTE(A, n);
            { const int nn = n + 2 < 128 ? n + 2 : 126; U_ISSUE(A, nn); }
            U_COMPUTE(B, n + 1);
        }
#undef U_ISSUE
#undef U_COMPUTE
#undef U64
#undef UPK
    }
    LDS_WAIT();
    if (PROBE_SUB == 1 && layer == 1) { __syncthreads(); tp1 = __builtin_amdgcn_s_memrealtime(); }
    constexpr int GW8 = 137216, GWS = 153600;
#pragma unroll 4
    for (int tt = 0; tt < 16; ++tt) { const int tl = tw0 + tt; const size_t t = (size_t)(t0 + tl); const float rs = rstd[t] * (1.f / (SU4 * SX8)), xoff = UOFF * ((const float*)(ws + WS_XSUM))[t];
        float wsa = 0.f;
#pragma unroll
        for (int k = 0; k < 2; ++k) { const int p = lane + 64 * k;
            const float dd = (*(LAS float*)(lds + GPW + (tl * 128 + p) * 4) * 512.f - xoff) * rs;
            const float wv = GT[t * NSEL + p] * 0.5f * dd * (1.f + erff(dd * 0.7071067811865476f)) * SW8;
            const int b8 = __builtin_amdgcn_cvt_pk_fp8_f32(wv, 0.f, 0, false) & 0xff; wsa += __builtin_amdgcn_cvt_f32_fp8(b8, 0);
            const int gq = p >> 4, ii = p & 15;
            *(LAS unsigned char*)(lds + GW8 + tl * 128 + (ii >> 2) * 32 + (ii & 3) * 8 + gq) = (unsigned char)b8; }
        wsa = wave_sum(wsa); if (lane == 0) *(LAS float*)(lds + GWS + tl * 4) = wsa; }
    LDS_WAIT();
    struct VSet { u32x4 vv[16]; };
    {
        const int g = lane >> 3, sub = lane & 7, q4 = lane >> 4, n16 = lane & 15, r8 = n16 >> 1, c2 = lane & 1;
        const int sb = GPW + wave * 8192;
        const int wa = sb + g * 128 + ((sub ^ g) << 4);
        int ta[8];
#pragma unroll
        for (int cb = 0; cb < 8; ++cb) ta[cb] = sb + (8 * q4 + r8) * 128 + ((cb ^ r8) << 4) + 8 * c2;
        constexpr unsigned NM = 0x0F0F0F0Fu;
#define UPK(lo_, hi_) ((long)(((unsigned long long)(hi_) << 32) | (lo_)))
#define V_ISSUE(S_, n_) do { const int dc_ = (n_) >> 4, tl_ = tw0 + ((n_) & 15); const unsigned char* slab_ = TV + (size_t)dc_ * SLAB; u32x4 of_[4];     \
            _Pragma("unroll") for (int z = 0; z < 4; ++z) of_[z] = *(LAS u32x4*)(lds + GOFF + (tl_ * 128 + g * 16 + z * 4) * 4); \
            _Pragma("unroll") for (int i = 0; i < 16; ++i) S_.vv[i] = *(const u32x4*)(slab_ + (size_t)(of_[i >> 2][i & 3] + (unsigned)(sub * 16))); } while (0)
#define V_XADDR(n_) (XS + (size_t)(t0 + tw0 + ((n_) & 15)) * DM + ((n_) >> 4) * 256 + 64 * q4 + 2 * n16)
#define V_COMPUTE(S_, n_, XA_, XB_) do { const int tl_ = tw0 + ((n_) & 15); f32x4 acl[8], ach[8];                                                                               \
            _Pragma("unroll") for (int c = 0; c < 8; ++c) { acl[c] = (f32x4){0.f, 0.f, 0.f, 0.f}; ach[c] = (f32x4){0.f, 0.f, 0.f, 0.f}; }                                           \
            _Pragma("unroll") for (int kb = 0; kb < 4; ++kb) { const int bo_ = (kb & 1) * 4096;                                                                                     \
                _Pragma("unroll") for (int ii = 0; ii < 4; ++ii) *(LAS u32x4*)(lds + wa + bo_ + ii * 1024) = S_.vv[4 * kb + ii];                                                    \
                const long aw_ = *(const LAS long*)(lds + GW8 + tl_ * 128 + kb * 32 + q4 * 8);                                                                                       \
                _Pragma("unroll") for (int cb = 0; cb < 8; ++cb) { const auto B_ = __builtin_amdgcn_ds_read_tr8_b64_v2i32((LAS i32x2v*)(lds + ta[cb] + bo_));                      \
                    const unsigned bx_ = (unsigned)B_[0], by_ = (unsigned)B_[1];                                                                                                    \
                    acl[cb] = __builtin_amdgcn_mfma_f32_16x16x32_fp8_fp8(aw_, UPK(bx_ & NM, by_ & NM), acl[cb], 0, 0, 0);                                                            \
                    ach[cb] = __builtin_amdgcn_mfma_f32_16x16x32_fp8_fp8(aw_, UPK((bx_ >> 4) & NM, (by_ >> 4) & NM), ach[cb], 0, 0, 0); } }                                          \
            { const float wof_ = UOFF * *(LAS float*)(lds + GWS + tl_ * 4);                                                                                                         \
                const float a0 = q4 == 0 ? acl[0][0] : q4 == 1 ? acl[2][0] : q4 == 2 ? acl[4][0] : acl[6][0], a1 = q4 == 0 ? ach[0][0] : q4 == 1 ? ach[2][0] : q4 == 2 ? ach[4][0] : ach[6][0]; \
                const float a2 = q4 == 0 ? acl[1][0] : q4 == 1 ? acl[3][0] : q4 == 2 ? acl[5][0] : acl[7][0], a3 = q4 == 0 ? ach[1][0] : q4 == 1 ? ach[3][0] : q4 == 2 ? ach[5][0] : ach[7][0]; \
                constexpr float SC_ = 1.f / (SW8 * SVQ);                                                                                                                            \
                const unsigned xa_ = XA_, xb_ = XB_; bf16_t* xp_ = V_XADDR(n_);                                                                                                     \
                const unsigned w0_ = cvtpk(bflo(xa_) + (a0 * 512.f - wof_) * SC_, bfhi(xa_) + (a1 * 512.f - wof_) * SC_), w1_ = cvtpk(bflo(xb_) + (a2 * 512.f - wof_) * SC_, bfhi(xb_) + (a3 * 512.f - wof_) * SC_); \
                *(unsigned*)xp_ = w0_; *(unsigned*)(xp_ + 32) = w1_;                                                                                                                \
                if (layer == 0) { unsigned char* x8_ = (unsigned char*)X8 + (xp_ - XS);     \
                    *(unsigned short*)x8_ = (unsigned short)__builtin_amdgcn_cvt_pk_fp8_f32(bflo(w0_) * SX8, bfhi(w0_) * SX8, 0, false); *(unsigned short*)(x8_ + 32) = (unsigned short)__builtin_amdgcn_cvt_pk_fp8_f32(bflo(w1_) * SX8, bfhi(w1_) * SX8, 0, false); } \
                const float y0 = bflo(w0_), y1 = bfhi(w0_), y2 = bflo(w1_), y3 = bfhi(w1_);                    \
                const float ssq = row_allsum(y0 * y0 + y1 * y1 + y2 * y2 + y3 * y3);                                                                                                \
                if (n16 == 0) { LAS float* sp = (LAS float*)(lds + GSS + (tl_ * 8 + q4) * 4); *sp += ssq; } } } while (0)
        VSet A, B;
        V_ISSUE(A, 0);
#pragma unroll 1
        for (int n = 0; n < 128; n += 2) {
            const unsigned xa0 = *(const unsigned*)V_XADDR(n), xa1 = *(const unsigned*)(V_XADDR(n) + 32);
            V_ISSUE(B, n + 1);
            V_COMPUTE(A, n, xa0, xa1);
            const unsigned xb0 = *(const unsigned*)V_XADDR(n + 1), xb1 = *(const unsigned*)(V_XADDR(n + 1) + 32);
            { const int nn = n + 2 < 128 ? n + 2 : 126; V_ISSUE(A, nn); }
            V_COMPUTE(B, n + 1, xb0, xb1);
        }
#undef V_ISSUE
#undef V_COMPUTE
#undef V_XADDR
#undef UPK
    }
    LDS_WAIT(); VM_WAIT();
    if (PROBE_SUB == 2 && layer == 1) { __syncthreads(); tp1 = __builtin_amdgcn_s_memrealtime(); }
#pragma unroll 2
    for (int tt = 0; tt < 16; ++tt) { const int tl = tw0 + tt; const size_t t = (size_t)(t0 + tl);
        float ss = (lane < 8) ? *(LAS float*)(lds + GSS + (tl * 8 + lane) * 4) : 0.f; ss = wave_sum(ss);
        const float rn = 1.f / sqrtf(ss * (1.f / DM) + EPS);
        if (layer == 0) { if (lane == 0) rstd[t] = rn; }
        else {
#pragma unroll
            for (int j = 0; j < 4; ++j) { const u32x4 w = __builtin_nontemporal_load((const u32x4*)(XS + t * DM + j * 512 + lane * 8)); const float* gp = fg + j * 512 + lane * 8; const f32x4 g0 = *(const f32x4*)gp, g1 = *(const f32x4*)(gp + 4);
                float* xr = X + t * DM + j * 512 + lane * 8;
                *(f32x4*)xr = (f32x4){bflo(w.x) * rn * g0[0], bfhi(w.x) * rn * g0[1], bflo(w.y) * rn * g0[2], bfhi(w.y) * rn * g0[3]};
                *(f32x4*)(xr + 4) = (f32x4){bflo(w.z) * rn * g1[0], bfhi(w.z) * rn * g1[1], bflo(w.w) * rn * g1[2], bfhi(w.w) * rn * g1[3]}; } }
    }
}

__device__ __forceinline__ unsigned f2ord(float f) { unsigned u = __float_as_uint(f); return u ^ ((u >> 31) ? 0xffffffffu : 0x80000000u); }
__device__ __forceinline__ float ord2f(unsigned u) { return __uint_as_float(u ^ ((u >> 31) ? 0x80000000u : 0xffffffffu)); }
__device__ __forceinline__ void peer_topk(const _Float16* SC, int* IDS, float* GT, const int lane, const int wave, const int G, const int bx) {
    pg8::StaticOrder SO; SO.init(T, DM, G, bx);
    const int l16 = lane & 15, row = (lane >> 4) & 1, L = lane & 31, base32 = lane & 32;
    int ci[2], cj[2]; bool cv[2];
#pragma unroll
    for (int sl = 0; sl < 2; ++sl) { const int n = L + 32 * sl; int i_, j_; bool v = true;
        if (n < 16) { i_ = 0; j_ = n; } else if (n < 24) { i_ = 1; j_ = n - 16; } else if (n < 29) { i_ = 2; j_ = n - 24; } else if (n < 33) { i_ = 3; j_ = n - 29; }
        else if (n < 36) { i_ = 4; j_ = n - 33; } else if (n < 42) { i_ = 5 + ((n - 36) >> 1); j_ = (n - 36) & 1; } else if (n < 50) { i_ = 8 + (n - 42); j_ = 0; } else { i_ = 15; j_ = 15; v = false; }
        ci[sl] = i_; cj[sl] = j_; cv[sl] = v; }
    pg8::Unit un;
    constexpr int NI = 8;
    for (int ui = 0; SO.next(ui, un); ++ui)
    for (int pr = wave * NI; pr < 128; pr += NWAVES * NI) {
        const int hh = un.pn; int t[NI]; unsigned k[NI][8], mine[NI], kc[NI][2], mysel[NI];
#pragma unroll
        for (int u = 0; u < NI; ++u) { t[u] = un.pm * 256 + (pr + u) * 2 + (lane >> 5);
            typedef _Float16 h8 __attribute__((ext_vector_type(8)));
            const h8 a0 = *(const h8*)(SC + (size_t)t[u] * DM + hh * 256 + row * 128 + l16 * 8);
#pragma unroll
            for (int e = 0; e < 8; ++e) { const float v = (float)a0[e]; k[u][e] = (f2ord(v) & ~127u) | (unsigned)(127 - (l16 * 8 + e)); } }
#define CE(a, b) do { _Pragma("unroll") for (int u = 0; u < NI; ++u) { const unsigned hi_ = umax(k[u][a], k[u][b]), lo_ = umin(k[u][a], k[u][b]); k[u][a] = hi_; k[u][b] = lo_; } } while (0)
        CE(0, 1); CE(2, 3); CE(4, 5); CE(6, 7); CE(0, 2); CE(1, 3); CE(4, 6); CE(5, 7); CE(1, 2); CE(5, 6);
        CE(0, 4); CE(1, 5); CE(2, 6); CE(3, 7); CE(2, 4); CE(3, 5); CE(1, 2); CE(3, 4); CE(5, 6);
#undef CE
#pragma unroll
        for (int u = 0; u < NI; ++u) mine[u] = 0u;
#pragma unroll 4
        for (int it = 0; it < TOPK; ++it) {
#pragma unroll
            for (int u = 0; u < NI; ++u) { const unsigned m = row_allmax(k[u][0]); if (l16 == it) mine[u] = m;
                if (k[u][0] == m) { k[u][0] = k[u][1]; k[u][1] = k[u][2]; k[u][2] = k[u][3]; k[u][3] = k[u][4]; k[u][4] = k[u][5]; k[u][5] = k[u][6]; k[u][6] = k[u][7]; k[u][7] = 0u; } } }
#pragma unroll
        for (int u = 0; u < NI; ++u) { mysel[u] = 0u;
#pragma unroll
            for (int sl = 0; sl < 2; ++sl) { const unsigned k1 = (unsigned)__shfl((int)mine[u], base32 + ci[sl]), k2 = (unsigned)__shfl((int)mine[u], base32 + 16 + cj[sl]);
                const float sum = ord2f(k1 & ~127u) + ord2f(k2 & ~127u);
                kc[u][sl] = cv[sl] ? ((f2ord(sum) & ~255u) | (unsigned)(255 - (ci[sl] * 16 + cj[sl]))) : 0u; } }
#pragma unroll 4
        for (int it = 0; it < TOPK; ++it) {
#pragma unroll
            for (int u = 0; u < NI; ++u) { unsigned m = row_allmax(umax(kc[u][0], kc[u][1]));
                { auto rr = __builtin_amdgcn_permlane16_swap(m, m, false, false); m = umax(rr[0], rr[1]); }
                if (L == it) mysel[u] = m; if (kc[u][0] == m) kc[u][0] = 0u; if (kc[u][1] == m) kc[u][1] = 0u; } }
#pragma unroll
        for (int u = 0; u < NI; ++u) {
            const int cidx = 255 - (int)(mysel[u] & 255u), si = (cidx >> 4) & 15, sj = cidx & 15;
            const unsigned k1 = (unsigned)__shfl((int)mine[u], base32 + si), k2 = (unsigned)__shfl((int)mine[u], base32 + 16 + sj);
            const int i1 = 127 - (int)(k1 & 127u), i2 = 127 - (int)(k2 & 127u);
            const _Float16* sb = SC + (size_t)t[u] * DM + hh * 256;
            float sc = 0.f; if (L < TOPK) sc = (float)sb[i1] + (float)sb[128 + i2];
            const float smax = __shfl(sc, base32);
            const float e = (L < TOPK) ? __expf(sc - smax) : 0.f;
            const float den = row_allsum(e);
            if (L < TOPK) { IDS[(size_t)t[u] * NSEL + hh * TOPK + L] = i1 * NKEYS + i2; GT[(size_t)t[u] * NSEL + hh * TOPK + L] = e / den; } }
    }
}

#ifndef PH_MASK
#define PH_MASK 0xFFFFFu
#endif
#define IN(k) (lo <= (k) && (k) < hi)
#define SITE(b) (((PH_MASK) >> (b)) & 1u)
#ifndef REP_MASK
#define REP_MASK 0u
#endif
#define REPS(b) for (int rep_ = 0; rep_ < ((((REP_MASK) >> (b)) & 1u) ? 3 : 1); ++rep_)
#define STAMP(k) do { if (PROBE_HI == (k)) tp1 = __builtin_amdgcn_s_memrealtime(); if (PROBE_LO == (k) + 1) tp0 = __builtin_amdgcn_s_memrealtime(); } while (0)
#define SEAM(k) do { if (IN(k) && IN((k) + 1)) xcd_barrier(bar, wave); STAMP(k); } while (0)
#define LOCAL_SEAM(k) do { if (IN(k) && IN((k) + 1)) { asm volatile("s_waitcnt vmcnt(0)" ::: "memory"); __syncthreads(); } STAMP(k); } while (0)
#define PH_LOCALS const __attribute__((address_space(4))) Args* A_ = (const __attribute__((address_space(4))) Args*)__builtin_amdgcn_kernarg_segment_ptr(); asm volatile("" : "+s"(A_)); \
    unsigned char* ws = A_->ws; float* X = A_->out; float* rstd = (float*)(ws + WS_RSTD); float* cs = (float*)(ws + WS_CS); bf16_t* XB = (bf16_t*)(ws + WS_XB); bf16_t* XS = (bf16_t*)(ws + WS_XS); const float* x_in = (const float*)A_->in[IN_X]; \
    const int lane = lane_id_v(), tid = wave * 64 + lane, gw = bx * NWAVES + wave, NGW = G * NWAVES, gtid = bx * NTHR + tid, gthreads = G * NTHR; \
    (void)X; (void)rstd; (void)cs; (void)XB; (void)XS; (void)x_in; (void)lane; (void)tid; (void)gw; (void)NGW; (void)gtid; (void)gthreads
#define AIN(k) (A_->in[k])

template <int layer>
__device__ __forceinline__ void peer_phases(LAS unsigned char* lds, const int lo, const int hi, const XcdBarrier& bar, const int wave, const int G, const int bx, unsigned long long& tp0, unsigned long long& tp1) {
    constexpr int pb = layer ? 15 : 4;
        if (SITE(4) && IN(pb)) REPS(4) { PH_LOCALS;
            for (int m = gw; m < T; m += NGW) row_bf16_to_rstd_x8(XS + (size_t)m * DM, rstd + m, lane, ws + WS_X8 + (size_t)m * DM, (float*)(ws + WS_XSUM) + m);
        }
        SEAM(pb);
        if (SITE(5) && IN(pb + 1)) REPS(5) { PH_LOCALS;
            if constexpr (layer == 1) {
                pg8::Gemm g{(const bf16_t*)(ws + WS_X8), (const bf16_t*)(ws + WS_WST) + (size_t)DM * DM, T, DM, DM / 2, DM / 2, 0}; pg8::StaticOrder S; S.init(T, DM, G, bx);
                pg8::EpiF16 E{(_Float16*)(ws + WS_SC), DM, rstd, 1.f / (SX8 * SWT8)};
                pg8::gemm_phase<pg8::EpiF16, true>(lds, g, S, E, wave, lane);
            } else {
            pg8::Gemm g{XS, (const bf16_t*)(ws + WS_WST) + (size_t)layer * DM * DM, T, DM, DM, DM, 0}; pg8::StaticOrder S; S.init(T, DM, G, bx);
            pg8::EpiF16 E{(_Float16*)(ws + WS_SC), DM, rstd};
            pg8::gemm_phase<pg8::EpiF16>(lds, g, S, E, wave, lane); }
        }
        LOCAL_SEAM(pb + 1);
        LOCAL_SEAM(pb + 2);
        if (SITE(7) && IN(pb + 3)) REPS(7) { PH_LOCALS;
            peer_topk((const _Float16*)(ws + WS_SC), (int*)(ws + WS_IDS), (float*)(ws + WS_GATE), lane, wave, G, bx);
        }
        SEAM(pb + 3);
        if (SITE(8) && IN(pb + 4)) REPS(8) { PH_LOCALS;
            if (bx < 256) peer_gather<layer>(lds, ws, X, XS, rstd, (const float*)AIN(IN_FG), wave, lane, bx, tp0, tp1);
        }
}

__global__ void __launch_bounds__(NTHR, 2) fwd(Args args) {
    extern __shared__ __attribute__((aligned(16))) unsigned char lds_raw[];
    LAS unsigned char* lds = (LAS unsigned char*)lds_raw;
    volatile LAS unsigned* MISC = (volatile LAS unsigned*)(lds + MISC_OFF);
    const int wave = __builtin_amdgcn_readfirstlane(threadIdx.x >> 6);
    const int G = gridDim.x, bx = blockIdx.x;
    unsigned* ctl = (unsigned*)(args.ws + WS_CTL);
    for (int u = threadIdx.x; u < (LDS_BYTES - RING_BYTES) / 4; u += NTHR) ((LAS unsigned*)(lds + RING_BYTES))[u] = 0u;
    __syncthreads();
    XcdBarrier bar; bar.bar = ctl + CW_BAR; bar.x = 0; bar.st = nullptr;
    const int lo = args.ph_lo, hi = args.ph_hi;
    const bool multi = (hi - lo) > 1;
    if (multi) bar = xcd_barrier_post(ctl + CW_BAR, MISC + 8);
    unsigned long long tp0 = 0ull, tp1 = 0ull; if (PROBE_LO == 0) tp0 = __builtin_amdgcn_s_memrealtime();

    if (SITE(0) && IN(0)) REPS(0) { PH_LOCALS;
        LAS float* scr = (LAS float*)(lds + wave * 16384);
        const float* sbg = (const float*)AIN(IN_SBG); const float* kvg = (const float*)AIN(IN_KVG); const float* mlag = (const float*)AIN(IN_MLAG);
        const float* kvlg = (const float*)AIN(IN_KVLG); const float* qlg = (const float*)AIN(IN_QLG); const float* pg = (const float*)AIN(IN_PG);
        constexpr int I_QKV = 32 * 192, I_WO = 32 * 64, I_DKV = 32 * 18, I_DQ = 32 * 16, I_UKV = 8 * 128, I_UQ = 8 * 96, I_MO = 32 * 64, I_PQ = 32 * 64;
        constexpr int NITEMS = I_QKV + I_WO + I_DKV + I_DQ + I_UKV + I_UQ + I_MO; (void)I_PQ;
        for (int it = gw; it < NITEMS; it += NGW) {
            int r = it;
            if (r < I_QKV) { transpose_item((const float*)AIN(IN_WQKV), 6144, 2048, 192, sbg, (bf16_t*)(ws + WS_WQKV), 0, scr, r, lane); continue; } r -= I_QKV;
            if (r < I_WO) { transpose_item((const float*)AIN(IN_WO), 2048, 2048, 64, nullptr, (bf16_t*)(ws + WS_WO), 0, scr, r, lane); continue; } r -= I_WO;
            if (r < I_DKV) { transpose_item<true>((const float*)AIN(IN_WDKV), 576, 2048, 18, kvg, (bf16_t*)(ws + WS_WDKQ), 0, scr, r, lane); continue; } r -= I_DKV;
            if (r < I_DQ) { transpose_item<true>((const float*)AIN(IN_WDQ), 512, 2048, 16, mlag, (bf16_t*)(ws + WS_WDKQ), 576, scr, r, lane); continue; } r -= I_DQ;
            if (r < I_UKV) { transpose_item<true>((const float*)AIN(IN_WUKV), 4096, 512, 128, kvlg, (bf16_t*)(ws + WS_WUKV), 0, scr, r, lane); continue; } r -= I_UKV;
            if (r < I_UQ) { transpose_item<true>((const float*)AIN(IN_WUQ), 3072, 512, 96, qlg, (bf16_t*)(ws + WS_WUQ), 0, scr, r, lane); continue; } r -= I_UQ;
            transpose_item<true>((const float*)AIN(IN_WMO), 2048, 2048, 64, nullptr, (bf16_t*)(ws + WS_WMO), 0, scr, r, lane);
            (void)pg;
        }
        { u32x4 z = {0u, 0u, 0u, 0u}; unsigned char* p = ws + WS_WDKQ + (size_t)1088 * DM; for (int i = gtid; i < 192 * DM / 16; i += gthreads) *(u32x4*)(p + (size_t)i * 16) = z; }
        { const float* k1 = (const float*)AIN(IN_PK1); const float* k2 = (const float*)AIN(IN_PK2); bf16_t* kbd = (bf16_t*)(ws + WS_KBD);
          for (int i = gtid; i < 2 * 2048 * 256; i += gthreads) { const int kk = i & 255, n = (i >> 8) & 255, hh = (i >> 16) & 7, l = i >> 19; float v = 0.f;
              if (n < 128) { if (kk < 128) v = k1[(((size_t)l * PH + hh) * NKEYS + n) * 128 + kk]; } else { if (kk >= 128) v = k2[(((size_t)l * PH + hh) * NKEYS + (n - 128)) * 128 + (kk - 128)]; }
              kbd[i] = (bf16_t)f2bf(v); } }
        { const float* wq = (const float*)AIN(IN_PWQ); bf16_t* wqg = (bf16_t*)(ws + WS_WPQ);
          for (size_t i = gtid; i < (size_t)2 * DM * DM / 8; i += gthreads) { const int l = (int)(i / ((size_t)DM * DM / 8)), k = (int)((i * 8 / DM) % DM); const float gk = pg[l * DM + k];
              const f32x4 a0 = *(const f32x4*)(wq + i * 8), a1 = *(const f32x4*)(wq + i * 8 + 4); u32x4 w; w.x = pk2(a0[0] * gk, a0[1] * gk); w.y = pk2(a0[2] * gk, a0[3] * gk); w.z = pk2(a1[0] * gk, a1[1] * gk); w.w = pk2(a1[2] * gk, a1[3] * gk);
              *(u32x4*)(wqg + i * 8) = w; } }
        convert_tables8((const float*)AIN(IN_PU), (const float*)AIN(IN_PV), pg, ws + WS_TU8, ws + WS_TV8, gtid, gthreads);
        convert_tables8((const float*)AIN(IN_PU) + (size_t)NEXP * DM, (const float*)AIN(IN_PV) + (size_t)NEXP * DM, pg + DM, ws + WS_TU8 + 64 * MiB, ws + WS_TV8 + 64 * MiB, gtid, gthreads);
        for (int m = gw; m < T; m += NGW) row_to_bf16_rstd(x_in + (size_t)m * DM, XB + (size_t)m * DM, rstd + m, lane);
        { const int* pos = (const int*)AIN(IN_POS);
          for (int i = gtid; i < T * 32; i += gthreads) { const int t = i >> 5, j = i & 31; const float inv = powf(10000.f, -(float)(2 * j) / 64.f); const float ang = (float)pos[t] * inv;
              cs[2 * i] = cosf(ang); cs[2 * i + 1] = sinf(ang); } }
    }
    if (SITE(0) && IN(0)) { if (multi) xcd_barrier(bar, wave);
        PH_LOCALS;
        { pg8::Gemm g{(const bf16_t*)(ws + WS_KBD), (const bf16_t*)(ws + WS_WPQ), DM, DM, 256, 256, 0, DM, 256};
            pg8::StaticOrder S; S.init(DM, DM, G, bx); pg8::EpiB16 E{(bf16_t*)(ws + WS_WST), DM, nullptr};
            pg8::gemm_phase<pg8::EpiB16>(lds, g, S, E, wave, lane); }
        { pg8::Gemm g{(const bf16_t*)(ws + WS_KBD) + (size_t)2048 * 256, (const bf16_t*)(ws + WS_WPQ) + (size_t)DM * DM, DM, DM, 256, 256, 0, DM, 256};
            pg8::StaticOrder S; S.init(DM, DM, G, bx); pg8::EpiF8 E{ws + WS_WST + (size_t)DM * DM * 2, DM, SWT8};
            pg8::gemm_phase<pg8::EpiF8>(lds, g, S, E, wave, lane); } }
    SEAM(0);

    {
        {
            if (SITE(1) && IN(1)) REPS(1) { PH_LOCALS;
                pg8::Gemm g{XB, (const bf16_t*)(ws + WS_WQKV), T, 3 * DM, DM, DM, 0}; pg8::StaticOrder S; S.init(T, 3 * DM, G, bx);
                pg8::EpiQKV E{(bf16_t*)(ws + WS_Q), (size_t)(WS_K - WS_Q) / 2, rstd, 0.08838834764831845f * LOG2E};
                pg8::gemm_phase<pg8::EpiQKV>(lds, g, S, E, wave, lane);
            }
            SEAM(1);
            if (SITE(2) && IN(2)) REPS(2) { PH_LOCALS;
                const int bh = bx >> 1, half = bx & 1, b = bh >> 4, h = bh & 15;
                if (bx < 256) {
                    const bf16_t* Qp = (const bf16_t*)(ws + WS_Q) + (size_t)b * SEQ * DM + h * HD; const bf16_t* Kp = (const bf16_t*)(ws + WS_K) + (size_t)b * SEQ * DM + h * HD;
                    const bf16_t* Vp = (const bf16_t*)(ws + WS_V) + (size_t)b * SEQ * DM + h * HD; bf16_t* Op = XB + (size_t)b * SEQ * DM + h * HD;
                    for (int i = 0; i < 8; ++i) { const int qb = 15 - (2 * i + ((i & 1) ^ half));
                        att::attn_unit<0>(lds, Qp, DM, Kp, Vp, DM, nullptr, nullptr, Op, DM, qb * 256, wave, lane); }
                }
            }
            SEAM(2);
            if (SITE(3) && IN(3)) REPS(3) { PH_LOCALS;
                pg8::Gemm g{XB, (const bf16_t*)(ws + WS_WO), T, DM, DM, DM, 0}; pg8::StaticOrder S; S.init(T, DM, G, bx);
                pg8::EpiResB<true> E{XS, x_in};
                pg8::gemm_phase<pg8::EpiResB<true>>(lds, g, S, E, wave, lane);
            }
            SEAM(3);
        }
        peer_phases<0>(lds, lo, hi, bar, wave, G, bx, tp0, tp1);
        SEAM(8);
        {
            if (SITE(9) && IN(9)) REPS(9) { PH_LOCALS;
                pg8::Gemm g{(const bf16_t*)(ws + WS_X8), (const bf16_t*)(ws + WS_WDKQ), T, NDKQ, DM / 2, DM / 2, 0}; pg8::StaticOrder S; S.init(T, NDKQ, G, bx);
                pg8::EpiB16 E{(bf16_t*)(ws + WS_DKQ), NDKQ, rstd, 1.f / (SX8 * SWT8)};
                pg8::gemm_phase<pg8::EpiB16, true>(lds, g, S, E, wave, lane);
            }
            SEAM(9);
            if (SITE(10) && IN(10)) REPS(10) { PH_LOCALS;
                const bf16_t* dkq = (const bf16_t*)(ws + WS_DKQ); bf16_t* CB = (bf16_t*)(ws + WS_CB); bf16_t* CQB = (bf16_t*)(ws + WS_CQB); bf16_t* KR = (bf16_t*)(ws + WS_KR);
                for (int m = gw; m < T; m += NGW) { const bf16_t* r = dkq + (size_t)m * NDKQ;
                    const u32x4 aw = *(const u32x4*)(r + lane * 8), qw = *(const u32x4*)(r + 576 + lane * 8);
                    const f32x4 a0 = {bflo(aw.x), bfhi(aw.x), bflo(aw.y), bfhi(aw.y)}, a1 = {bflo(aw.z), bfhi(aw.z), bflo(aw.w), bfhi(aw.w)};
                    const f32x4 q0 = {bflo(qw.x), bfhi(qw.x), bflo(qw.y), bfhi(qw.y)}, q1 = {bflo(qw.z), bfhi(qw.z), bflo(qw.w), bfhi(qw.w)};
                    float sa = a0[0] * a0[0] + a0[1] * a0[1] + a0[2] * a0[2] + a0[3] * a0[3] + a1[0] * a1[0] + a1[1] * a1[1] + a1[2] * a1[2] + a1[3] * a1[3];
                    float sq = q0[0] * q0[0] + q0[1] * q0[1] + q0[2] * q0[2] + q0[3] * q0[3] + q1[0] * q1[0] + q1[1] * q1[1] + q1[2] * q1[2] + q1[3] * q1[3];
                    sa = wave_sum(sa); sq = wave_sum(sq);
                    const float ra = 1.f / sqrtf(sa * (1.f / KVL) + EPS), rq = 1.f / sqrtf(sq * (1.f / QL) + EPS);
                    const float ra8 = ra * SA8, rq8 = rq * SA8;
                    u32x2 w; w.x = pk4_fp8(a0[0] * ra8, a0[1] * ra8, a0[2] * ra8, a0[3] * ra8); w.y = pk4_fp8(a1[0] * ra8, a1[1] * ra8, a1[2] * ra8, a1[3] * ra8);
                    *(u32x2*)((unsigned char*)CB + (size_t)m * KVL + lane * 8) = w;
                    u32x2 y; y.x = pk4_fp8(q0[0] * rq8, q0[1] * rq8, q0[2] * rq8, q0[3] * rq8); y.y = pk4_fp8(q1[0] * rq8, q1[1] * rq8, q1[2] * rq8, q1[3] * rq8);
                    *(u32x2*)((unsigned char*)CQB + (size_t)m * QL + lane * 8) = y;
                    if (lane < 32) { const float x1 = bf2f(r[512 + lane]), x2 = bf2f(r[512 + 32 + lane]), co = cs[((size_t)m * 32 + lane) * 2], si = cs[((size_t)m * 32 + lane) * 2 + 1];
                        unsigned char* kr8 = (unsigned char*)KR + (size_t)m * 64;
                        kr8[lane] = (unsigned char)(__builtin_amdgcn_cvt_pk_fp8_f32((x1 * co - x2 * si) * SK8, 0.f, 0, false) & 0xff); kr8[32 + lane] = (unsigned char)(__builtin_amdgcn_cvt_pk_fp8_f32((x2 * co + x1 * si) * SK8, 0.f, 0, false) & 0xff); } }
            }
            SEAM(10);
            if (SITE(11) && IN(11)) REPS(11) { PH_LOCALS;
                pg8::Gemm g{(const bf16_t*)(ws + WS_CB), (const bf16_t*)(ws + WS_WUKV), T, 4096, KVL / 2, KVL / 2, 0}; pg8::StaticOrder S; S.init(T, 4096, G, bx);
                pg8::EpiUKV E{(bf16_t*)(ws + WS_KN), (bf16_t*)(ws + WS_VM), nullptr, 1.f / (SA8 * SWT8)};
                pg8::gemm_phase<pg8::EpiUKV, true>(lds, g, S, E, wave, lane);
            }
            LOCAL_SEAM(11);
            if (SITE(12) && IN(12)) REPS(12) { PH_LOCALS;
                pg8::Gemm g{(const bf16_t*)(ws + WS_CQB), (const bf16_t*)(ws + WS_WUQ), T, 3072, QL / 2, QL / 2, 0}; pg8::StaticOrder S; S.init(T, 3072, G, bx);
                pg8::EpiB16 E{(bf16_t*)(ws + WS_QM), 3072, nullptr, 1.f / (SA8 * SWT8)};
                pg8::gemm_phase<pg8::EpiB16, true>(lds, g, S, E, wave, lane);
            }
            SEAM(12);
            if (SITE(13) && IN(13)) REPS(13) { PH_LOCALS;
                if (bx < 256) {
                    const int xcd = bx & 7, jx = bx >> 3, gx = jx >> 4, jj = jx & 15;
#pragma unroll 1
                    for (int i = 0; i < 8; ++i) { const int bh = xcd * 16 + gx * 8 + i, b = bh >> 4, h = bh & 15; const int q0_ = (jj + (i >> 1)) & 15, qb = (i & 1) ? 15 - q0_ : q0_;
                        const bf16_t* Qp = (const bf16_t*)(ws + WS_QM) + (size_t)b * SEQ * 3072 + h * 192; const bf16_t* Kp = (const bf16_t*)(ws + WS_KN + (size_t)b * SEQ * DM + h * HD);
                        const bf16_t* Vp = (const bf16_t*)(ws + WS_VM + (size_t)b * SEQ * DM + h * HD); const bf16_t* Rp = (const bf16_t*)(ws + WS_KR + (size_t)b * SEQ * 64);
                        bf16_t* Op = (bf16_t*)((unsigned char*)XB + (size_t)b * SEQ * DM + h * HD);
                        att::attn_unit<1>(lds, Qp, 3072, Kp, Vp, DM, Rp, cs + (size_t)b * SEQ * 64, Op, DM, qb * 256, wave, lane); }
                }
            }
            SEAM(13);
            if (SITE(14) && IN(14)) REPS(14) { PH_LOCALS;
                pg8::Gemm g{XB, (const bf16_t*)(ws + WS_WMO), T, DM, DM / 2, DM / 2, 0}; pg8::StaticOrder S; S.init(T, DM, G, bx);
                pg8::EpiResB<false> E{XS, nullptr, 1.f / (SO8 * SWT8)};
                pg8::gemm_phase<pg8::EpiResB<false>, true>(lds, g, S, E, wave, lane);
            }
            SEAM(14);
        }
        peer_phases<1>(lds, lo, hi, bar, wave, G, bx, tp0, tp1);
    }
    if (PROBE_LO >= 0 || PROBE_SUB) { if (PROBE_HI == 19) tp1 = __builtin_amdgcn_s_memrealtime();
#if PROBE_ARG
        { unsigned long long* durs = (unsigned long long*)(args.ws + WS_CTL + 512 * 1024);
          if (wave == 0 && lane_id_v() == 0) __hip_atomic_store(durs + bx, tp1 - tp0, __ATOMIC_RELAXED, __HIP_MEMORY_SCOPE_AGENT);
          if (multi) xcd_barrier(bar, wave);
          if (bx == 0 && wave == 0) { unsigned long long mx = 0ull; int am = 0; for (int i = 0; i < 256; ++i) { const unsigned long long v = __hip_atomic_load(durs + i, __ATOMIC_RELAXED, __HIP_MEMORY_SCOPE_AGENT); if (v > mx) { mx = v; am = i; } }
              const unsigned long long d = (PROBE_ARG == 1) ? mx * 8ull : (unsigned long long)am * 10000ull, t0_ = __builtin_amdgcn_s_memrealtime(); while (__builtin_amdgcn_s_memrealtime() - t0_ < d) __builtin_amdgcn_s_sleep(16); } }
#else
        if (bx == PROBE_WG && wave == 0) { const unsigned long long d = (tp1 - tp0) * 8ull, t0_ = __builtin_amdgcn_s_memrealtime(); while (__builtin_amdgcn_s_memrealtime() - t0_ < d) __builtin_amdgcn_s_sleep(16); }
#endif
    }
#undef IN
#undef SEAM
}

extern "C" void kernel_launch(void* const* d_in, const int* in_sizes, int n_in, void* d_out, int out_size, void* d_ws, size_t ws_size, hipStream_t stream) {
    static int grid = 0;
    if (grid == 0) {
        if (n_in != 21 || out_size != T * DM || ws_size < WS_END) { fprintf(stderr, "kernel_launch: unexpected shapes (n_in %d out %d ws %zu need %zu)\n", n_in, out_size, ws_size, (size_t)WS_END); grid = -1; return; }
        int dev = 0, cus = 0, per_cu = 0;
        if (hipGetDevice(&dev) != hipSuccess || hipDeviceGetAttribute(&cus, hipDeviceAttributeMultiprocessorCount, dev) != hipSuccess) { grid = -1; return; }
        if (hipFuncSetAttribute((const void*)fwd, hipFuncAttributeMaxDynamicSharedMemorySize, LDS_BYTES) != hipSuccess) { fprintf(stderr, "kernel_launch: hipFuncSetAttribute failed\n"); grid = -1; return; }
        if (hipOccupancyMaxActiveBlocksPerMultiprocessor(&per_cu, (const void*)fwd, NTHR, LDS_BYTES) != hipSuccess || per_cu < 1) fprintf(stderr, "kernel_launch: occupancy query reports %d\n", per_cu);
        (void)hipGetLastError();
        grid = cus < 256 ? cus : 256;
    }
    if (grid < 0) return;
    (void)hipMemsetAsync((char*)d_ws + WS_CTL, 0, CTL_ZERO_BYTES, stream);
    Args a{};
    for (int i = 0; i < 21; ++i) a.in[i] = d_in[i];
    a.out = (float*)d_out; a.ws = (unsigned char*)d_ws;
#if MK_ONE_LAUNCH
    a.ph_lo = 0; a.ph_hi = 20;
    hipLaunchKernelGGL(fwd, dim3(grid), dim3(NTHR), LDS_BYTES, stream, a);
#else
    for (int ph = 0; ph < 20; ++ph) { a.ph_lo = ph; a.ph_hi = ph + 1; hipLaunchKernelGGL(fwd, dim3(grid), dim3(NTHR), LDS_BYTES, stream, a); }
#endif
}
```

```cpp
#include <hip/hip_runtime.h>
#include <cstdio>
#include <cstdint>

#define PROBE_LO -1
#define PROBE_SUB 0
#define PROBE_WG 0
#define PROBE_ARG 0
#define PROBE_HI -1
#ifndef MK_ONE_LAUNCH
#define MK_ONE_LAUNCH 1
#endif

#define LAS __attribute__((address_space(3)))
#define GAS __attribute__((address_space(1)))
typedef unsigned short bf16_t;
typedef short bf16x8 __attribute__((ext_vector_type(8)));
typedef short s16x4 __attribute__((ext_vector_type(4)));
typedef float f32x2 __attribute__((ext_vector_type(2)));
typedef float f32x4 __attribute__((ext_vector_type(4)));
typedef float f32x16 __attribute__((ext_vector_type(16)));
typedef unsigned u32x2 __attribute__((ext_vector_type(2)));
typedef int i32x2v __attribute__((ext_vector_type(2)));
typedef unsigned u32x4 __attribute__((ext_vector_type(4)));
typedef __bf16 bf16v2 __attribute__((ext_vector_type(2)));
typedef _Float16 h16x2 __attribute__((ext_vector_type(2)));
__device__ __forceinline__ float dot2bf(unsigned a, unsigned b, float c) { return __builtin_amdgcn_fdot2_f32_bf16(__builtin_bit_cast(bf16v2, a), __builtin_bit_cast(bf16v2, b), c, false); }

constexpr int NB = 8, SEQ = 4096, DM = 2048, T = NB * SEQ, NH = 16, HD = 128;
constexpr int KVL = 512, QKR = 64, QL = 512, NEXP = 16384, PH = 8, NKEYS = 128, TOPK = 16, NSEL = PH * TOPK;
constexpr int NDKQ = 1280;
constexpr float EPS = 1e-6f;
constexpr float LOG2E = 1.4426950408889634f;
constexpr int NWAVES = 8, NTHR = 512;

constexpr size_t MiB = 1u << 20;
constexpr size_t WS_CTL = 0, CTL_ZERO_BYTES = 1 * MiB;
constexpr size_t WS_RSTD = 1 * MiB;
constexpr size_t WS_XSUM = 1 * MiB + 512 * 1024;
constexpr size_t WS_CS = 2 * MiB;
constexpr size_t WS_WQKV = 16 * MiB;
constexpr size_t WS_WO = 40 * MiB;
constexpr size_t WS_WDKQ = 48 * MiB;
constexpr size_t WS_WUKV = 54 * MiB;
constexpr size_t WS_WUQ = 58 * MiB;
constexpr size_t WS_WMO = 62 * MiB;
constexpr size_t WS_WPQ = 70 * MiB;
constexpr size_t WS_KBD = 86 * MiB;
constexpr size_t WS_TU8 = 96 * MiB;
constexpr size_t WS_TV8 = 128 * MiB;
constexpr float SU8 = 512.f, SV4 = 4.f, SX8 = 8.f, SU4 = 136.f, UOFF = 7.5f, SVQ = 8.5f, SW8 = 64.f;
constexpr size_t WS_CB = 96 * MiB;
constexpr size_t WS_CQB = 128 * MiB;
constexpr size_t WS_XB = 224 * MiB;
constexpr size_t WS_R0 = 352 * MiB;
constexpr size_t WS_Q = WS_R0, WS_K = WS_R0 + 128 * MiB, WS_V = WS_R0 + 256 * MiB;
constexpr size_t WS_KN = WS_R0, WS_VM = WS_R0 + 128 * MiB, WS_QM = WS_R0 + 256 * MiB;
constexpr size_t WS_KR = WS_R0 + 448 * MiB;
constexpr size_t WS_QP = WS_R0, WS_SC = WS_R0 + 128 * MiB, WS_IDS = WS_R0 + 384 * MiB, WS_GATE = WS_R0 + 400 * MiB;
constexpr size_t WS_DKQ = WS_R0 + 256 * MiB;
constexpr size_t WS_X8 = WS_R0 + 416 * MiB;
constexpr size_t WS_XS = WS_R0 + 480 * MiB;
constexpr size_t WS_WST = WS_R0 + 608 * MiB;
constexpr size_t WS_END = WS_R0 + 624 * MiB;

constexpr int CW_TMO = 0, CW_CHK = 2, CW_BAR = 4096;

__device__ __forceinline__ unsigned f2bf(float f) { unsigned u = __builtin_bit_cast(unsigned, f); return (u + 0x7fffu + ((u >> 16) & 1u)) >> 16; }
__device__ __forceinline__ unsigned pk2(float lo, float hi) { return f2bf(lo) | (f2bf(hi) << 16); }
__device__ __forceinline__ unsigned pk4_fp8(float a, float b, float c, float d) { int w = __builtin_amdgcn_cvt_pk_fp8_f32(a, b, 0, false); w = __builtin_amdgcn_cvt_pk_fp8_f32(c, d, w, true); return (unsigned)w; }
constexpr float SA8 = 16.f, SWT8 = 512.f;
constexpr float SQ8 = 16.f, SK8 = 16.f, SV8 = 16.f, SD8 = 16.f;
constexpr float SO8 = 32.f, SO8S = 16.f;
template <int CTRL> __device__ __forceinline__ float quad_f32(float x) { return __int_as_float(__builtin_amdgcn_update_dpp(0, __float_as_int(x), CTRL, 0xF, 0xF, false)); }
__device__ __forceinline__ float bflo(unsigned w) { return __builtin_bit_cast(float, w << 16); }
__device__ __forceinline__ float bfhi(unsigned w) { return __builtin_bit_cast(float, w & 0xffff0000u); }
__device__ __forceinline__ float bf2f(bf16_t h) { return __builtin_bit_cast(float, (unsigned)h << 16); }
__device__ __forceinline__ unsigned cvtpk(float lo, float hi) { unsigned r; asm volatile("v_cvt_pk_bf16_f32 %0, %1, %2" : "=v"(r) : "v"(lo), "v"(hi)); return r; }
__device__ __forceinline__ float wave_sum(float v) {
#pragma unroll
    for (int o = 1; o < 64; o <<= 1) v += __shfl_xor(v, o);
    return v;
}
__device__ __forceinline__ unsigned wave_max_u32(unsigned v) {
#pragma unroll
    for (int o = 1; o < 64; o <<= 1) { unsigned w = (unsigned)__shfl_xor((int)v, o); v = v > w ? v : w; }
    return v;
}
__device__ __forceinline__ int lane_id_v() { int l; asm volatile("v_mbcnt_lo_u32_b32 %0, -1, 0\n\tv_mbcnt_hi_u32_b32 %0, -1, %0" : "=v"(l)); return l; }
#define LDS_WAIT() asm volatile("s_waitcnt lgkmcnt(0)" ::: "memory")
#define VM_WAIT() asm volatile("s_waitcnt vmcnt(0)" ::: "memory")
#define SBAR() __builtin_amdgcn_sched_barrier(0)

namespace pg8 {
constexpr int BM = 256, BK = 64, HALF = 128, HTB = HALF * BK * 2, STAGE_BYTES = 8 * HTB, NXCD = 8, WGM = 8;
__host__ __device__ __forceinline__ int lds_byte(int r, int c) { const int st = (r >> 4) * 2 + (c >> 5), rr = r & 15, cc = c & 31, ob = rr * 64 + cc * 2; return st * 1024 + (ob ^ (((ob >> 9) & 1) << 5)); }
__host__ __device__ __forceinline__ void stage_rc(int b, int& R, int& C) { const int st = b / 1024, sb = b % 1024, swz = sb ^ (((sb >> 9) & 1) << 5); R = (st >> 1) * 16 + swz / 64; C = (st & 1) * 32 + (swz % 64) / 2; }
__host__ __device__ __forceinline__ int perm32(int rho) { const int n = rho >> 4, i = rho & 15; return 8 * (i >> 2) + 4 * n + (i & 3); }
struct Unit { int pm, pn; };
struct Gemm { const bf16_t* A; const bf16_t* Bt; int M, N, K, lda, a_pn, ldb = 0, b_pm = 0; };
struct StaticOrder {
    int nM, nN, nwg, G, c;
    __device__ void init(int M, int N, int G_, int c_) { nM = M / BM; nN = N / BM; nwg = nM * nN; G = G_; c = c_; }
    __device__ bool next(int i, Unit& u) const {
        const long L = (long)i * G + c; if (L >= nwg) return false;
        int wgid = (int)L; { const int q = nwg / NXCD, r = nwg % NXCD, xcd = wgid % NXCD, off = wgid / NXCD; wgid = (xcd < r ? xcd * (q + 1) : r * (q + 1) + (xcd - r) * q) + off; }
        const int nig = WGM * nN, gid = wgid / nig, fm = gid * WGM, gsz = (nM - fm) < WGM ? (nM - fm) : WGM;
        u.pm = fm + ((wgid % nig) % gsz); u.pn = (wgid % nig) / gsz; return true;
    }
};
struct EpiQKV {
    static constexpr bool PERM = true;
    bf16_t* Q; size_t split_stride; const float* rstd; float qscale;
    __device__ __forceinline__ void operator()(const f32x4 (&acc)[2][2][4][2], const Unit& u, int wr, int wc, int fr, int fq) const {
        const int row0 = u.pm * BM + wr * 64 + fr; int colt = u.pn * BM; const int t = colt / DM; bf16_t* base = Q + (size_t)t * split_stride; colt -= t * DM;
        const float sc = t == 0 ? qscale : 1.f; const int col0 = colt + wc * 32 + 8 * fq;
#pragma unroll
        for (int ai = 0; ai < 2; ++ai)
#pragma unroll
            for (int m = 0; m < 4; ++m) { const int row = row0 + ai * HALF + m * 16; const float rs = rstd[row] * sc; bf16_t* rowp = base + (size_t)row * DM + col0;
#pragma unroll
                for (int bj = 0; bj < 2; ++bj) { const f32x4 v0 = acc[ai][bj][m][0] * rs, v1 = acc[ai][bj][m][1] * rs;
                    u32x4 w; w.x = cvtpk(v0[0], v0[1]); w.y = cvtpk(v0[2], v0[3]); w.z = cvtpk(v1[0], v1[1]); w.w = cvtpk(v1[2], v1[3]);
                    *(u32x4*)(rowp + bj * HALF) = w; } }
    }
};
struct EpiB16 {
    static constexpr bool PERM = true;
    bf16_t* O; int ldc; const float* rstd; float scale = 1.f;
    __device__ __forceinline__ void operator()(const f32x4 (&acc)[2][2][4][2], const Unit& u, int wr, int wc, int fr, int fq) const {
        const int row0 = u.pm * BM + wr * 64 + fr, col0 = u.pn * BM + wc * 32 + 8 * fq;
#pragma unroll
        for (int ai = 0; ai < 2; ++ai)
#pragma unroll
            for (int m = 0; m < 4; ++m) { const int row = row0 + ai * HALF + m * 16; const float rs = (rstd ? rstd[row] : 1.f) * scale; bf16_t* rowp = O + (size_t)row * ldc + col0;
#pragma unroll
                for (int bj = 0; bj < 2; ++bj) { const f32x4 v0 = acc[ai][bj][m][0] * rs, v1 = acc[ai][bj][m][1] * rs;
                    u32x4 w; w.x = cvtpk(v0[0], v0[1]); w.y = cvtpk(v0[2], v0[3]); w.z = cvtpk(v1[0], v1[1]); w.w = cvtpk(v1[2], v1[3]);
                    *(u32x4*)(rowp + bj * HALF) = w; } }
    }
};
struct EpiUKV {
    static constexpr bool PERM = true;
    bf16_t* KN; bf16_t* VM; const float* rstd; float scale = 1.f;
    __device__ __forceinline__ void operator()(const f32x4 (&acc)[2][2][4][2], const Unit& u, int wr, int wc, int fr, int fq) const {
        const int row0 = u.pm * BM + wr * 64 + fr, col0 = u.pn * HD + wc * 32 + 8 * fq;
#pragma unroll
        for (int ai = 0; ai < 2; ++ai)
#pragma unroll
            for (int m = 0; m < 4; ++m) { const int row = row0 + ai * HALF + m * 16; const float rs = (rstd ? rstd[row] : 1.f) * scale;
                { const f32x4 v0 = acc[ai][0][m][0] * (rs * SK8), v1 = acc[ai][0][m][1] * (rs * SK8);
                    u32x2 w; w.x = pk4_fp8(v0[0], v0[1], v0[2], v0[3]); w.y = pk4_fp8(v1[0], v1[1], v1[2], v1[3]); *(u32x2*)((unsigned char*)KN + (size_t)row * DM + col0) = w; }
                { const f32x4 v0 = acc[ai][1][m][0] * (rs * SV8), v1 = acc[ai][1][m][1] * (rs * SV8);
                    u32x2 w; w.x = pk4_fp8(v0[0], v0[1], v0[2], v0[3]); w.y = pk4_fp8(v1[0], v1[1], v1[2], v1[3]); *(u32x2*)((unsigned char*)VM + (size_t)row * DM + col0) = w; } }
    }
};
struct EpiF8R {
    static constexpr bool PERM = true;
    unsigned char* O; int ldc; const float* rstd; float scale; int ncols;
    __device__ __forceinline__ void operator()(const f32x4 (&acc)[2][2][4][2], const Unit& u, int wr, int wc, int fr, int fq) const {
        const int row0 = u.pm * BM + wr * 64 + fr, col0 = u.pn * BM + wc * 32 + 8 * fq;
#pragma unroll
        for (int ai = 0; ai < 2; ++ai)
#pragma unroll
            for (int m = 0; m < 4; ++m) { const int row = row0 + ai * HALF + m * 16; const float rs = rstd[row] * scale; unsigned char* rowp = O + (size_t)row * ldc + col0;
#pragma unroll
                for (int bj = 0; bj < 2; ++bj) { if (col0 + bj * HALF < ncols) { const f32x4 v0 = acc[ai][bj][m][0] * rs, v1 = acc[ai][bj][m][1] * rs;
                    u32x2 w; w.x = pk4_fp8(v0[0], v0[1], v0[2], v0[3]); w.y = pk4_fp8(v1[0], v1[1], v1[2], v1[3]); *(u32x2*)(rowp + bj * HALF) = w; } } }
    }
};
struct EpiF8 {
    static constexpr bool PERM = true;
    unsigned char* O; int ldc; float scale;
    __device__ __forceinline__ void operator()(const f32x4 (&acc)[2][2][4][2], const Unit& u, int wr, int wc, int fr, int fq) const {
        const int row0 = u.pm * BM + wr * 64 + fr, col0 = u.pn * BM + wc * 32 + 8 * fq;
#pragma unroll
        for (int ai = 0; ai < 2; ++ai)
#pragma unroll
            for (int m = 0; m < 4; ++m) { const int row = row0 + ai * HALF + m * 16; unsigned char* rowp = O + (size_t)row * ldc + col0;
#pragma unroll
                for (int bj = 0; bj < 2; ++bj) { const f32x4 v0 = acc[ai][bj][m][0] * scale, v1 = acc[ai][bj][m][1] * scale;
                    u32x2 w; w.x = pk4_fp8(v0[0], v0[1], v0[2], v0[3]); w.y = pk4_fp8(v1[0], v1[1], v1[2], v1[3]); *(u32x2*)(rowp + bj * HALF) = w; } }
    }
};
struct EpiF16 {
    static constexpr bool PERM = true;
    _Float16* O; int ldc; const float* rstd; float scale = 1.f;
    __device__ __forceinline__ void operator()(const f32x4 (&acc)[2][2][4][2], const Unit& u, int wr, int wc, int fr, int fq) const {
        typedef _Float16 h8 __attribute__((ext_vector_type(8)));
        const int row0 = u.pm * BM + wr * 64 + fr, col0 = u.pn * BM + wc * 32 + 8 * fq;
#pragma unroll
        for (int ai = 0; ai < 2; ++ai)
#pragma unroll
            for (int m = 0; m < 4; ++m) { const int row = row0 + ai * HALF + m * 16; const float rs = rstd[row] * scale; _Float16* rowp = O + (size_t)row * ldc + col0;
#pragma unroll
                for (int bj = 0; bj < 2; ++bj) { const f32x4 v0 = acc[ai][bj][m][0] * rs, v1 = acc[ai][bj][m][1] * rs;
                    const h8 w = {(_Float16)v0[0], (_Float16)v0[1], (_Float16)v0[2], (_Float16)v0[3], (_Float16)v1[0], (_Float16)v1[1], (_Float16)v1[2], (_Float16)v1[3]};
                    *(h8*)(rowp + bj * HALF) = w; } }
    }
};
struct EpiF32 {
    static constexpr bool PERM = false;
    float* C; int ldc; const float* rstd;
    __device__ __forceinline__ void operator()(const f32x4 (&acc)[2][2][4][2], const Unit& u, int wr, int wc, int fr, int fq) const {
        const int row0 = u.pm * BM + wr * 64 + fr, col0 = u.pn * BM + wc * 32 + 4 * fq;
#pragma unroll
        for (int ai = 0; ai < 2; ++ai)
#pragma unroll
            for (int m = 0; m < 4; ++m) { const int row = row0 + ai * HALF + m * 16; const float rs = rstd ? rstd[row] : 1.f; float* rowp = C + (size_t)row * ldc + col0;
#pragma unroll
                for (int bj = 0; bj < 2; ++bj)
#pragma unroll
                    for (int n = 0; n < 2; ++n) *(f32x4*)(rowp + bj * HALF + n * 16) = acc[ai][bj][m][n] * rs; }
    }
};
template <bool BASE_F32> struct EpiResB {
    static constexpr bool PERM = true;
    bf16_t* XS; const float* basef; float scale = 1.f;
    __device__ __forceinline__ void operator()(const f32x4 (&acc)[2][2][4][2], const Unit& u, int wr, int wc, int fr, int fq) const {
        const int row0 = u.pm * BM + wr * 64 + fr, col0 = u.pn * BM + wc * 32 + 8 * fq;
#pragma unroll
        for (int ai = 0; ai < 2; ++ai)
#pragma unroll
            for (int m = 0; m < 4; ++m) { const size_t ro = (size_t)(row0 + ai * HALF + m * 16) * DM + col0;
#pragma unroll
                for (int bj = 0; bj < 2; ++bj) { f32x4 b0, b1;
                    if constexpr (BASE_F32) { b0 = *(const f32x4*)(basef + ro + bj * HALF); b1 = *(const f32x4*)(basef + ro + bj * HALF + 4); }
                    else { const u32x4 bw = *(const u32x4*)(XS + ro + bj * HALF); b0 = (f32x4){bflo(bw.x), bfhi(bw.x), bflo(bw.y), bfhi(bw.y)}; b1 = (f32x4){bflo(bw.z), bfhi(bw.z), bflo(bw.w), bfhi(bw.w)}; }
                    const f32x4 v0 = acc[ai][bj][m][0] * scale + b0, v1 = acc[ai][bj][m][1] * scale + b1;
                    u32x4 w; w.x = cvtpk(v0[0], v0[1]); w.y = cvtpk(v0[2], v0[3]); w.z = cvtpk(v1[0], v1[1]); w.w = cvtpk(v1[2], v1[3]);
                    *(u32x4*)(XS + ro + bj * HALF) = w; } }
    }
};
struct EpiRes {
    static constexpr bool PERM = false;
    float* C; const float* base; int ldc;
    __device__ __forceinline__ void operator()(const f32x4 (&acc)[2][2][4][2], const Unit& u, int wr, int wc, int fr, int fq) const {
        const int row0 = u.pm * BM + wr * 64 + fr, col0 = u.pn * BM + wc * 32 + 4 * fq;
#pragma unroll
        for (int ai = 0; ai < 2; ++ai)
#pragma unroll
            for (int m = 0; m < 4; ++m) { const size_t ro = (size_t)(row0 + ai * HALF + m * 16) * ldc + col0;
#pragma unroll
                for (int bj = 0; bj < 2; ++bj)
#pragma unroll
                    for (int n = 0; n < 2; ++n) { const f32x4 b = *(const f32x4*)(base + ro + bj * HALF + n * 16); *(f32x4*)(C + ro + bj * HALF + n * 16) = acc[ai][bj][m][n] + b; } }
    }
};

typedef int i32x4v __attribute__((ext_vector_type(4)));
typedef int i32x8v __attribute__((ext_vector_type(8)));
template <class Epi, bool FP8 = false>
__device__ __forceinline__ void gemm_phase(LAS unsigned char* lds, const Gemm g, const StaticOrder& S, const Epi& E, const int wid, const int lane) {
    const int tid = wid * 64 + lane, wr = wid >> 2, wc = wid & 3, fr = lane & 15, fq = lane >> 4;
    const int K = g.K, nt = K / BK, lda = g.lda, ldb = g.ldb ? g.ldb : K;
    unsigned voffA[2], voffB[2];
#pragma unroll
    for (int i = 0; i < 2; ++i) { int R, C; stage_rc(tid * 16 + i * 8192, R, C); const int Rb = Epi::PERM ? ((R & ~31) + perm32(R & 31)) : R;
        voffA[i] = (unsigned)(R * lda + C) * 2u; voffB[i] = (unsigned)(Rb * ldb + C) * 2u; }
    const size_t kstep = (size_t)(BK * 2);
    const size_t hstepA = (size_t)HALF * lda * 2, hstepB = (size_t)HALF * ldb * 2;
    const size_t tstepA = 2 * hstepA, tstepB = 2 * hstepB;
    const unsigned ldsw = (unsigned)wid * 1024u;
    const int aoff = lds_byte(wr * 64 + fr, fq * 8); int boff = lds_byte(wc * 32 + fr, fq * 8) + 4 * HTB; asm volatile("" : "+v"(boff));
#define PG8_SA(b, h) (((b) * 2 + (h)) * HTB)
#define PG8_SB(b, h) ((4 + (b) * 2 + (h)) * HTB)
#define PG8_SBR(b, h) (((b) * 2 + (h)) * HTB)
#define PG8_STAGE(bufoff, gbase, voff) do { _Pragma("unroll") for (int _i = 0; _i < 2; ++_i) { unsigned vo_ = (voff)[_i]; asm volatile("" : "+v"(vo_));     \
        __builtin_amdgcn_global_load_lds((const unsigned*)((const char*)(gbase) + vo_), (LAS unsigned*)(lds + (bufoff) + ldsw + _i * 8192), 16, 0, 0); } } while (0)
#define PG8_LD4(addr_) (*(const LAS i32x4v*)(lds + (addr_)))
#define PG8_LDA(dst, b, h) do { if constexpr (FP8) { _Pragma("unroll") for (int m = 0; m < 4; ++m) dst##8[m] = __builtin_shufflevector(PG8_LD4(PG8_SA(b, h) + aoff + m * 2048), PG8_LD4(PG8_SA(b, h) + aoff + m * 2048 + 1024), 0, 1, 2, 3, 4, 5, 6, 7); } \
        else { _Pragma("unroll") for (int m = 0; m < 4; ++m) _Pragma("unroll") for (int k = 0; k < 2; ++k) dst[m][k] = *(const LAS bf16x8*)(lds + PG8_SA(b, h) + aoff + m * 2048 + k * 1024); } } while (0)
#define PG8_LDB(dst, b, h) do { if constexpr (FP8) { _Pragma("unroll") for (int n = 0; n < 2; ++n) dst##8[n] = __builtin_shufflevector(PG8_LD4(PG8_SBR(b, h) + boff + n * 2048), PG8_LD4(PG8_SBR(b, h) + boff + n * 2048 + 1024), 0, 1, 2, 3, 4, 5, 6, 7); } \
        else { _Pragma("unroll") for (int n = 0; n < 2; ++n) _Pragma("unroll") for (int k = 0; k < 2; ++k) dst[n][k] = *(const LAS bf16x8*)(lds + PG8_SBR(b, h) + boff + n * 2048 + k * 1024); } } while (0)
#define PG8_MMA(ai, bj, At, Bt) do { __builtin_amdgcn_s_setprio(1);                                                                                                         \
        if constexpr (FP8) { _Pragma("unroll") for (int m = 0; m < 4; ++m) _Pragma("unroll") for (int n = 0; n < 2; ++n)                                                          \
            acc[ai][bj][m][n] = __builtin_amdgcn_mfma_scale_f32_16x16x128_f8f6f4(Bt##8[n], At##8[m], acc[ai][bj][m][n], 0, 0, 0, 0, 0, 0); }                     \
        else { _Pragma("unroll") for (int m = 0; m < 4; ++m) _Pragma("unroll") for (int n = 0; n < 2; ++n) _Pragma("unroll") for (int k = 0; k < 2; ++k)                           \
            acc[ai][bj][m][n] = __builtin_amdgcn_mfma_f32_16x16x32_bf16(Bt[n][k], At[m][k], acc[ai][bj][m][n], 0, 0, 0); }                                                          \
        __builtin_amdgcn_s_setprio(0); } while (0)
#define PG8_WAIT_V(n) asm volatile("s_waitcnt vmcnt(" #n ")" ::: "memory")
#define PG8_WAIT_L(n) asm volatile("s_waitcnt lgkmcnt(" #n ")" ::: "memory")
#define PG8_BAR __builtin_amdgcn_s_barrier()
#define PG8_SCHED __builtin_amdgcn_sched_barrier(0)
    Unit cur, nxt; int ui = 0;
    if (!S.next(0, cur)) return;
    f32x4 acc[2][2][4][2];
#pragma unroll
    for (int a = 0; a < 2; ++a)
#pragma unroll
        for (int b = 0; b < 2; ++b)
#pragma unroll
            for (int m = 0; m < 4; ++m)
#pragma unroll
                for (int n = 0; n < 2; ++n) acc[a][b][m][n] = (f32x4){0.f, 0.f, 0.f, 0.f};
    bf16x8 At[4][2], B0[2][2], B1[2][2];
    i32x8v At8[4], B08[2], B18[2]; (void)At8; (void)B08; (void)B18; (void)At; (void)B0; (void)B1;
    const char* cA = (const char*)g.A + (size_t)cur.pm * tstepA + (size_t)cur.pn * g.a_pn * 2; const char* cB = (const char*)g.Bt + (size_t)cur.pn * tstepB + (size_t)cur.pm * g.b_pm * 2;
    PG8_STAGE(PG8_SB(0, 0), cB, voffB); PG8_STAGE(PG8_SB(0, 1), cB + hstepB, voffB); PG8_STAGE(PG8_SA(0, 0), cA, voffA); PG8_STAGE(PG8_SA(0, 1), cA + hstepA, voffA);
    if (wr == 1) PG8_BAR;
    PG8_WAIT_V(2); PG8_BAR;
    PG8_STAGE(PG8_SB(1, 0), cB + kstep, voffB); PG8_STAGE(PG8_SA(1, 0), cA + kstep, voffA); PG8_STAGE(PG8_SB(1, 1), cB + hstepB + kstep, voffB);
    PG8_WAIT_V(6); PG8_BAR;
#pragma unroll 1
    for (;;) {
        const bool has_next = S.next(ui + 1, nxt);
        const char* nA = has_next ? (const char*)g.A + (size_t)nxt.pm * tstepA + (size_t)nxt.pn * g.a_pn * 2 : cA; const char* nB = has_next ? (const char*)g.Bt + (size_t)nxt.pn * tstepB + (size_t)nxt.pm * g.b_pm * 2 : cB;
#pragma unroll 1
        for (int t = 0; t < nt; t += 2) {
            const bool last = (t == nt - 2);
            const char* a1 = cA + (size_t)(t + 1) * kstep;
            const char* a2 = last ? nA : cA + (size_t)(t + 2) * kstep; const char* b2 = last ? nB : cB + (size_t)(t + 2) * kstep;
            const char* a3 = a2 + kstep; const char* b3 = b2 + kstep;
            PG8_LDB(B0, 0, 0); PG8_LDB(B1, 0, 1); PG8_SCHED; PG8_LDA(At, 0, 0); PG8_STAGE(PG8_SA(1, 1), a1 + hstepA, voffA);
            PG8_WAIT_V(8); PG8_WAIT_L(0); PG8_BAR; PG8_MMA(0, 0, At, B0); PG8_MMA(0, 1, At, B1); PG8_BAR; PG8_SCHED;
            PG8_LDA(At, 0, 1); PG8_STAGE(PG8_SB(0, 0), b2, voffB); PG8_STAGE(PG8_SB(0, 1), b2 + hstepB, voffB); PG8_STAGE(PG8_SA(0, 0), a2, voffA);
            PG8_WAIT_V(8); PG8_WAIT_L(0); PG8_BAR; PG8_MMA(1, 0, At, B0); PG8_MMA(1, 1, At, B1); PG8_BAR; PG8_SCHED;
            PG8_LDB(B0, 1, 0); PG8_LDB(B1, 1, 1); PG8_SCHED; PG8_LDA(At, 1, 0); PG8_STAGE(PG8_SA(0, 1), a2 + hstepA, voffA);
            PG8_WAIT_V(8); PG8_WAIT_L(0); PG8_BAR; PG8_MMA(0, 0, At, B0); PG8_MMA(0, 1, At, B1); PG8_BAR; PG8_SCHED;
            PG8_LDA(At, 1, 1); PG8_STAGE(PG8_SB(1, 0), b3, voffB); PG8_STAGE(PG8_SB(1, 1), b3 + hstepB, voffB); PG8_STAGE(PG8_SA(1, 0), a3, voffA);
            PG8_WAIT_V(8); PG8_WAIT_L(0); PG8_BAR; PG8_MMA(1, 0, At, B0); PG8_MMA(1, 1, At, B1); PG8_BAR; PG8_SCHED;
        }
        if (wr == 0) PG8_BAR;
        E(acc, cur, wr, wc, fr, fq);
        if (!has_next) break;
#pragma unroll
        for (int a = 0; a < 2; ++a)
#pragma unroll
            for (int b = 0; b < 2; ++b)
#pragma unroll
                for (int m = 0; m < 4; ++m)
#pragma unroll
                    for (int n = 0; n < 2; ++n) acc[a][b][m][n] = (f32x4){0.f, 0.f, 0.f, 0.f};
        cur = nxt; cA = nA; cB = nB; ++ui;
        if (wr == 1) PG8_BAR;
    }
    PG8_WAIT_V(0);
    PG8_BAR;
#undef PG8_SA
#undef PG8_SB
#undef PG8_SBR
#undef PG8_STAGE
#undef PG8_LDA
#undef PG8_LD4
#undef PG8_LDB
#undef PG8_MMA
#undef PG8_WAIT_V
#undef PG8_WAIT_L
#undef PG8_BAR
#undef PG8_SCHED
}
}

namespace att {
typedef int i32x8q __attribute__((ext_vector_type(8)));
typedef int i32x4q __attribute__((ext_vector_type(4)));
constexpr int SHM_V = 16384, SHM_K = 16384, SHM_R = 8192;
constexpr int OFF_V = 0, OFF_K = 2 * SHM_V, OFF_R = OFF_K + 2 * SHM_K, OFF_WS = OFF_R + 2 * SHM_R, LDS_BYTES = OFF_WS + NWAVES * 64 * 4;
#define KSWZ(row, colB) ((row) * 256 + ((colB) ^ (((row) & 7) << 4)))
#define RSWZ(row, colB) ((row) * 128 + ((colB) ^ (((row) & 7) << 4)))
__device__ __forceinline__ int v_st(int k, int c) { const int kk = (k & ~0xC) | ((k & 4) << 1) | ((k & 8) >> 1); return ((kk >> 3) * 4 + (c >> 5)) * 512 + ((kk & 7) * 32 + (c & 31)) * 2; }
__device__ __forceinline__ int v_rd_base(int lane) { return ((lane & 3) << 3) | (((lane >> 2) & 3) << 6) | (((lane >> 4) & 1) << 5) | (((lane >> 5) & 1) << 8); }
__device__ __forceinline__ int crow(int r, int hi) { return (r & 3) + 8 * (r >> 2) + 4 * hi; }
__device__ __forceinline__ float pl_sum(float x) { auto rr = __builtin_amdgcn_permlane32_swap(__float_as_uint(x), __float_as_uint(x), false, false); return __uint_as_float(rr[0]) + __uint_as_float(rr[1]); }
__device__ __forceinline__ float pl_max(float x) { auto rr = __builtin_amdgcn_permlane32_swap(__float_as_uint(x), __float_as_uint(x), false, false); return fmaxf(__uint_as_float(rr[0]), __uint_as_float(rr[1])); }

#define PK4(P, B_, OUT) do { unsigned a0 = cvtpk(P[B_+0], P[B_+1]), a1 = cvtpk(P[B_+2], P[B_+3]);                          \
        unsigned b0 = cvtpk(P[B_+4], P[B_+5]), b1 = cvtpk(P[B_+6], P[B_+7]);                                             \
        auto r0 = __builtin_amdgcn_permlane32_swap(a0, b0, false, false); auto r1 = __builtin_amdgcn_permlane32_swap(a1, b1, false, false); \
        u32x4 w = {r0[0], r1[0], r0[1], r1[1]}; OUT = __builtin_bit_cast(bf16x8, w); } while (0)

__device__ __forceinline__ void pv_tile(f32x16* o, unsigned vb, bf16x8 pa0, bf16x8 pa1, bf16x8 pa2, bf16x8 pa3) {
#define TRRD(dst, off) asm volatile("ds_read_b64_tr_b16 %0, %1 offset:%2" : "=&v"(dst) : "v"(vb), "i"(off) : "memory")
#define PV_RD(S, d0) do { constexpr int b_ = (d0) * 512; TRRD(S##l0, b_); TRRD(S##h0, b_ + 2048); TRRD(S##l1, b_ + 4096); TRRD(S##h1, b_ + 6144); TRRD(S##l2, b_ + 8192); TRRD(S##h2, b_ + 10240); TRRD(S##l3, b_ + 12288); TRRD(S##h3, b_ + 14336); } while (0)
#define PV_MM(S, d0) do {   \
        o[d0] = __builtin_amdgcn_mfma_f32_32x32x16_bf16(pa0, (bf16x8){S##l0[0], S##l0[1], S##l0[2], S##l0[3], S##h0[0], S##h0[1], S##h0[2], S##h0[3]}, o[d0], 0, 0, 0);   \
        o[d0] = __builtin_amdgcn_mfma_f32_32x32x16_bf16(pa1, (bf16x8){S##l1[0], S##l1[1], S##l1[2], S##l1[3], S##h1[0], S##h1[1], S##h1[2], S##h1[3]}, o[d0], 0, 0, 0);   \
        o[d0] = __builtin_amdgcn_mfma_f32_32x32x16_bf16(pa2, (bf16x8){S##l2[0], S##l2[1], S##l2[2], S##l2[3], S##h2[0], S##h2[1], S##h2[2], S##h2[3]}, o[d0], 0, 0, 0);   \
        o[d0] = __builtin_amdgcn_mfma_f32_32x32x16_bf16(pa3, (bf16x8){S##l3[0], S##l3[1], S##l3[2], S##l3[3], S##h3[0], S##h3[1], S##h3[2], S##h3[3]}, o[d0], 0, 0, 0); } while (0)
#define PV_WAIT(n) do { asm volatile("s_waitcnt lgkmcnt(" #n ")" ::: "memory"); SBAR(); } while (0)
    s16x4 Al0, Al1, Al2, Al3, Ah0, Ah1, Ah2, Ah3, Bl0, Bl1, Bl2, Bl3, Bh0, Bh1, Bh2, Bh3;
    PV_RD(A, 0); PV_RD(B, 1); PV_WAIT(8); PV_MM(A, 0); SBAR();
    PV_RD(A, 2); PV_WAIT(8); PV_MM(B, 1); SBAR();
    PV_RD(B, 3); PV_WAIT(8); PV_MM(A, 2); SBAR();
    PV_WAIT(0); PV_MM(B, 3);
#undef PV_RD
#undef PV_MM
#undef PV_WAIT
#undef TRRD
}

__device__ __forceinline__ void pv_tile8(f32x16* o, LAS unsigned char* vt, const int (&va)[4], const i32x8q pa) {
#pragma unroll
    for (int d0 = 0; d0 < 4; ++d0) {
        const auto b0 = __builtin_amdgcn_ds_read_tr8_b64_v2i32((LAS i32x2v*)(vt + va[d0])), b1 = __builtin_amdgcn_ds_read_tr8_b64_v2i32((LAS i32x2v*)(vt + va[d0] + 2048));
        const auto b2 = __builtin_amdgcn_ds_read_tr8_b64_v2i32((LAS i32x2v*)(vt + va[d0] + 4096)), b3 = __builtin_amdgcn_ds_read_tr8_b64_v2i32((LAS i32x2v*)(vt + va[d0] + 6144));
        const i32x8q bb = {b0[0], b0[1], b1[0], b1[1], b2[0], b2[1], b3[0], b3[1]};
        o[d0] = __builtin_amdgcn_mfma_scale_f32_32x32x64_f8f6f4(pa, bb, o[d0], 0, 0, 0, 0, 0, 0); }
}
__device__ __forceinline__ void sb_tile(f32x16& p0, f32x16& p1, float& R, int dq, int hi) {
    const float NEG = -__builtin_inff();
    asm volatile("" : "+v"(dq));
    float g[8];
#define SB_GRP(P, half, i) do { float Lv[4], zv[4];                                                                              \
        _Pragma("unroll") for (int jj = 0; jj < 4; ++jj) { const int c = jj + 8 * (i) + 32 * (half); const bool ok = dq >= c;  \
            const float z = fminf(P[4 * (i) + jj], 80.f); const float e = __builtin_amdgcn_exp2f(z);                               \
            const float sp = __builtin_amdgcn_logf(1.f + e); Lv[jj] = ok ? -sp : 0.f; zv[jj] = ok ? z : NEG; }                      \
        const float s3 = Lv[3], s2 = Lv[2] + s3, s1 = Lv[1] + s2, s0 = Lv[0] + s1;                                                \
        P[4 * (i) + 0] = zv[0] + s0; P[4 * (i) + 1] = zv[1] + s1; P[4 * (i) + 2] = zv[2] + s2; P[4 * (i) + 3] = zv[3] + s3;      \
        g[(half) * 4 + (i)] = s0; } while (0)
    SB_GRP(p0, 0, 0); SB_GRP(p0, 0, 1); SB_GRP(p0, 0, 2); SB_GRP(p0, 0, 3);
    SB_GRP(p1, 1, 0); SB_GRP(p1, 1, 1); SB_GRP(p1, 1, 2); SB_GRP(p1, 1, 3);
#undef SB_GRP
    float c[8], Tk[8];
#pragma unroll
    for (int k = 0; k < 8; ++k) c[k] = pl_sum(g[k]);
    Tk[7] = 0.f;
#pragma unroll
    for (int k = 6; k >= 0; --k) Tk[k] = Tk[k + 1] + c[k + 1];
    const float tot = Tk[0] + c[0];
#pragma unroll
    for (int k = 0; k < 8; ++k) { const float add = R + Tk[k] + (hi == 0 ? (c[k] - g[k]) : 0.f);
#pragma unroll
        for (int jj = 0; jj < 4; ++jj) { if (k < 4) p0[4 * k + jj] = __builtin_amdgcn_exp2f(p0[4 * k + jj] + add); else p1[4 * (k - 4) + jj] = __builtin_amdgcn_exp2f(p1[4 * (k - 4) + jj] + add); } }
    R += tot;
}

template <int MODE>
__device__ __forceinline__ void attn_unit(LAS unsigned char* lds, const bf16_t* Qp, int qpitch, const bf16_t* Kp, const bf16_t* Vp, int kvpitch,
                                          const bf16_t* Rp, const float* cs, bf16_t* Op, int opitch, int q0, const int wid, const int lane) {
    constexpr float SCALE = 0.07216878364870323f / (SQ8 * SK8);
    constexpr float C2 = LOG2E * SCALE, THR = MODE ? 5.f : 8.f, SB_EXIT = 40.f;
    const int r32 = lane & 31, hi = lane >> 5;
    const int qrow = q0 + wid * 32 + r32;
    LAS unsigned char* V_lds = lds + OFF_V; LAS unsigned char* K_lds = lds + OFF_K; LAS unsigned char* R_lds = lds + OFF_R;
    LAS float* wsf = (LAS float*)(lds + OFF_WS) + wid * 64;
    bf16x8 qr[MODE ? 1 : 8]; i32x8q qf[MODE ? 3 : 1]; (void)qr; (void)qf;
    if constexpr (MODE == 0) {
#pragma unroll
        for (int d0 = 0; d0 < 8; ++d0) qr[d0] = *(const bf16x8*)(Qp + (size_t)qrow * qpitch + d0 * 16 + hi * 8);
    } else {
#pragma unroll
        for (int j = 0; j < 3; ++j) {
            const unsigned char* qp8 = (const unsigned char*)Qp + (size_t)qrow * qpitch + j * 64 + hi * 32;
            const u32x4 wa = *(const u32x4*)qp8, wb = *(const u32x4*)(qp8 + 16);
            i32x8q q8 = {(int)wa.x, (int)wa.y, (int)wa.z, (int)wa.w, (int)wb.x, (int)wb.y, (int)wb.z, (int)wb.w};
            if (j == 2) { const float* csr = cs + (size_t)qrow * 64;
                float f[32];
#pragma unroll
                for (int c = 0; c < 8; ++c) { const auto lo2 = __builtin_amdgcn_cvt_pk_f32_fp8(q8[c], false), hi2 = __builtin_amdgcn_cvt_pk_f32_fp8(q8[c], true); f[4 * c] = lo2[0]; f[4 * c + 1] = lo2[1]; f[4 * c + 2] = hi2[0]; f[4 * c + 3] = hi2[1]; }
#pragma unroll
                for (int e = 0; e < 32; ++e) { const float own = f[e]; auto rr = __builtin_amdgcn_permlane32_swap(__float_as_uint(own), __float_as_uint(own), false, false);
                    const float oth = __uint_as_float(hi ? rr[0] : rr[1]); const float co = csr[2 * e], si = csr[2 * e + 1];
                    f[e] = hi ? (own * co + oth * si) : (own * co - oth * si); }
#pragma unroll
                for (int c = 0; c < 8; ++c) q8[c] = (int)pk4_fp8(f[4 * c], f[4 * c + 1], f[4 * c + 2], f[4 * c + 3]); }
            qf[j] = q8; }
    }
    const int NT = q0 / 64 + 4;
    const unsigned vb0 = (unsigned)(size_t)(V_lds) + (unsigned)v_rd_base(lane);
    unsigned koff[2], voff[2], roff;
#pragma unroll
    for (int i = 0; i < 2; ++i) { const int p = (wid * 2 + i) * 64 + lane;
        { const int row = p >> 4, pc = p & 15; koff[i] = (unsigned)(row * kvpitch + ((pc ^ (row & 7)) * 8)); }
        { const int sub = p >> 5, w = p & 31, kk = (sub >> 2) * 8 + (w >> 2), c = (sub & 3) * 32 + (w & 3) * 8, k = (kk & ~0xC) | ((kk & 4) << 1) | ((kk & 8) >> 1); voff[i] = (unsigned)(k * kvpitch + c); } }
    { const int p = wid * 64 + lane, row = p >> 3, pc = p & 7; roff = (unsigned)(row * 64 + ((pc ^ (row & 7)) * 8)); }
    if constexpr (MODE == 1) { const int p = wid * 64 + lane, row = p >> 3, pc = p & 7, sg = pc ^ (row & 7);
        koff[0] = (unsigned)(row * kvpitch + sg * 16);
        roff = (unsigned)(((2 * (row & 31) + (sg >> 2)) * 64) + (sg & 3) * 16); }
    int va8[4]; (void)va8;
    if constexpr (MODE == 1) { const int p = wid * 64 + lane, row = p >> 3, pc = p & 7, sw = (row & 3) | (((row >> 3) & 1) << 2);
        voff[0] = (unsigned)(row * kvpitch + ((pc ^ sw) * 16));
        const int r = (lane & 15) >> 1, pp = lane & 1, gq = (lane >> 4) & 1, row0 = (r & 3) + 8 * (r >> 2) + 4 * hi;
#pragma unroll
        for (int d0 = 0; d0 < 4; ++d0) va8[d0] = row0 * 128 + (((2 * d0 + gq) ^ r) << 4) + 8 * pp; }
#define TILE_OF(it) (MODE ? (it) : (NT - 1 - (it)))
#define STAGE(jt, bf) do { const size_t kb_ = (size_t)(jt) * 64 * kvpitch;                                                                                   \
        if constexpr (MODE == 1) {                                                                                                                           \
            __builtin_amdgcn_global_load_lds((const unsigned*)((const unsigned char*)Kp + kb_ + koff[0]), (LAS unsigned*)(K_lds + (bf) * 8192 + wid * 1024), 16, 0, 0);     \
            if (wid < 4) __builtin_amdgcn_global_load_lds((const unsigned*)((const unsigned char*)Rp + (size_t)(jt) * 64 * 64 + roff), (LAS unsigned*)(R_lds + (bf) * 4096 + wid * 1024), 16, 0, 0); \
            __builtin_amdgcn_global_load_lds((const unsigned*)((const unsigned char*)Vp + kb_ + voff[0]), (LAS unsigned*)(V_lds + (bf) * 8192 + wid * 1024), 16, 0, 0); \
        } else {                                                                                                                                             \
        _Pragma("unroll") for (int i_ = 0; i_ < 2; ++i_) {                                                                                                   \
            __builtin_amdgcn_global_load_lds((const unsigned*)(Kp + kb_ + koff[i_]), (LAS unsigned*)(K_lds + (bf) * SHM_K + (wid * 2 + i_) * 1024), 16, 0, 0);   \
            __builtin_amdgcn_global_load_lds((const unsigned*)(Vp + kb_ + voff[i_]), (LAS unsigned*)(V_lds + (bf) * SHM_V + (wid * 2 + i_) * 1024), 16, 0, 0); } } } while (0)
    float m_reg = -1e30f, l_reg = 0.f, Rrun = 0.f; f32x16 o[4]; bool wdone = false; (void)wdone;
#pragma unroll
    for (int d = 0; d < 4; ++d) o[d] = f32x16{};
    STAGE(TILE_OF(0), 0);
    if constexpr (MODE == 1) STAGE(1, 1);
    __syncthreads();
    for (int it = 0; it < NT; ++it) {
        const int buf = MODE ? (it & 3) : (it & 1), jt = TILE_OF(it), k0 = jt * 64;
        if constexpr (MODE == 1) { if ((it & 1) == 0 && it + 2 < NT) { STAGE(it + 2, (it + 2) & 3); STAGE(it + 3, (it + 3) & 3); } }
        else { if (it + 1 < NT) STAGE(TILE_OF(it + 1), buf ^ 1); }
        if (MODE ? (k0 <= q0 + wid * 32 + 31) : (k0 < q0 + wid * 32 + 31 && !wdone)) {
        f32x16 p0 = f32x16{}, p1 = f32x16{};
        if constexpr (MODE == 1) {
            LAS unsigned char* kb = K_lds + buf * 8192; LAS unsigned char* rb = R_lds + buf * 4096;
#define KF8(base_, row_, colB_) __builtin_shufflevector(*(const LAS i32x4q*)((base_) + RSWZ(row_, colB_)), *(const LAS i32x4q*)((base_) + RSWZ(row_, (colB_) + 16)), 0, 1, 2, 3, 4, 5, 6, 7)
#pragma unroll
            for (int j = 0; j < 2; ++j) { const i32x8q a0 = KF8(kb, r32, 64 * j + 32 * hi), a1 = KF8(kb, r32 + 32, 64 * j + 32 * hi);
                p0 = __builtin_amdgcn_mfma_scale_f32_32x32x64_f8f6f4(a0, qf[j], p0, 0, 0, 0, 0, 0, 0);
                p1 = __builtin_amdgcn_mfma_scale_f32_32x32x64_f8f6f4(a1, qf[j], p1, 0, 0, 0, 0, 0, 0); }
            { const i32x8q a0 = KF8(rb, r32 >> 1, (r32 & 1) * 64 + 32 * hi), a1 = KF8(rb, (r32 >> 1) + 16, (r32 & 1) * 64 + 32 * hi);
                p0 = __builtin_amdgcn_mfma_scale_f32_32x32x64_f8f6f4(a0, qf[2], p0, 0, 0, 0, 0, 0, 0);
                p1 = __builtin_amdgcn_mfma_scale_f32_32x32x64_f8f6f4(a1, qf[2], p1, 0, 0, 0, 0, 0, 0); }
#undef KF8
        } else {
            LAS unsigned char* kb = K_lds + buf * SHM_K;
#pragma unroll
            for (int d0 = 0; d0 < 8; ++d0) { LAS unsigned char* a = kb + KSWZ(r32, ((d0 & 3) * 16 + hi * 8) * 2) + (d0 >> 2) * 128;
                const bf16x8 b0 = *(LAS bf16x8*)a, b1 = *(LAS bf16x8*)(a + 32 * 256);
                p0 = __builtin_amdgcn_mfma_f32_32x32x16_bf16(b0, qr[d0], p0, 0, 0, 0);
                p1 = __builtin_amdgcn_mfma_f32_32x32x16_bf16(b1, qr[d0], p1, 0, 0, 0); }
        }
        bf16x8 pa0, pa1, pa2, pa3;
        if constexpr (MODE == 0) {
            sb_tile(p0, p1, Rrun, qrow - 1 - k0 - 4 * hi, hi);
        } else {
            const float NEG = -__builtin_inff();
            if (k0 + 63 > q0 + wid * 32) {
                int dq = qrow - k0 - 4 * hi; asm volatile("" : "+v"(dq));
#pragma unroll
                for (int r = 0; r < 16; ++r) { const int c = (r & 3) + 8 * (r >> 2); if (dq < c) p0[r] = NEG; if (dq < c + 32) p1[r] = NEG; }
            }
            float pmax = p0[0];
#pragma unroll
            for (int r = 1; r < 16; ++r) pmax = fmaxf(pmax, p0[r]);
#pragma unroll
            for (int r = 0; r < 16; ++r) pmax = fmaxf(pmax, p1[r]);
            pmax = pl_max(pmax);
            float mn, alpha;
            if (__all((pmax - m_reg) * SCALE <= THR)) { mn = m_reg; alpha = 1.f; }
            else { mn = fmaxf(m_reg, pmax); alpha = __builtin_amdgcn_exp2f((m_reg - mn) * C2); m_reg = mn; }
            const float mnL = -mn * C2;
#pragma unroll
            for (int r = 0; r < 16; ++r) { p0[r] = __builtin_amdgcn_exp2f(fmaf(p0[r], C2, mnL)); p1[r] = __builtin_amdgcn_exp2f(fmaf(p1[r], C2, mnL)); }
            float ps = 0.f;
#pragma unroll
            for (int r = 0; r < 16; ++r) ps += p0[r] + p1[r];
            ps = pl_sum(ps);
            l_reg = l_reg * alpha + ps;
            if (__any(alpha < 1.f)) { if (hi == 0) wsf[r32] = alpha; LDS_WAIT();
#pragma unroll
                for (int r = 0; r < 16; ++r) { const float al = wsf[crow(r, hi)];
#pragma unroll
                    for (int d = 0; d < 4; ++d) o[d][r] *= al; } }
        }
        if constexpr (MODE == 1) { i32x8q pa;
#pragma unroll
            for (int c = 0; c < 4; ++c) { pa[c] = (int)pk4_fp8(p0[4 * c], p0[4 * c + 1], p0[4 * c + 2], p0[4 * c + 3]); pa[4 + c] = (int)pk4_fp8(p1[4 * c], p1[4 * c + 1], p1[4 * c + 2], p1[4 * c + 3]); }
            pv_tile8(o, V_lds + buf * 8192, va8, pa);
        } else {
        PK4(p0, 0, pa0); PK4(p0, 8, pa1); PK4(p1, 0, pa2); PK4(p1, 8, pa3);
        SBAR();
        pv_tile(o, vb0 + buf * SHM_V, pa0, pa1, pa2, pa3); }
        }
        if constexpr (MODE == 0) {
            wdone = __all(Rrun < -SB_EXIT);
            if (lane == 0) wsf[40 + (it & 1)] = wdone ? 1.f : 0.f;
            __syncthreads();
            LAS float* wsa = (LAS float*)(lds + OFF_WS) + 40 + (it & 1);
            const float allf = wsa[0] * wsa[64] * wsa[128] * wsa[192] * wsa[256] * wsa[320] * wsa[384] * wsa[448];
            if (allf != 0.f) break;
        } else {
            if (it & 1) __syncthreads();
        }
    }
    if constexpr (MODE == 1) { if (hi == 0) wsf[r32] = l_reg; LDS_WAIT(); }
    if constexpr (MODE == 1) {
        GAS unsigned char* Ow = (GAS unsigned char*)Op + (size_t)(q0 + wid * 32) * opitch; asm volatile("" : "+s"(Ow));
        int hio = hi; asm volatile("" : "+v"(hio));
#pragma unroll
        for (int r = 0; r < 16; ++r) { const int orow = crow(r, hio); const float inv = __builtin_amdgcn_rcpf(wsf[orow]) * (SO8 / SV8);
#pragma unroll
            for (int d0 = 0; d0 < 4; ++d0) { const float v = o[d0][r] * inv; const float v1 = quad_f32<0xB1>(v), v2 = quad_f32<0x4E>(v), v3 = quad_f32<0x1B>(v);
                if ((r32 & 3) == 0) *(GAS unsigned*)(Ow + (size_t)orow * opitch + d0 * 32 + r32) = pk4_fp8(v, v1, v2, v3); } }
    } else {
    GAS unsigned char* Ow = (GAS unsigned char*)Op + (size_t)(q0 + wid * 32) * opitch; asm volatile("" : "+s"(Ow));
    int hio = hi; asm volatile("" : "+v"(hio));
#pragma unroll
    for (int r = 0; r < 16; ++r) { const int orow = crow(r, hio);
#pragma unroll
        for (int d0 = 0; d0 < 4; ++d0) { const float v = o[d0][r] * SO8S; const float v1 = quad_f32<0xB1>(v), v2 = quad_f32<0x4E>(v), v3 = quad_f32<0x1B>(v);
            if ((r32 & 3) == 0) *(GAS unsigned*)(Ow + (size_t)orow * opitch + d0 * 32 + r32) = pk4_fp8(v, v1, v2, v3); } }
    }
    __syncthreads();
#undef TILE_OF
#undef STAGE
}
}

#define XB_TMO      128
#define XB_XCNT(j)  (256  + 64 * (j))
#define XB_XSUB(j)  (1280 + 64 * (j))
#define XB_XGEN(j)  (2304 + 64 * (j))
#define XB_TOP      3328
#define XB_TOPGEN   3392
#define XCD_BAR_WORDS 3456
#define XB_SPIN_CAP (1u << 22)
__device__ __forceinline__ unsigned xb_ld(unsigned* p)              { return __hip_atomic_load(p, __ATOMIC_RELAXED, __HIP_MEMORY_SCOPE_AGENT); }
__device__ __forceinline__ unsigned xb_add(unsigned* p, unsigned v) { return __hip_atomic_fetch_add(p, v, __ATOMIC_RELAXED, __HIP_MEMORY_SCOPE_AGENT); }
__device__ __forceinline__ unsigned xb_xcc_id() { return (unsigned)__builtin_amdgcn_s_getreg((3 << 11) | 20) & 0xFu; }
#define XB_SPIN(cond, bar) do { unsigned _sp = 0; while (cond) { __builtin_amdgcn_s_sleep(1); \
    if ((++_sp & 255u) == 0u) { if (xb_ld(&(bar)[XB_TMO])) break; if (_sp > XB_SPIN_CAP) { atomicAdd(&(bar)[XB_TMO], 1u); break; } } } } while (0)
struct XcdBarrier { unsigned* bar; unsigned x; volatile LAS unsigned* st; };
__device__ __forceinline__ XcdBarrier xcd_barrier_post(unsigned* bar, volatile LAS unsigned* st) {
    XcdBarrier b; b.bar = bar; b.x = xb_xcc_id(); b.st = st;
    if (threadIdx.x == 0) (void)xb_add(&bar[XB_XCNT(b.x)], 1u);
    return b;
}
__device__ __forceinline__ void xcd_barrier_complete(unsigned* bar, unsigned x, unsigned& nloc, unsigned& nx) {
    const unsigned G = gridDim.x * gridDim.y * gridDim.z;
    unsigned sum, cnt, mine, sp = 0u;
    for (;;) {
        sum = 0u; cnt = 0u; mine = 0u;
#pragma unroll
        for (unsigned j = 0; j < 16; ++j) { const unsigned c = xb_ld(&bar[XB_XCNT(j)]); sum += c; cnt += (c > 0u) ? 1u : 0u; mine = (j == x) ? c : mine; }
        if (sum == G) break;
        __builtin_amdgcn_s_sleep(1);
        if ((++sp & 255u) == 0u) { if (xb_ld(&bar[XB_TMO])) break; if (sp > XB_SPIN_CAP) { atomicAdd(&bar[XB_TMO], 1u); break; } }
    }
    nloc = mine > 0u ? mine : 1u; nx = cnt > 0u ? cnt : 1u;
}
__device__ __forceinline__ void xcd_barrier(const XcdBarrier& b, const int wave) {
    asm volatile("s_waitcnt vmcnt(0)" ::: "memory");
    __syncthreads();
    if (wave == 0 && lane_id_v() == 0) {
        unsigned* bar = b.bar;
        __builtin_amdgcn_s_waitcnt(0);
        unsigned nloc = b.st[0], nx = b.st[1];
        if (nloc == 0u) { xcd_barrier_complete(bar, b.x, nloc, nx); b.st[0] = nloc; b.st[1] = nx; }
        const unsigned old = xb_add(&bar[XB_XSUB(b.x)], 1u);
        const unsigned gen = old / nloc;
        if (old + 1u == (gen + 1u) * nloc) {
            __builtin_amdgcn_fence(__ATOMIC_RELEASE, "agent");
            asm volatile("s_waitcnt vmcnt(0)" ::: "memory");
            const unsigned og = xb_add(&bar[XB_TOP], 1u);
            const unsigned tg = og / nx;
            if (og + 1u == (tg + 1u) * nx) xb_add(&bar[XB_TOPGEN], 1u);
            else XB_SPIN(xb_ld(&bar[XB_TOPGEN]) == tg, bar);
            __builtin_amdgcn_fence(__ATOMIC_ACQUIRE, "agent");
            xb_add(&bar[XB_XGEN(b.x)], 1u);
            asm volatile("s_waitcnt vmcnt(0)" ::: "memory");
        } else {
            XB_SPIN(xb_ld(&bar[XB_XGEN(b.x)]) == gen, bar);
            __builtin_amdgcn_fence(__ATOMIC_ACQUIRE, "agent");
            asm volatile("s_waitcnt vmcnt(0)" ::: "memory");
        }
    }
    __syncthreads();
}

constexpr int RING_BYTES = 131072, MISC_OFF = RING_BYTES + 320, LDS_BYTES = 155648;
static_assert(att::LDS_BYTES <= RING_BYTES, "attention LDS");

struct Args { const void* in[21]; float* out; unsigned char* ws; int ph_lo, ph_hi; };
enum { IN_X = 0, IN_POS, IN_SBG, IN_WQKV, IN_WO, IN_KVG, IN_WDKV, IN_KVLG, IN_WUKV, IN_MLAG, IN_WDQ, IN_QLG, IN_WUQ, IN_WMO, IN_PG, IN_PWQ, IN_PK1, IN_PK2, IN_PU, IN_PV, IN_FG };

template <bool F8 = false>
__device__ __forceinline__ void transpose_item(const float* W, int ldw, int K, int nblk, const float* gain, bf16_t* WT, int row_off, LAS float* scr, int item, int lane) {
    const int kb = item / nblk, nb = item % nblk, k0 = 64 * kb, n0 = 32 * nb;
#pragma unroll
    for (int i = 0; i < 8; ++i) { const int kk = 8 * i + (lane >> 3), c4 = (lane & 7) * 4; const float gv = gain ? gain[k0 + kk] : 1.f;
        const f32x4 wv = *(const f32x4*)(W + (size_t)(k0 + kk) * ldw + n0 + c4);
        scr[kk * 33 + c4] = wv[0] * gv; scr[kk * 33 + c4 + 1] = wv[1] * gv; scr[kk * 33 + c4 + 2] = wv[2] * gv; scr[kk * 33 + c4 + 3] = wv[3] * gv; }
    LDS_WAIT(); asm volatile("" ::: "memory");
    const int c = lane & 7;
#pragma unroll
    for (int j = 0; j < 4; ++j) { const int n = (lane >> 3) + 8 * j; const LAS float* s = scr + (8 * c) * 33 + n;
        if constexpr (F8) { u32x2 o; o.x = pk4_fp8(s[0 * 33] * SWT8, s[1 * 33] * SWT8, s[2 * 33] * SWT8, s[3 * 33] * SWT8); o.y = pk4_fp8(s[4 * 33] * SWT8, s[5 * 33] * SWT8, s[6 * 33] * SWT8, s[7 * 33] * SWT8);
            *(u32x2*)((unsigned char*)WT + (size_t)(row_off + n0 + n) * K + k0 + 8 * c) = o; }
        else { u32x4 o; o.x = pk2(s[0 * 33], s[1 * 33]); o.y = pk2(s[2 * 33], s[3 * 33]); o.z = pk2(s[4 * 33], s[5 * 33]); o.w = pk2(s[6 * 33], s[7 * 33]);
            *(u32x4*)(WT + (size_t)(row_off + n0 + n) * K + k0 + 8 * c) = o; } }
    LDS_WAIT(); asm volatile("" ::: "memory");
}

__device__ __forceinline__ void convert_tables8(const float* u, const float* v, const float* g, unsigned char* TU, unsigned char* TV, int gtid, int gthreads) {
    const size_t n32 = (size_t)NEXP * DM / 32;
    for (size_t i = gtid; i < n32; i += gthreads) { const int d = (int)((i * 32) % DM); const size_t e = (i * 32) / DM;
        const size_t dst = ((size_t)(d >> 8) * NEXP + e) * 128 + ((d & 255) >> 1);
        u32x4 w;
#pragma unroll
        for (int k = 0; k < 4; ++k) { const int cb = (k & 1) * 4 + (k >> 1) * 16;
            const f32x4 lo = *(const f32x4*)(u + i * 32 + cb), hi = *(const f32x4*)(u + i * 32 + cb + 8), gl = *(const f32x4*)(g + d + cb), gh = *(const f32x4*)(g + d + cb + 8);
            unsigned wd = 0u;
#pragma unroll
            for (int b = 0; b < 4; ++b) { const unsigned cl = (unsigned)(int)rintf(fminf(fmaxf(lo[b] * gl[b] * SU4 + UOFF, 0.f), 15.f)), ch = (unsigned)(int)rintf(fminf(fmaxf(hi[b] * gh[b] * SU4 + UOFF, 0.f), 15.f));
                wd |= (cl | (ch << 4)) << (8 * b); }
            w[k] = wd; }
        *(u32x4*)(TU + dst) = w;
        u32x4 x;
#pragma unroll
        for (int q = 0; q < 4; ++q) { const f32x4 b0 = *(const f32x4*)(v + i * 32 + q * 8), b1 = *(const f32x4*)(v + i * 32 + q * 8 + 4); unsigned wd = 0u;
#pragma unroll
            for (int b = 0; b < 4; ++b) { const unsigned cc = (unsigned)(int)rintf(fminf(fmaxf(b0[b] * SVQ + UOFF, 0.f), 15.f)), cd = (unsigned)(int)rintf(fminf(fmaxf(b1[b] * SVQ + UOFF, 0.f), 15.f));
                wd |= (cc << (4 * b)) | (cd << (16 + 4 * b)); }
            x[q] = wd; }
        *(u32x4*)(TV + dst) = x; }
}
__device__ __forceinline__ void row_to_bf16_rstd(const float* xrow, bf16_t* orow, float* rstd_out, int lane, unsigned char* x8row = nullptr) {
    f32x4 v[8]; float s = 0.f;
#pragma unroll
    for (int j = 0; j < 8; ++j) { v[j] = *(const f32x4*)(xrow + j * 256 + lane * 4); s += v[j][0] * v[j][0] + v[j][1] * v[j][1] + v[j][2] * v[j][2] + v[j][3] * v[j][3]; }
    s = wave_sum(s);
#pragma unroll
    for (int j = 0; j < 8; ++j) { u32x2 w; w.x = pk2(v[j][0], v[j][1]); w.y = pk2(v[j][2], v[j][3]); *(u32x2*)(orow + j * 256 + lane * 4) = w;
        if (x8row) *(unsigned*)(x8row + j * 256 + lane * 4) = pk4_fp8(v[j][0] * SX8, v[j][1] * SX8, v[j][2] * SX8, v[j][3] * SX8); }
    if (lane == 0) *rstd_out = 1.f / sqrtf(s * (1.f / DM) + EPS);
}

template <int CTRL> __device__ __forceinline__ unsigned dpp_u32(unsigned x) { return (unsigned)__builtin_amdgcn_update_dpp(0, (int)x, CTRL, 0xF, 0xF, false); }
template <int CTRL> __device__ __forceinline__ float dpp_f32(float x) { return __int_as_float(__builtin_amdgcn_update_dpp(0, __float_as_int(x), CTRL, 0xF, 0xF, false)); }
__device__ __forceinline__ unsigned umax(unsigned a, unsigned b) { return a > b ? a : b; }
__device__ __forceinline__ unsigned umin(unsigned a, unsigned b) { return a < b ? a : b; }
__device__ __forceinline__ unsigned row_allmax(unsigned x) { x = umax(x, dpp_u32<0xB1>(x)); x = umax(x, dpp_u32<0x4E>(x)); x = umax(x, dpp_u32<0x124>(x)); x = umax(x, dpp_u32<0x128>(x)); return x; }
__device__ __forceinline__ float row_allsum(float x) { x += dpp_f32<0xB1>(x); x += dpp_f32<0x4E>(x); x += dpp_f32<0x124>(x); x += dpp_f32<0x128>(x); return x; }


__device__ __forceinline__ void rows4_bf16_to_rstd_x8(const bf16_t* XSb, float* rstd, unsigned char* X8b, float* xsum, const int m0, const int mstep, const int lane) {
    u32x4 w[4][4];
#pragma unroll
    for (int r = 0; r < 4; ++r)
#pragma unroll
        for (int j = 0; j < 4; ++j) w[r][j] = *(const u32x4*)(XSb + (size_t)(m0 + r * mstep) * DM + j * 512 + lane * 8);
#pragma unroll
    for (int r = 0; r < 4; ++r) { float s = 0.f, sx = 0.f; unsigned char* x8row = X8b + (size_t)(m0 + r * mstep) * DM;
#pragma unroll
        for (int j = 0; j < 4; ++j) { const u32x4 ww = w[r][j];
            const float v0 = bflo(ww.x), v1 = bfhi(ww.x), v2 = bflo(ww.y), v3 = bfhi(ww.y), v4 = bflo(ww.z), v5 = bfhi(ww.z), v6 = bflo(ww.w), v7 = bfhi(ww.w);
            s += v0 * v0 + v1 * v1 + v2 * v2 + v3 * v3 + v4 * v4 + v5 * v5 + v6 * v6 + v7 * v7;
            u32x2 o; o.x = pk4_fp8(v0 * SX8, v1 * SX8, v2 * SX8, v3 * SX8); o.y = pk4_fp8(v4 * SX8, v5 * SX8, v6 * SX8, v7 * SX8); *(u32x2*)(x8row + j * 512 + lane * 8) = o;
            const auto d0 = __builtin_amdgcn_cvt_pk_f32_fp8((int)o.x, false), d1 = __builtin_amdgcn_cvt_pk_f32_fp8((int)o.x, true), d2 = __builtin_amdgcn_cvt_pk_f32_fp8((int)o.y, false), d3 = __builtin_amdgcn_cvt_pk_f32_fp8((int)o.y, true);
            sx += ((d0[0] + d0[1]) + (d1[0] + d1[1])) + ((d2[0] + d2[1]) + (d3[0] + d3[1])); }
        s = wave_sum(s); sx = wave_sum(sx);
        if (lane == 0) { rstd[m0 + r * mstep] = 1.f / sqrtf(s * (1.f / DM) + EPS); xsum[m0 + r * mstep] = sx; } }
}
__device__ __forceinline__ void row_bf16_to_rstd_x8(const bf16_t* xrow, float* rstd_out, int lane, unsigned char* x8row, float* xsum_out) {
    float s = 0.f, sx = 0.f;
#pragma unroll
    for (int j = 0; j < 4; ++j) { const u32x4 w = *(const u32x4*)(xrow + j * 512 + lane * 8);
        const float v0 = bflo(w.x), v1 = bfhi(w.x), v2 = bflo(w.y), v3 = bfhi(w.y), v4 = bflo(w.z), v5 = bfhi(w.z), v6 = bflo(w.w), v7 = bfhi(w.w);
        s += v0 * v0 + v1 * v1 + v2 * v2 + v3 * v3 + v4 * v4 + v5 * v5 + v6 * v6 + v7 * v7;
        u32x2 o; o.x = pk4_fp8(v0 * SX8, v1 * SX8, v2 * SX8, v3 * SX8); o.y = pk4_fp8(v4 * SX8, v5 * SX8, v6 * SX8, v7 * SX8); *(u32x2*)(x8row + j * 512 + lane * 8) = o;
        const auto d0 = __builtin_amdgcn_cvt_pk_f32_fp8((int)o.x, false), d1 = __builtin_amdgcn_cvt_pk_f32_fp8((int)o.x, true), d2 = __builtin_amdgcn_cvt_pk_f32_fp8((int)o.y, false), d3 = __builtin_amdgcn_cvt_pk_f32_fp8((int)o.y, true);
        sx += ((d0[0] + d0[1]) + (d1[0] + d1[1])) + ((d2[0] + d2[1]) + (d3[0] + d3[1])); }
    s = wave_sum(s); sx = wave_sum(sx);
    if (lane == 0) { *rstd_out = 1.f / sqrtf(s * (1.f / DM) + EPS); *xsum_out = sx; }
}
template <int layer>
__device__ __forceinline__ void peer_gather(LAS unsigned char* lds, unsigned char* ws, float* X, bf16_t* XS, float* rstd, const float* fg, const int wave, const int lane, const int bx, unsigned long long& tp0, unsigned long long& tp1) {
    constexpr int GOFF = 0, GPW = 65536, GSS = 131072 + 1024;
    const unsigned char* TU = ws + WS_TU8 + (size_t)layer * 64 * MiB; const unsigned char* TV = ws + WS_TV8 + (size_t)layer * 64 * MiB; const unsigned char* X8 = ws + WS_X8;
    const int* IDS = (const int*)(ws + WS_IDS); const float* GT = (const float*)(ws + WS_GATE);
    const int tw0 = wave * 16, t0 = bx * 128;
    for (int tt = 0; tt < 16; ++tt) { const int tl = tw0 + tt; const size_t t = (size_t)(t0 + tl);
#pragma unroll
        for (int k = 0; k < 2; ++k) { const int p = lane + 64 * k; const int id = IDS[t * NSEL + p];
            *(LAS unsigned*)(lds + GOFF + (tl * 128 + p) * 4) = (unsigned)id * 128u; *(LAS float*)(lds + GPW + (tl * 128 + p) * 4) = 0.f; }
        if (lane < 8) *(LAS float*)(lds + GSS + (tl * 8 + lane) * 4) = 0.f; }
    LDS_WAIT();
    if (PROBE_SUB == 1 && layer == 1) tp0 = __builtin_amdgcn_s_memrealtime();
    constexpr size_t SLAB = (size_t)NEXP * 128;
    struct USet { u32x4 ua[16], h0, h1; };
    {
        const int r = lane & 15, q = lane >> 4;
#define U_ISSUE(S_, n_) do { const int kc_ = (n_) >> 4, tl_ = tw0 + ((n_) & 15); const unsigned char* slab_ = TU + (size_t)kc_ * SLAB; const unsigned lo_ = (unsigned)((r & 1) * 64 + q * 16);               \
            { const unsigned char* xp_ = X8 + (size_t)(t0 + tl_) * DM + kc_ * 256 + (r >> 3) * 128 + q * 32; S_.h0 = *(const u32x4*)xp_; S_.h1 = *(const u32x4*)(xp_ + 16); }            \
            _Pragma("unroll") for (int G_ = 0; G_ < 16; ++G_) S_.ua[G_] = *(const u32x4*)(slab_ + (size_t)(*(LAS unsigned*)(lds + GOFF + (tl_ * 128 + G_ * 8 + (r >> 1)) * 4) + lo_)); } while (0)
#define U64(v_, a_, b_) ((long)(((unsigned long long)(v_).b_ << 32) | (v_).a_))
#define UPK(lo_, hi_) ((long)(((unsigned long long)(hi_) << 32) | (lo_)))
        constexpr unsigned NM = 0x0F0F0F0Fu;
#define U_COMPUTE(S_, n_) do { const int tl_ = tw0 + ((n_) & 15);                                                                                                                  \
            _Pragma("unroll") for (int hg = 0; hg < 2; ++hg) { f32x2 sel_ = {0.f, 0.f};                                                                                             \
                _Pragma("unroll") for (int g8 = 0; g8 < 8; ++g8) { f32x4 c = {0.f, 0.f, 0.f, 0.f};                                                                                  \
                    const u32x4 X_ = S_.ua[hg * 8 + g8];                                                                                                                           \
                    c = __builtin_amdgcn_mfma_f32_16x16x32_fp8_fp8(UPK(X_.x & NM, X_.y & NM), U64(S_.h0, x, y), c, 0, 0, 0); c = __builtin_amdgcn_mfma_f32_16x16x32_fp8_fp8(UPK((X_.x >> 4) & NM, (X_.y >> 4) & NM), U64(S_.h0, z, w), c, 0, 0, 0); \
                    c = __builtin_amdgcn_mfma_f32_16x16x32_fp8_fp8(UPK(X_.z & NM, X_.w & NM), U64(S_.h1, x, y), c, 0, 0, 0); c = __builtin_amdgcn_mfma_f32_16x16x32_fp8_fp8(UPK((X_.z >> 4) & NM, (X_.w >> 4) & NM), U64(S_.h1, z, w), c, 0, 0, 0); \
                    const float c0 = c[0] + dpp_f32<0x128>(c[1]), c1 = c[2] + dpp_f32<0x128>(c[3]); const bool pick = (r == g8); sel_[0] = pick ? c0 : sel_[0]; sel_[1] = pick ? c1 : sel_[1]; } \
                if (r < 8) { LAS f32x2* p = (LAS f32x2*)(lds + GPW + (tl_ * 128 + (hg * 8 + r) * 8 + 2 * q) * 4); f32x2 v0 = *p; v0 += sel_; *p = v0; } } } while (0)
        USet A, B;
        U_ISSUE(A, 0);
#pragma unroll 1
        for (int n = 0; n < 128; n += 2) {
            U_ISSUE(B, n + 1);
            U_COMPUTE(A, n);
            { const int nn = n + 2 < 128 ? n + 2 : 126; U_ISSUE(A, nn); }
            U_COMPUTE(B, n + 1);
        }
#undef U_ISSUE
#undef U_COMPUTE
#undef U64
#undef UPK
    }
    LDS_WAIT();
    if (PROBE_SUB == 1 && layer == 1) { __syncthreads(); tp1 = __builtin_amdgcn_s_memrealtime(); }
    constexpr int GW8 = 137216, GWS = 153600;
    for (int tt = 0; tt < 16; ++tt) { const int tl = tw0 + tt; const size_t t = (size_t)(t0 + tl); const float rs = rstd[t] * (1.f / (SU4 * SX8)), xoff = UOFF * ((const float*)(ws + WS_XSUM))[t];
        float wsa = 0.f;
#pragma unroll
        for (int k = 0; k < 2; ++k) { const int p = lane + 64 * k;
            const float dd = (*(LAS float*)(lds + GPW + (tl * 128 + p) * 4) * 512.f - xoff) * rs;
            const float wv = GT[t * NSEL + p] * 0.5f * dd * (1.f + erff(dd * 0.7071067811865476f)) * SW8;
            const int b8 = __builtin_amdgcn_cvt_pk_fp8_f32(fminf(fmaxf(wv, -448.f), 448.f), 0.f, 0, false) & 0xff; wsa += __builtin_amdgcn_cvt_f32_fp8(b8, 0);
            const int gq = p >> 4, ii = p & 15;
            *(LAS unsigned char*)(lds + GW8 + tl * 128 + (ii >> 2) * 32 + (ii & 3) * 8 + gq) = (unsigned char)b8; }
        wsa = wave_sum(wsa); if (lane == 0) *(LAS float*)(lds + GWS + tl * 4) = wsa; }
    LDS_WAIT();
    struct VSet { u32x4 vv[16]; };
    {
        const int g = lane >> 3, sub = lane & 7, q4 = lane >> 4, n16 = lane & 15, r8 = n16 >> 1, c2 = lane & 1;
        const int sb = GPW + wave * 8192;
        const int wa = sb + g * 128 + ((sub ^ g) << 4);
        int ta[8];
#pragma unroll
        for (int cb = 0; cb < 8; ++cb) ta[cb] = sb + (8 * q4 + r8) * 128 + ((cb ^ r8) << 4) + 8 * c2;
        constexpr unsigned NM = 0x0F0F0F0Fu;
#define UPK(lo_, hi_) ((long)(((unsigned long long)(hi_) << 32) | (lo_)))
#define V_ISSUE(S_, n_) do { const int dc_ = (n_) >> 4, tl_ = tw0 + ((n_) & 15); const unsigned char* slab_ = TV + (size_t)dc_ * SLAB; u32x4 of_[4];     \
            _Pragma("unroll") for (int z = 0; z < 4; ++z) of_[z] = *(LAS u32x4*)(lds + GOFF + (tl_ * 128 + g * 16 + z * 4) * 4); \
            _Pragma("unroll") for (int i = 0; i < 16; ++i) S_.vv[i] = *(const u32x4*)(slab_ + (size_t)(of_[i >> 2][i & 3] + (unsigned)(sub * 16))); } while (0)
#define V_XADDR(n_) (XS + (size_t)(t0 + tw0 + ((n_) & 15)) * DM + ((n_) >> 4) * 256 + 64 * q4 + 2 * n16)
#define V_COMPUTE(S_, n_, XA_, XB_) do { const int tl_ = tw0 + ((n_) & 15); f32x4 acl[8], ach[8];                                                                               \
            _Pragma("unroll") for (int c = 0; c < 8; ++c) { acl[c] = (f32x4){0.f, 0.f, 0.f, 0.f}; ach[c] = (f32x4){0.f, 0.f, 0.f, 0.f}; }                                           \
            _Pragma("unroll") for (int kb = 0; kb < 4; ++kb) { const int bo_ = (kb & 1) * 4096;                                                                                     \
                _Pragma("unroll") for (int ii = 0; ii < 4; ++ii) *(LAS u32x4*)(lds + wa + bo_ + ii * 1024) = S_.vv[4 * kb + ii];                                                    \
                const long aw_ = *(const LAS long*)(lds + GW8 + tl_ * 128 + kb * 32 + q4 * 8);                                                                                       \
                _Pragma("unroll") for (int cb = 0; cb < 8; ++cb) { const auto B_ = __builtin_amdgcn_ds_read_tr8_b64_v2i32((LAS i32x2v*)(lds + ta[cb] + bo_));                      \
                    const unsigned bx_ = (unsigned)B_[0], by_ = (unsigned)B_[1];                                                                                                    \
                    acl[cb] = __builtin_amdgcn_mfma_f32_16x16x32_fp8_fp8(aw_, UPK(bx_ & NM, by_ & NM), acl[cb], 0, 0, 0);                                                            \
                    ach[cb] = __builtin_amdgcn_mfma_f32_16x16x32_fp8_fp8(aw_, UPK((bx_ >> 4) & NM, (by_ >> 4) & NM), ach[cb], 0, 0, 0); } }                                          \
            { const float wof_ = UOFF * *(LAS float*)(lds + GWS + tl_ * 4);                                                                                                         \
                const float a0 = q4 == 0 ? acl[0][0] : q4 == 1 ? acl[2][0] : q4 == 2 ? acl[4][0] : acl[6][0], a1 = q4 == 0 ? ach[0][0] : q4 == 1 ? ach[2][0] : q4 == 2 ? ach[4][0] : ach[6][0]; \
                const float a2 = q4 == 0 ? acl[1][0] : q4 == 1 ? acl[3][0] : q4 == 2 ? acl[5][0] : acl[7][0], a3 = q4 == 0 ? ach[1][0] : q4 == 1 ? ach[3][0] : q4 == 2 ? ach[5][0] : ach[7][0]; \
                constexpr float SC_ = 1.f / (SW8 * SVQ);                                                                                                                            \
                const unsigned xa_ = XA_, xb_ = XB_; bf16_t* xp_ = V_XADDR(n_);                                                                                                     \
                const unsigned w0_ = cvtpk(bflo(xa_) + (a0 * 512.f - wof_) * SC_, bfhi(xa_) + (a1 * 512.f - wof_) * SC_), w1_ = cvtpk(bflo(xb_) + (a2 * 512.f - wof_) * SC_, bfhi(xb_) + (a3 * 512.f - wof_) * SC_); \
                *(unsigned*)xp_ = w0_; *(unsigned*)(xp_ + 32) = w1_;                                                                                                                \
                if (layer == 0) { unsigned char* x8_ = (unsigned char*)X8 + (xp_ - XS);     \
                    *(unsigned short*)x8_ = (unsigned short)__builtin_amdgcn_cvt_pk_fp8_f32(bflo(w0_) * SX8, bfhi(w0_) * SX8, 0, false); *(unsigned short*)(x8_ + 32) = (unsigned short)__builtin_amdgcn_cvt_pk_fp8_f32(bflo(w1_) * SX8, bfhi(w1_) * SX8, 0, false); } \
                const float y0 = bflo(w0_), y1 = bfhi(w0_), y2 = bflo(w1_), y3 = bfhi(w1_);                    \
                const float ssq = row_allsum(y0 * y0 + y1 * y1 + y2 * y2 + y3 * y3);                                                                                                \
                if (n16 == 0) { LAS float* sp = (LAS float*)(lds + GSS + (tl_ * 8 + q4) * 4); *sp += ssq; } } } while (0)
        VSet A, B;
        V_ISSUE(A, 0);
#pragma unroll 1
        for (int n = 0; n < 128; n += 2) {
            const unsigned xa0 = *(const unsigned*)V_XADDR(n), xa1 = *(const unsigned*)(V_XADDR(n) + 32);
            V_ISSUE(B, n + 1);
            V_COMPUTE(A, n, xa0, xa1);
            const unsigned xb0 = *(const unsigned*)V_XADDR(n + 1), xb1 = *(const unsigned*)(V_XADDR(n + 1) + 32);
            { const int nn = n + 2 < 128 ? n + 2 : 126; V_ISSUE(A, nn); }
            V_COMPUTE(B, n + 1, xb0, xb1);
        }
#undef V_ISSUE
#undef V_COMPUTE
#undef V_XADDR
#undef UPK
    }
    LDS_WAIT(); VM_WAIT();
    if (PROBE_SUB == 2 && layer == 1) { __syncthreads(); tp1 = __builtin_amdgcn_s_memrealtime(); }
    u32x4 wnx[4];
    if (layer == 1) {
#pragma unroll
        for (int j = 0; j < 4; ++j) wnx[j] = __builtin_nontemporal_load((const u32x4*)(XS + (size_t)(t0 + tw0) * DM + j * 512 + lane * 8)); }
    for (int tt = 0; tt < 16; ++tt) { const int tl = tw0 + tt; const size_t t = (size_t)(t0 + tl);
        float ss = (lane < 8) ? *(LAS float*)(lds + GSS + (tl * 8 + lane) * 4) : 0.f; ss = wave_sum(ss);
        const float rn = 1.f / sqrtf(ss * (1.f / DM) + EPS);
        if (layer == 0) { if (lane == 0) rstd[t] = rn; }
        else {
            u32x4 wcur[4];
#pragma unroll
            for (int j = 0; j < 4; ++j) wcur[j] = wnx[j];
            { const size_t tn = t + (tt < 15 ? 1 : 0);
#pragma unroll
              for (int j = 0; j < 4; ++j) wnx[j] = __builtin_nontemporal_load((const u32x4*)(XS + tn * DM + j * 512 + lane * 8)); }
#pragma unroll
            for (int j = 0; j < 4; ++j) { const u32x4 w = wcur[j]; const float* gp = fg + j * 512 + lane * 8; const f32x4 g0 = *(const f32x4*)gp, g1 = *(const f32x4*)(gp + 4);
                float* xr = X + t * DM + j * 512 + lane * 8;
                *(f32x4*)xr = (f32x4){bflo(w.x) * rn * g0[0], bfhi(w.x) * rn * g0[1], bflo(w.y) * rn * g0[2], bfhi(w.y) * rn * g0[3]};
                *(f32x4*)(xr + 4) = (f32x4){bflo(w.z) * rn * g1[0], bfhi(w.z) * rn * g1[1], bflo(w.w) * rn * g1[2], bfhi(w.w) * rn * g1[3]}; } }
    }
}

__device__ __forceinline__ unsigned f2ord(float f) { unsigned u = __float_as_uint(f); return u ^ ((u >> 31) ? 0xffffffffu : 0x80000000u); }
__device__ __forceinline__ float ord2f(unsigned u) { return __uint_as_float(u ^ ((u >> 31) ? 0x80000000u : 0xffffffffu)); }
__device__ __forceinline__ void peer_topk(const _Float16* SC, int* IDS, float* GT, const int lane, const int wave, const int G, const int bx) {
    pg8::StaticOrder SO; SO.init(T, DM, G, bx);
    const int l16 = lane & 15, row = (lane >> 4) & 1, L = lane & 31, base32 = lane & 32;
    int ci[2], cj[2]; bool cv[2];
#pragma unroll
    for (int sl = 0; sl < 2; ++sl) { const int n = L + 32 * sl; int i_, j_; bool v = true;
        if (n < 16) { i_ = 0; j_ = n; } else if (n < 24) { i_ = 1; j_ = n - 16; } else if (n < 29) { i_ = 2; j_ = n - 24; } else if (n < 33) { i_ = 3; j_ = n - 29; }
        else if (n < 36) { i_ = 4; j_ = n - 33; } else if (n < 42) { i_ = 5 + ((n - 36) >> 1); j_ = (n - 36) & 1; } else if (n < 50) { i_ = 8 + (n - 42); j_ = 0; } else { i_ = 15; j_ = 15; v = false; }
        ci[sl] = i_; cj[sl] = j_; cv[sl] = v; }
    pg8::Unit un;
    constexpr int NI = 8;
    for (int ui = 0; SO.next(ui, un); ++ui)
    for (int pr = wave * NI; pr < 128; pr += NWAVES * NI) {
        const int hh = un.pn; int t[NI]; unsigned k[NI][8], mine[NI], kc[NI][2], mysel[NI];
#pragma unroll
        for (int u = 0; u < NI; ++u) { t[u] = un.pm * 256 + (pr + u) * 2 + (lane >> 5);
            typedef _Float16 h8 __attribute__((ext_vector_type(8)));
            const h8 a0 = *(const h8*)(SC + (size_t)t[u] * DM + hh * 256 + row * 128 + l16 * 8);
#pragma unroll
            for (int e = 0; e < 8; ++e) { const float v = (float)a0[e]; k[u][e] = (f2ord(v) & ~127u) | (unsigned)(127 - (l16 * 8 + e)); } }
#define CE(a, b) do { _Pragma("unroll") for (int u = 0; u < NI; ++u) { const unsigned hi_ = umax(k[u][a], k[u][b]), lo_ = umin(k[u][a], k[u][b]); k[u][a] = hi_; k[u][b] = lo_; } } while (0)
        CE(0, 1); CE(2, 3); CE(4, 5); CE(6, 7); CE(0, 2); CE(1, 3); CE(4, 6); CE(5, 7); CE(1, 2); CE(5, 6);
        CE(0, 4); CE(1, 5); CE(2, 6); CE(3, 7); CE(2, 4); CE(3, 5); CE(1, 2); CE(3, 4); CE(5, 6);
#undef CE
#pragma unroll
        for (int u = 0; u < NI; ++u) mine[u] = 0u;
#pragma unroll 4
        for (int it = 0; it < TOPK; ++it) {
#pragma unroll
            for (int u = 0; u < NI; ++u) { const unsigned m = row_allmax(k[u][0]); if (l16 == it) mine[u] = m;
                if (k[u][0] == m) { k[u][0] = k[u][1]; k[u][1] = k[u][2]; k[u][2] = k[u][3]; k[u][3] = k[u][4]; k[u][4] = k[u][5]; k[u][5] = k[u][6]; k[u][6] = k[u][7]; k[u][7] = 0u; } } }
#pragma unroll
        for (int u = 0; u < NI; ++u) { mysel[u] = 0u;
#pragma unroll
            for (int sl = 0; sl < 2; ++sl) { const unsigned k1 = (unsigned)__shfl((int)mine[u], base32 + ci[sl]), k2 = (unsigned)__shfl((int)mine[u], base32 + 16 + cj[sl]);
                const float sum = ord2f(k1 & ~127u) + ord2f(k2 & ~127u);
                kc[u][sl] = cv[sl] ? ((f2ord(sum) & ~255u) | (unsigned)(255 - (ci[sl] * 16 + cj[sl]))) : 0u; } }
#pragma unroll 4
        for (int it = 0; it < TOPK; ++it) {
#pragma unroll
            for (int u = 0; u < NI; ++u) { unsigned m = row_allmax(umax(kc[u][0], kc[u][1]));
                { auto rr = __builtin_amdgcn_permlane16_swap(m, m, false, false); m = umax(rr[0], rr[1]); }
                if (L == it) mysel[u] = m; if (kc[u][0] == m) kc[u][0] = 0u; if (kc[u][1] == m) kc[u][1] = 0u; } }
#pragma unroll
        for (int u = 0; u < NI; ++u) {
            const int cidx = 255 - (int)(mysel[u] & 255u), si = (cidx >> 4) & 15, sj = cidx & 15;
            const unsigned k1 = (unsigned)__shfl((int)mine[u], base32 + si), k2 = (unsigned)__shfl((int)mine[u], base32 + 16 + sj);
            const int i1 = 127 - (int)(k1 & 127u), i2 = 127 - (int)(k2 & 127u);
            const _Float16* sb = SC + (size_t)t[u] * DM + hh * 256;
            float sc = 0.f; if (L < TOPK) sc = (float)sb[i1] + (float)sb[128 + i2];
            const float smax = __shfl(sc, base32);
            const float e = (L < TOPK) ? __expf(sc - smax) : 0.f;
            const float den = row_allsum(e);
            if (L < TOPK) { IDS[(size_t)t[u] * NSEL + hh * TOPK + L] = i1 * NKEYS + i2; GT[(size_t)t[u] * NSEL + hh * TOPK + L] = e / den; } }
    }
}

#ifndef PH_MASK
#define PH_MASK 0xFFFFFu
#endif
#define IN(k) (lo <= (k) && (k) < hi)
#define SITE(b) (((PH_MASK) >> (b)) & 1u)
#ifndef REP_MASK
#define REP_MASK 0u
#endif
#define REPS(b) for (int rep_ = 0; rep_ < ((((REP_MASK) >> (b)) & 1u) ? 3 : 1); ++rep_)
#define STAMP(k) do { if (PROBE_HI == (k)) tp1 = __builtin_amdgcn_s_memrealtime(); if (PROBE_LO == (k) + 1) tp0 = __builtin_amdgcn_s_memrealtime(); } while (0)
#define SEAM(k) do { if (IN(k) && IN((k) + 1)) xcd_barrier(bar, wave); STAMP(k); } while (0)
#define LOCAL_SEAM(k) do { if (IN(k) && IN((k) + 1)) { asm volatile("s_waitcnt vmcnt(0)" ::: "memory"); __syncthreads(); } STAMP(k); } while (0)
#define PH_LOCALS const __attribute__((address_space(4))) Args* A_ = (const __attribute__((address_space(4))) Args*)__builtin_amdgcn_kernarg_segment_ptr(); asm volatile("" : "+s"(A_)); \
    unsigned char* ws = A_->ws; float* X = A_->out; float* rstd = (float*)(ws + WS_RSTD); float* cs = (float*)(ws + WS_CS); bf16_t* XB = (bf16_t*)(ws + WS_XB); bf16_t* XS = (bf16_t*)(ws + WS_XS); const float* x_in = (const float*)A_->in[IN_X]; \
    const int lane = lane_id_v(), tid = wave * 64 + lane, gw = bx * NWAVES + wave, NGW = G * NWAVES, gtid = bx * NTHR + tid, gthreads = G * NTHR; \
    (void)X; (void)rstd; (void)cs; (void)XB; (void)XS; (void)x_in; (void)lane; (void)tid; (void)gw; (void)NGW; (void)gtid; (void)gthreads
#define AIN(k) (A_->in[k])

template <int layer>
__device__ __forceinline__ void peer_phases(LAS unsigned char* lds, const int lo, const int hi, const XcdBarrier& bar, const int wave, const int G, const int bx, unsigned long long& tp0, unsigned long long& tp1) {
    constexpr int pb = layer ? 15 : 4;
        if (SITE(4) && IN(pb)) REPS(4) { PH_LOCALS;
            for (int m = gw; m < T; m += 4 * NGW) rows4_bf16_to_rstd_x8(XS, rstd, ws + WS_X8, (float*)(ws + WS_XSUM), m, NGW, lane);
        }
        SEAM(pb);
        if (SITE(5) && IN(pb + 1)) REPS(5) { PH_LOCALS;
            if constexpr (layer == 1) {
                pg8::Gemm g{(const bf16_t*)(ws + WS_X8), (const bf16_t*)(ws + WS_WST) + (size_t)DM * DM, T, DM, DM / 2, DM / 2, 0}; pg8::StaticOrder S; S.init(T, DM, G, bx);
                pg8::EpiF16 E{(_Float16*)(ws + WS_SC), DM, rstd, 1.f / (SX8 * SWT8)};
                pg8::gemm_phase<pg8::EpiF16, true>(lds, g, S, E, wave, lane);
            } else {
            pg8::Gemm g{XS, (const bf16_t*)(ws + WS_WST) + (size_t)layer * DM * DM, T, DM, DM, DM, 0}; pg8::StaticOrder S; S.init(T, DM, G, bx);
            pg8::EpiF16 E{(_Float16*)(ws + WS_SC), DM, rstd};
            pg8::gemm_phase<pg8::EpiF16>(lds, g, S, E, wave, lane); }
        }
        LOCAL_SEAM(pb + 1);
        LOCAL_SEAM(pb + 2);
        if (SITE(7) && IN(pb + 3)) REPS(7) { PH_LOCALS;
            peer_topk((const _Float16*)(ws + WS_SC), (int*)(ws + WS_IDS), (float*)(ws + WS_GATE), lane, wave, G, bx);
        }
        SEAM(pb + 3);
        if (SITE(8) && IN(pb + 4)) REPS(8) { PH_LOCALS;
            if (bx < 256) peer_gather<layer>(lds, ws, X, XS, rstd, (const float*)AIN(IN_FG), wave, lane, bx, tp0, tp1);
        }
}

__global__ void __launch_bounds__(NTHR, 2) fwd(Args args) {
    extern __shared__ __attribute__((aligned(16))) unsigned char lds_raw[];
    LAS unsigned char* lds = (LAS unsigned char*)lds_raw;
    volatile LAS unsigned* MISC = (volatile LAS unsigned*)(lds + MISC_OFF);
    const int wave = __builtin_amdgcn_readfirstlane(threadIdx.x >> 6);
    const int G = gridDim.x, bx = blockIdx.x;
    unsigned* ctl = (unsigned*)(args.ws + WS_CTL);
    for (int u = threadIdx.x; u < (LDS_BYTES - RING_BYTES) / 4; u += NTHR) ((LAS unsigned*)(lds + RING_BYTES))[u] = 0u;
    __syncthreads();
    XcdBarrier bar; bar.bar = ctl + CW_BAR; bar.x = 0; bar.st = nullptr;
    const int lo = args.ph_lo, hi = args.ph_hi;
    const bool multi = (hi - lo) > 1;
    if (multi) bar = xcd_barrier_post(ctl + CW_BAR, MISC + 8);
    unsigned long long tp0 = 0ull, tp1 = 0ull; if (PROBE_LO == 0) tp0 = __builtin_amdgcn_s_memrealtime();

    if (SITE(0) && IN(0)) REPS(0) { PH_LOCALS;
        LAS float* scr = (LAS float*)(lds + wave * 16384);
        const float* sbg = (const float*)AIN(IN_SBG); const float* kvg = (const float*)AIN(IN_KVG); const float* mlag = (const float*)AIN(IN_MLAG);
        const float* kvlg = (const float*)AIN(IN_KVLG); const float* qlg = (const float*)AIN(IN_QLG); const float* pg = (const float*)AIN(IN_PG);
        constexpr int I_QKV = 32 * 192, I_WO = 32 * 64, I_DKV = 32 * 18, I_DQ = 32 * 16, I_UKV = 8 * 128, I_UQ = 8 * 96, I_MO = 32 * 64, I_PQ = 32 * 64;
        constexpr int NITEMS = I_QKV + I_WO + I_DKV + I_DQ + I_UKV + I_UQ + I_MO; (void)I_PQ;
#pragma unroll 1
        for (int pass_ = 0; pass_ < 2; ++pass_) { if (((pass_ ^ bx) & 1) == 0) {
        for (int it = gw; it < NITEMS; it += NGW) {
            int r = it;
            if (r < I_QKV) { transpose_item((const float*)AIN(IN_WQKV), 6144, 2048, 192, sbg, (bf16_t*)(ws + WS_WQKV), 0, scr, r, lane); continue; } r -= I_QKV;
            if (r < I_WO) { transpose_item<true>((const float*)AIN(IN_WO), 2048, 2048, 64, nullptr, (bf16_t*)(ws + WS_WO), 0, scr, r, lane); continue; } r -= I_WO;
            if (r < I_DKV) { transpose_item<true>((const float*)AIN(IN_WDKV), 576, 2048, 18, kvg, (bf16_t*)(ws + WS_WDKQ), 0, scr, r, lane); continue; } r -= I_DKV;
            if (r < I_DQ) { transpose_item<true>((const float*)AIN(IN_WDQ), 512, 2048, 16, mlag, (bf16_t*)(ws + WS_WDKQ), 576, scr, r, lane); continue; } r -= I_DQ;
            if (r < I_UKV) { transpose_item<true>((const float*)AIN(IN_WUKV), 4096, 512, 128, kvlg, (bf16_t*)(ws + WS_WUKV), 0, scr, r, lane); continue; } r -= I_UKV;
            if (r < I_UQ) { transpose_item<true>((const float*)AIN(IN_WUQ), 3072, 512, 96, qlg, (bf16_t*)(ws + WS_WUQ), 0, scr, r, lane); continue; } r -= I_UQ;
            transpose_item<true>((const float*)AIN(IN_WMO), 2048, 2048, 64, nullptr, (bf16_t*)(ws + WS_WMO), 0, scr, r, lane);
            (void)pg;
        }
        { u32x4 z = {0u, 0u, 0u, 0u}; unsigned char* p = ws + WS_WDKQ + (size_t)1088 * DM; for (int i = gtid; i < 192 * DM / 16; i += gthreads) *(u32x4*)(p + (size_t)i * 16) = z; }
        { const float* k1 = (const float*)AIN(IN_PK1); const float* k2 = (const float*)AIN(IN_PK2); bf16_t* kbd = (bf16_t*)(ws + WS_KBD);
          for (int i = gtid; i < 2 * 2048 * 256; i += gthreads) { const int kk = i & 255, n = (i >> 8) & 255, hh = (i >> 16) & 7, l = i >> 19; float v = 0.f;
              if (n < 128) { if (kk < 128) v = k1[(((size_t)l * PH + hh) * NKEYS + n) * 128 + kk]; } else { if (kk >= 128) v = k2[(((size_t)l * PH + hh) * NKEYS + (n - 128)) * 128 + (kk - 128)]; }
              kbd[i] = (bf16_t)f2bf(v); } }
        { const float* wq = (const float*)AIN(IN_PWQ); bf16_t* wqg = (bf16_t*)(ws + WS_WPQ);
          for (size_t i = gtid; i < (size_t)2 * DM * DM / 8; i += gthreads) { const int l = (int)(i / ((size_t)DM * DM / 8)), k = (int)((i * 8 / DM) % DM); const float gk = pg[l * DM + k];
              const f32x4 a0 = *(const f32x4*)(wq + i * 8), a1 = *(const f32x4*)(wq + i * 8 + 4); u32x4 w; w.x = pk2(a0[0] * gk, a0[1] * gk); w.y = pk2(a0[2] * gk, a0[3] * gk); w.z = pk2(a1[0] * gk, a1[1] * gk); w.w = pk2(a1[2] * gk, a1[3] * gk);
              *(u32x4*)(wqg + i * 8) = w; } }
        } else {
        convert_tables8((const float*)AIN(IN_PU), (const float*)AIN(IN_PV), pg, ws + WS_TU8, ws + WS_TV8, gtid, gthreads);
        convert_tables8((const float*)AIN(IN_PU) + (size_t)NEXP * DM, (const float*)AIN(IN_PV) + (size_t)NEXP * DM, pg + DM, ws + WS_TU8 + 64 * MiB, ws + WS_TV8 + 64 * MiB, gtid, gthreads);
        for (int m = gw; m < T; m += NGW) row_to_bf16_rstd(x_in + (size_t)m * DM, XS + (size_t)m * DM, rstd + m, lane);
        { const int* pos = (const int*)AIN(IN_POS);
          for (int i = gtid; i < T * 32; i += gthreads) { const int t = i >> 5, j = i & 31; const float inv = powf(10000.f, -(float)(2 * j) / 64.f); const float ang = (float)pos[t] * inv;
              cs[2 * i] = cosf(ang); cs[2 * i + 1] = sinf(ang); } }
        } }
    }
    if (SITE(0) && IN(0)) { if (multi) xcd_barrier(bar, wave);
        PH_LOCALS;
        { pg8::Gemm g{(const bf16_t*)(ws + WS_KBD), (const bf16_t*)(ws + WS_WPQ), DM, DM, 256, 256, 0, DM, 256};
            pg8::StaticOrder S; S.init(DM, DM, G, bx); pg8::EpiB16 E{(bf16_t*)(ws + WS_WST), DM, nullptr};
            pg8::gemm_phase<pg8::EpiB16>(lds, g, S, E, wave, lane); }
        { pg8::Gemm g{(const bf16_t*)(ws + WS_KBD) + (size_t)2048 * 256, (const bf16_t*)(ws + WS_WPQ) + (size_t)DM * DM, DM, DM, 256, 256, 0, DM, 256};
            pg8::StaticOrder S; S.init(DM, DM, G, bx); pg8::EpiF8 E{ws + WS_WST + (size_t)DM * DM * 2, DM, SWT8};
            pg8::gemm_phase<pg8::EpiF8>(lds, g, S, E, wave, lane); } }
    SEAM(0);

    {
        {
            if (SITE(1) && IN(1)) REPS(1) { PH_LOCALS;
                pg8::Gemm g{XS, (const bf16_t*)(ws + WS_WQKV), T, 3 * DM, DM, DM, 0}; pg8::StaticOrder S; S.init(T, 3 * DM, G, bx);
                pg8::EpiQKV E{(bf16_t*)(ws + WS_Q), (size_t)(WS_K - WS_Q) / 2, rstd, 0.08838834764831845f * LOG2E};
                pg8::gemm_phase<pg8::EpiQKV>(lds, g, S, E, wave, lane);
            }
            SEAM(1);
            if (SITE(2) && IN(2)) REPS(2) { PH_LOCALS;
                const int bh = bx >> 1, half = bx & 1, b = bh >> 4, h = bh & 15;
                if (bx < 256) {
                    const bf16_t* Qp = (const bf16_t*)(ws + WS_Q) + (size_t)b * SEQ * DM + h * HD; const bf16_t* Kp = (const bf16_t*)(ws + WS_K) + (size_t)b * SEQ * DM + h * HD;
                    const bf16_t* Vp = (const bf16_t*)(ws + WS_V) + (size_t)b * SEQ * DM + h * HD; bf16_t* Op = (bf16_t*)((unsigned char*)XB + (size_t)b * SEQ * DM + h * HD);
                    for (int i = 0; i < 8; ++i) { const int qb = 15 - (2 * i + ((i & 1) ^ half));
                        att::attn_unit<0>(lds, Qp, DM, Kp, Vp, DM, nullptr, nullptr, Op, DM, qb * 256, wave, lane); }
                }
            }
            SEAM(2);
            if (SITE(3) && IN(3)) REPS(3) { PH_LOCALS;
                pg8::Gemm g{XB, (const bf16_t*)(ws + WS_WO), T, DM, DM / 2, DM / 2, 0}; pg8::StaticOrder S; S.init(T, DM, G, bx);
                pg8::EpiResB<false> E{XS, nullptr, 1.f / (SO8S * SWT8)};
                pg8::gemm_phase<pg8::EpiResB<false>, true>(lds, g, S, E, wave, lane);
            }
            SEAM(3);
        }
        peer_phases<0>(lds, lo, hi, bar, wave, G, bx, tp0, tp1);
        SEAM(8);
        {
            if (SITE(9) && IN(9)) REPS(9) { PH_LOCALS;
                pg8::Gemm g{(const bf16_t*)(ws + WS_X8), (const bf16_t*)(ws + WS_WDKQ), T, NDKQ, DM / 2, DM / 2, 0}; pg8::StaticOrder S; S.init(T, NDKQ, G, bx);
                pg8::EpiF8R E{ws + WS_DKQ, NDKQ, rstd, SD8 / (SX8 * SWT8), 1088};
                pg8::gemm_phase<pg8::EpiF8R, true>(lds, g, S, E, wave, lane);
            }
            SEAM(9);
            if (SITE(10) && IN(10)) REPS(10) { PH_LOCALS;
                const bf16_t* dkq = (const bf16_t*)(ws + WS_DKQ); bf16_t* CB = (bf16_t*)(ws + WS_CB); bf16_t* CQB = (bf16_t*)(ws + WS_CQB); bf16_t* KR = (bf16_t*)(ws + WS_KR);
                for (int m0 = gw; m0 < T; m0 += 4 * NGW) {
                    u32x2 awv[4], qwv[4]; float x1v[4], x2v[4], cov[4], siv[4];
#pragma unroll
                    for (int rr = 0; rr < 4; ++rr) { const int m = m0 + rr * NGW; const unsigned char* r = (const unsigned char*)dkq + (size_t)m * NDKQ;
                        awv[rr] = *(const u32x2*)(r + lane * 8); qwv[rr] = *(const u32x2*)(r + 576 + lane * 8);
                        x1v[rr] = 0.f; x2v[rr] = 0.f; cov[rr] = 0.f; siv[rr] = 0.f;
                        if (lane < 32) { x1v[rr] = __builtin_amdgcn_cvt_f32_fp8((int)r[512 + lane], 0) * (1.f / SD8); x2v[rr] = __builtin_amdgcn_cvt_f32_fp8((int)r[512 + 32 + lane], 0) * (1.f / SD8); cov[rr] = cs[((size_t)m * 32 + lane) * 2]; siv[rr] = cs[((size_t)m * 32 + lane) * 2 + 1]; } }
#pragma unroll
                    for (int rr = 0; rr < 4; ++rr) { const int m = m0 + rr * NGW; const u32x2 aw = awv[rr], qw = qwv[rr];
#define D8(wd_, hi_) __builtin_amdgcn_cvt_pk_f32_fp8((int)(wd_), hi_)
                    const f32x4 a0 = f32x4{D8(aw.x, false)[0], D8(aw.x, false)[1], D8(aw.x, true)[0], D8(aw.x, true)[1]} * (1.f / SD8), a1 = f32x4{D8(aw.y, false)[0], D8(aw.y, false)[1], D8(aw.y, true)[0], D8(aw.y, true)[1]} * (1.f / SD8);
                    const f32x4 q0 = f32x4{D8(qw.x, false)[0], D8(qw.x, false)[1], D8(qw.x, true)[0], D8(qw.x, true)[1]} * (1.f / SD8), q1 = f32x4{D8(qw.y, false)[0], D8(qw.y, false)[1], D8(qw.y, true)[0], D8(qw.y, true)[1]} * (1.f / SD8);
#undef D8
                    float sa = a0[0] * a0[0] + a0[1] * a0[1] + a0[2] * a0[2] + a0[3] * a0[3] + a1[0] * a1[0] + a1[1] * a1[1] + a1[2] * a1[2] + a1[3] * a1[3];
                    float sq = q0[0] * q0[0] + q0[1] * q0[1] + q0[2] * q0[2] + q0[3] * q0[3] + q1[0] * q1[0] + q1[1] * q1[1] + q1[2] * q1[2] + q1[3] * q1[3];
                    sa = wave_sum(sa); sq = wave_sum(sq);
                    const float ra = 1.f / sqrtf(sa * (1.f / KVL) + EPS), rq = 1.f / sqrtf(sq * (1.f / QL) + EPS);
                    const float ra8 = ra * SA8, rq8 = rq * SA8;
                    u32x2 w; w.x = pk4_fp8(a0[0] * ra8, a0[1] * ra8, a0[2] * ra8, a0[3] * ra8); w.y = pk4_fp8(a1[0] * ra8, a1[1] * ra8, a1[2] * ra8, a1[3] * ra8);
                    *(u32x2*)((unsigned char*)CB + (size_t)m * KVL + lane * 8) = w;
                    u32x2 y; y.x = pk4_fp8(q0[0] * rq8, q0[1] * rq8, q0[2] * rq8, q0[3] * rq8); y.y = pk4_fp8(q1[0] * rq8, q1[1] * rq8, q1[2] * rq8, q1[3] * rq8);
                    *(u32x2*)((unsigned char*)CQB + (size_t)m * QL + lane * 8) = y;
                    if (lane < 32) { const float x1 = x1v[rr], x2 = x2v[rr], co = cov[rr], si = siv[rr];
                        unsigned char* kr8 = (unsigned char*)KR + (size_t)m * 64;
                        kr8[lane] = (unsigned char)(__builtin_amdgcn_cvt_pk_fp8_f32((x1 * co - x2 * si) * SK8, 0.f, 0, false) & 0xff); kr8[32 + lane] = (unsigned char)(__builtin_amdgcn_cvt_pk_fp8_f32((x2 * co + x1 * si) * SK8, 0.f, 0, false) & 0xff); } } }
            }
            SEAM(10);
            if (SITE(11) && IN(11)) REPS(11) { PH_LOCALS;
                pg8::Gemm g{(const bf16_t*)(ws + WS_CB), (const bf16_t*)(ws + WS_WUKV), T, 4096, KVL / 2, KVL / 2, 0}; pg8::StaticOrder S; S.init(T, 4096, G, bx);
                pg8::EpiUKV E{(bf16_t*)(ws + WS_KN), (bf16_t*)(ws + WS_VM), nullptr, 1.f / (SA8 * SWT8)};
                pg8::gemm_phase<pg8::EpiUKV, true>(lds, g, S, E, wave, lane);
            }
            LOCAL_SEAM(11);
            if (SITE(12) && IN(12)) REPS(12) { PH_LOCALS;
                pg8::Gemm g{(const bf16_t*)(ws + WS_CQB), (const bf16_t*)(ws + WS_WUQ), T, 3072, QL / 2, QL / 2, 0}; pg8::StaticOrder S; S.init(T, 3072, G, bx);
                pg8::EpiF8 E{ws + WS_QM, 3072, SQ8 / (SA8 * SWT8)};
                pg8::gemm_phase<pg8::EpiF8, true>(lds, g, S, E, wave, lane);
            }
            SEAM(12);
            if (SITE(13) && IN(13)) REPS(13) { PH_LOCALS;
                if (bx < 256) {
                    const int xcd = bx & 7, jx = bx >> 3, gx = jx >> 4, jj = jx & 15;
#pragma unroll 1
                    for (int i = 0; i < 8; ++i) { const int bh = xcd * 16 + gx * 8 + i, b = bh >> 4, h = bh & 15; const int q0_ = (jj + (i >> 1)) & 15, qb = (i & 1) ? 15 - q0_ : q0_;
                        const bf16_t* Qp = (const bf16_t*)(ws + WS_QM + (size_t)b * SEQ * 3072 + h * 192); const bf16_t* Kp = (const bf16_t*)(ws + WS_KN + (size_t)b * SEQ * DM + h * HD);
                        const bf16_t* Vp = (const bf16_t*)(ws + WS_VM + (size_t)b * SEQ * DM + h * HD); const bf16_t* Rp = (const bf16_t*)(ws + WS_KR + (size_t)b * SEQ * 64);
                        bf16_t* Op = (bf16_t*)((unsigned char*)XB + (size_t)b * SEQ * DM + h * HD);
                        att::attn_unit<1>(lds, Qp, 3072, Kp, Vp, DM, Rp, cs + (size_t)b * SEQ * 64, Op, DM, qb * 256, wave, lane); }
                }
            }
            SEAM(13);
            if (SITE(14) && IN(14)) REPS(14) { PH_LOCALS;
                pg8::Gemm g{XB, (const bf16_t*)(ws + WS_WMO), T, DM, DM / 2, DM / 2, 0}; pg8::StaticOrder S; S.init(T, DM, G, bx);
                pg8::EpiResB<false> E{XS, nullptr, 1.f / (SO8 * SWT8)};
                pg8::gemm_phase<pg8::EpiResB<false>, true>(lds, g, S, E, wave, lane);
            }
            SEAM(14);
        }
        peer_phases<1>(lds, lo, hi, bar, wave, G, bx, tp0, tp1);
    }
    if (PROBE_LO >= 0 || PROBE_SUB) { if (PROBE_HI == 19) tp1 = __builtin_amdgcn_s_memrealtime();
#if PROBE_ARG
        { unsigned long long* durs = (unsigned long long*)(args.ws + WS_CTL + 512 * 1024);
          if (wave == 0 && lane_id_v() == 0) __hip_atomic_store(durs + bx, tp1 - tp0, __ATOMIC_RELAXED, __HIP_MEMORY_SCOPE_AGENT);
          if (multi) xcd_barrier(bar, wave);
          if (bx == 0 && wave == 0) { unsigned long long mx = 0ull; int am = 0; for (int i = 0; i < 256; ++i) { const unsigned long long v = __hip_atomic_load(durs + i, __ATOMIC_RELAXED, __HIP_MEMORY_SCOPE_AGENT); if (v > mx) { mx = v; am = i; } }
              const unsigned long long d = (PROBE_ARG == 1) ? mx * 8ull : (unsigned long long)am * 10000ull, t0_ = __builtin_amdgcn_s_memrealtime(); while (__builtin_amdgcn_s_memrealtime() - t0_ < d) __builtin_amdgcn_s_sleep(16); } }
#else
        if (bx == PROBE_WG && wave == 0) { const unsigned long long d = (tp1 - tp0) * 8ull, t0_ = __builtin_amdgcn_s_memrealtime(); while (__builtin_amdgcn_s_memrealtime() - t0_ < d) __builtin_amdgcn_s_sleep(16); }
#endif
    }
#undef IN
#undef SEAM
}

extern "C" void kernel_launch(void* const* d_in, const int* in_sizes, int n_in, void* d_out, int out_size, void* d_ws, size_t ws_size, hipStream_t stream) {
    static int grid = 0;
    if (grid == 0) {
        if (n_in != 21 || out_size != T * DM || ws_size < WS_END) { fprintf(stderr, "kernel_launch: unexpected shapes (n_in %d out %d ws %zu need %zu)\n", n_in, out_size, ws_size, (size_t)WS_END); grid = -1; return; }
        int dev = 0, cus = 0, per_cu = 0;
        if (hipGetDevice(&dev) != hipSuccess || hipDeviceGetAttribute(&cus, hipDeviceAttributeMultiprocessorCount, dev) != hipSuccess) { grid = -1; return; }
        if (hipFuncSetAttribute((const void*)fwd, hipFuncAttributeMaxDynamicSharedMemorySize, LDS_BYTES) != hipSuccess) { fprintf(stderr, "kernel_launch: hipFuncSetAttribute failed\n"); grid = -1; return; }
        if (hipOccupancyMaxActiveBlocksPerMultiprocessor(&per_cu, (const void*)fwd, NTHR, LDS_BYTES) != hipSuccess || per_cu < 1) fprintf(stderr, "kernel_launch: occupancy query reports %d\n", per_cu);
        (void)hipGetLastError();
        grid = cus < 256 ? cus : 256;
    }
    if (grid < 0) return;
    (void)hipMemsetAsync((char*)d_ws + WS_CTL, 0, CTL_ZERO_BYTES, stream);
    Args a{};
    for (int i = 0; i < 21; ++i) a.in[i] = d_in[i];
    a.out = (float*)d_out; a.ws = (unsigned char*)d_ws;
#if MK_ONE_LAUNCH
    a.ph_lo = 0; a.ph_hi = 20;
    hipLaunchKernelGGL(fwd, dim3(grid), dim3(NTHR), LDS_BYTES, stream, a);
#else
    for (int ph = 0; ph < 20; ++ph) { a.ph_lo = ph; a.ph_hi = ph + 1; hipLaunchKernelGGL(fwd, dim3(grid), dim3(NTHR), LDS_BYTES, stream, a); }
#endif
}
```
